# Optimizing an MI355X kernel written in HIP

```python
import jax, jax.numpy as jnp
from jax import lax
import numpy as np

D_MODEL = 2048
BATCH = 4
SEQ = 4096
DEPTH = 1

HEAD_DIM = 128
N_ATT_HEADS = D_MODEL // (2 * HEAD_DIM)
N_RET_HEADS = D_MODEL // (2 * HEAD_DIM)
D_ATT = N_ATT_HEADS * HEAD_DIM
D_RET = N_RET_HEADS * HEAD_DIM
D_MIX = D_ATT + D_RET
D_IN_PROJ = 3 * D_ATT + 4 * D_RET
DILATED_PATTERNS = ((128, 1), (512, 4), (2048, 16))
RET_CHUNK = 128
D_FF = -(-(8 * D_MODEL) // (3 * 256)) * 256
EPS = 1e-6

kernel_name = 'hybrid_dilated_attn_retention_block'


def rmsnorm(x, w):
    xf = x.astype(jnp.float32)
    xf = xf * lax.rsqrt(jnp.mean(xf * xf, axis=-1, keepdims=True) + EPS)
    return (xf * w.astype(jnp.float32)).astype(x.dtype)


def alibi_slopes(n_heads):
    return jnp.exp2(-8.0 * jnp.arange(1, n_heads + 1, dtype=jnp.float32) / n_heads)


def dilated_window_partial(q, k, v, slopes, window, dilation):
    B, H, S, Dh = q.shape
    half = window // (2 * dilation)
    blk = half
    L = S // dilation
    nb = -(-L // blk)
    Lp = nb * blk

    def to_sub(t):
        return t.reshape(B, H, L, dilation, Dh).transpose(0, 1, 3, 2, 4)

    qb = jnp.pad(to_sub(q), ((0, 0), (0, 0), (0, 0), (0, Lp - L), (0, 0)))
    qb = qb.reshape(B, H, dilation, nb, blk, Dh)

    def key_windows(t):
        tp = jnp.pad(to_sub(t), ((0, 0), (0, 0), (0, 0), (blk, Lp - L + blk), (0, 0)))
        tb = tp.reshape(B, H, dilation, nb + 2, blk, Dh)
        return jnp.concatenate([tb[:, :, :, :-2], tb[:, :, :, 1:-1], tb[:, :, :, 2:]], axis=4)

    kw = key_windows(k)
    vw = key_windows(v)
    s = jnp.einsum('bhrnqd,bhrnkd->bhrnqk', qb, kw) * (Dh ** -0.5)
    lq = jnp.arange(nb)[:, None] * blk + jnp.arange(blk)[None, :]
    lk = jnp.arange(nb)[:, None] * blk - blk + jnp.arange(3 * blk)[None, :]
    dist = jnp.abs(lq[:, :, None] - lk[:, None, :])
    valid = (dist <= half) & (lk[:, None, :] >= 0) & (lk[:, None, :] < L)
    bias = -slopes[:, None, None, None, None] * (dilation * dist).astype(jnp.float32)
    s = jnp.where(valid, s + bias, -jnp.inf)
    m = jnp.max(s, axis=-1)
    p = jnp.exp(s - m[..., None])
    den = jnp.sum(p, axis=-1)
    num = jnp.einsum('bhrnqk,bhrnkd->bhrnqd', p, vw)
    num = num.reshape(B, H, dilation, Lp, Dh)[:, :, :, :L].transpose(0, 1, 3, 2, 4).reshape(B, H, S, Dh)
    m = m.reshape(B, H, dilation, Lp)[..., :L].transpose(0, 1, 3, 2).reshape(B, H, S)
    den = den.reshape(B, H, dilation, Lp)[..., :L].transpose(0, 1, 3, 2).reshape(B, H, S)
    return num, m, den


def dilated_mixture_attention(q, k, v, slopes):
    q, k, v = (t.astype(jnp.float32) for t in (q, k, v))
    parts = [dilated_window_partial(q, k, v, slopes, w, d) for (w, d) in DILATED_PATTERNS]
    m_all = jnp.max(jnp.stack([p[1] for p in parts], axis=0), axis=0)
    num = 0.0
    den = 0.0
    for (n_i, m_i, d_i) in parts:
        w_i = jnp.exp(m_i - m_all)
        num = num + w_i[..., None] * n_i
        den = den + w_i * d_i
    return num / den[..., None]


def retention_direction(q, k, v, log_gamma, strict):
    B, H, S, Dh = q.shape
    C = RET_CHUNK
    nc = S // C
    idx = jnp.arange(C, dtype=jnp.float32)
    rel = idx[:, None] - idx[None, :]
    inside = (rel > 0) if strict else (rel >= 0)
    decay_mask = jnp.where(inside, jnp.exp(log_gamma[:, None, None] * jnp.maximum(rel, 0.0)), 0.0)
    q_dec = jnp.exp(log_gamma[:, None] * (idx + 1.0))[..., None]
    k_dec = jnp.exp(log_gamma[:, None] * (C - 1.0 - idx))[..., None]
    chunk_dec = jnp.exp(log_gamma * C)[:, None, None]

    def to_chunks(t):
        return t.reshape(B, H, nc, C, Dh).transpose(2, 0, 1, 3, 4)

    def step(state, qkv):
        qc, kc, vc = qkv
        inner = jnp.einsum('bhid,bhjd->bhij', qc, kc) * decay_mask
        o = jnp.einsum('bhij,bhjd->bhid', inner, vc) + jnp.einsum('bhid,bhde->bhie', qc * q_dec, state)
        state = state * chunk_dec + jnp.einsum('bhjd,bhje->bhde', kc * k_dec, vc)
        return state, o

    state0 = jnp.zeros((B, H, Dh, Dh), jnp.float32)
    _, o = lax.scan(step, state0, (to_chunks(q), to_chunks(k), to_chunks(v)))
    return o.transpose(1, 2, 0, 3, 4).reshape(B, H, S, Dh)


def bidirectional_retention(q, k, v, decay_fwd, decay_bwd):
    q, k, v = (t.astype(jnp.float32) for t in (q, k, v))
    q = q * (q.shape[-1] ** -0.5)
    lg_f = -jnp.exp(decay_fwd.astype(jnp.float32))
    lg_b = -jnp.exp(decay_bwd.astype(jnp.float32))
    o_f = retention_direction(q, k, v, lg_f, strict=False)
    flip = lambda t: jnp.flip(t, axis=2)
    o_b = flip(retention_direction(flip(q), flip(k), flip(v), lg_b, strict=True))
    return o_f + o_b


def setup_inputs(seed: int = 0) -> dict:
    key = jax.random.key(seed)
    ks = jax.random.split(key, 16)
    f32 = jnp.float32
    nrm = lambda k, shape, scale: jax.random.normal(k, shape, f32) * scale
    gain = lambda k, shape: 1.0 + 0.01 * jax.random.normal(k, shape, f32)
    base = np.log(-np.log(1.0 - 2.0 ** (-5.0 - np.arange(N_RET_HEADS)))).astype(np.float32)
    base = jnp.asarray(base)[None, :]
    return {
        'x': jax.random.normal(ks[0], (BATCH, SEQ, D_MODEL), f32),
        'norm_mix_w': gain(ks[1], (DEPTH, D_MODEL)),
        'w_in': nrm(ks[2], (DEPTH, D_MODEL, D_IN_PROJ), D_MODEL ** -0.5),
        'ret_decay_fwd': base + 0.05 * jax.random.normal(ks[3], (DEPTH, N_RET_HEADS), f32),
        'ret_decay_bwd': base + 0.05 * jax.random.normal(ks[4], (DEPTH, N_RET_HEADS), f32),
        'ret_norm_w': gain(ks[5], (DEPTH, D_RET)),
        'w_out': nrm(ks[6], (DEPTH, D_MIX, D_MODEL), D_MIX ** -0.5),
        'norm_ffn_w': gain(ks[7], (DEPTH, D_MODEL)),
        'w_gate': nrm(ks[8], (DEPTH, D_MODEL, D_FF), D_MODEL ** -0.5),
        'w_up': nrm(ks[9], (DEPTH, D_MODEL, D_FF), D_MODEL ** -0.5),
        'w_down': nrm(ks[10], (DEPTH, D_FF, D_MODEL), D_FF ** -0.5),
        'norm_final_w': gain(ks[11], (D_MODEL,)),
    }


def reference(x, norm_mix_w, w_in, ret_decay_fwd, ret_decay_bwd, ret_norm_w, w_out,
              norm_ffn_w, w_gate, w_up, w_down, norm_final_w):
    B, S, _ = x.shape
    slopes = alibi_slopes(N_ATT_HEADS)
    splits = [D_ATT, 2 * D_ATT, 3 * D_ATT, 3 * D_ATT + D_RET, 3 * D_ATT + 2 * D_RET, 3 * D_ATT + 3 * D_RET]

    def heads(t):
        return t.reshape(B, S, -1, HEAD_DIM).transpose(0, 2, 1, 3)

    def merge(t):
        return t.transpose(0, 2, 1, 3).reshape(B, S, -1)

    h = x
    for layer in range(DEPTH):
        n = rmsnorm(h, norm_mix_w[layer])
        proj = n @ w_in[layer]
        q_a, k_a, v_a, q_r, k_r, v_r, g_r = jnp.split(proj, splits, axis=-1)
        attn = dilated_mixture_attention(heads(q_a), heads(k_a), heads(v_a), slopes)
        ret = bidirectional_retention(heads(q_r), heads(k_r), heads(v_r),
                                      ret_decay_fwd[layer], ret_decay_bwd[layer])
        ret = ret * lax.rsqrt(jnp.mean(ret * ret, axis=-1, keepdims=True) + EPS)
        ret = merge(ret) * ret_norm_w[layer].astype(jnp.float32)
        ret = ret * jax.nn.silu(g_r.astype(jnp.float32))
        mixed = jnp.concatenate([merge(attn), ret], axis=-1).astype(x.dtype)
        h = h + mixed @ w_out[layer]
        n2 = rmsnorm(h, norm_ffn_w[layer])
        h = h + (jax.nn.silu(n2 @ w_gate[layer]) * (n2 @ w_up[layer])) @ w_down[layer]
    return rmsnorm(h, norm_final_w)
```

```cpp
#include <hip/hip_runtime.h>
#include <cstdio>
#include <cstdint>
namespace pg8 {
#define PG8_LAS __attribute__((address_space(3)))
typedef unsigned short bf16_t;
typedef short bf16x8 __attribute__((ext_vector_type(8)));
typedef float f32x4 __attribute__((ext_vector_type(4)));
typedef unsigned u32x4 __attribute__((ext_vector_type(4)));
constexpr int BM = 256, BK = 64, HALF = 128, HTB = HALF * BK * 2  , STAGE_BYTES = 8 * HTB, NXCD = 8, WGM = 8;

__host__ __device__ __forceinline__ int lds_byte(int r, int c) { const int st = (r >> 4) * 2 + (c >> 5), rr = r & 15, cc = c & 31, ob = rr * 64 + cc * 2; return st * 1024 + (ob ^ (((ob >> 9) & 1) << 5)); }
__host__ __device__ __forceinline__ void stage_rc(int b, int& R, int& C) { const int st = b / 1024, sb = b % 1024, swz = sb ^ (((sb >> 9) & 1) << 5); R = (st >> 1) * 16 + swz / 64; C = (st & 1) * 32 + (swz % 64) / 2; }
__host__ __device__ __forceinline__ int perm32(int rho) { const int n = rho >> 4, i = rho & 15; return 8 * (i >> 2) + 4 * n + (i & 3); }

struct Unit { int pm, pn; };
struct Gemm { const bf16_t* A; const bf16_t* Bt; int M, N, K; };

struct StaticOrder {
    int nM, nN, nwg, G, c;
    __host__ __device__ void init(int M, int N, int G_, int c_) { nM = M / BM; nN = N / BM; nwg = nM * nN; G = G_; c = c_; }
    __host__ __device__ bool next(int i, Unit& u) const {
        const long L = (long)i * G + c; if (L >= nwg) return false;
        int wgid = (int)L; { const int q = nwg / NXCD, r = nwg % NXCD, xcd = wgid % NXCD, off = wgid / NXCD; wgid = (xcd < r ? xcd * (q + 1) : r * (q + 1) + (xcd - r) * q) + off; }
        const int nig = WGM * nN, gid = wgid / nig, fm = gid * WGM, gsz = (nM - fm) < WGM ? (nM - fm) : WGM;
        u.pm = fm + ((wgid % nig) % gsz); u.pn = (wgid % nig) / gsz; return true;
    }
    __device__ __forceinline__ void a_ready(const Unit&) const {}
    __device__ __forceinline__ void done(const Unit&) const {}
};

__device__ __forceinline__ unsigned cvt_pk_bf16(float lo, float hi) { unsigned r; asm volatile("v_cvt_pk_bf16_f32 %0, %1, %2" : "=v"(r) : "v"(lo), "v"(hi)); return r; }
typedef float f32x2 __attribute__((ext_vector_type(2)));
__device__ __forceinline__ f32x2 gelu_pk(f32x2 v) {
    const f32x2 av = __builtin_elementwise_abs(v), d = av * 0.2316418882f + 1.0f;
    f32x2 t; t.x = __builtin_amdgcn_rcpf(d.x); t.y = __builtin_amdgcn_rcpf(d.y);
    f32x2 q = t * 0.5307027145f + (-0.7265760135f); q = q * t + 0.7107068705f; q = q * t + (-0.142248368f); q = q * t + 0.127414796f; q = q * t;
    const f32x2 s = (v * v) * (-0.72134752044f);
    f32x2 e; e.x = __builtin_amdgcn_exp2f(s.x); e.y = __builtin_amdgcn_exp2f(s.y);
    const f32x2 m = v * (q * e), r = v - m;
    f32x2 o; o.x = v.x < 0.f ? m.x : r.x; o.y = v.y < 0.f ? m.y : r.y; return o;
}

template <int ACT  > struct EpiBf16 {
    static constexpr bool PERM = true, AFTER_DRAIN = false; static_assert(ACT == 0 || ACT == 1, "EpiBf16: ACT is 0 (none) or 1 (gelu_pk)");
    bf16_t* O; int ldc; const float* bias; int split_cols; size_t split_stride; float scale0;
    __device__ __forceinline__ void operator()(const f32x4 (&acc)[2][2][4][2], const Unit& u, int wr, int wc, int fr, int fq) const {
        const int row0 = u.pm * BM + wr * 64 + fr; int colt = u.pn * BM; bf16_t* base = O;
        float sc = 1.f; if (split_cols) { const int t = colt / split_cols; base += (size_t)t * split_stride; colt -= t * split_cols; if (t == 0) sc = scale0; }
        const int col0 = colt + wc * 32 + 8 * fq, bcol0 = u.pn * BM + wc * 32 + 8 * fq;
        f32x4 bv[2][2];
#pragma unroll
        for (int bj = 0; bj < 2; ++bj)
#pragma unroll
            for (int n = 0; n < 2; ++n) bv[bj][n] = bias ? *(const f32x4*)(bias + bcol0 + bj * HALF + 4 * n) : (f32x4){0.f, 0.f, 0.f, 0.f};
#pragma unroll
        for (int ai = 0; ai < 2; ++ai)
#pragma unroll
            for (int m = 0; m < 4; ++m) { bf16_t* rowp = base + (size_t)(row0 + ai * HALF + m * 16) * ldc + col0;
#pragma unroll
                for (int bj = 0; bj < 2; ++bj) { f32x4 v0 = acc[ai][bj][m][0] + bv[bj][0], v1 = acc[ai][bj][m][1] + bv[bj][1];
                    if (ACT == 1) { f32x2 a = gelu_pk((f32x2){v0[0], v0[1]}), b = gelu_pk((f32x2){v0[2], v0[3]}), c = gelu_pk((f32x2){v1[0], v1[1]}), d = gelu_pk((f32x2){v1[2], v1[3]});
                        v0 = (f32x4){a.x, a.y, b.x, b.y}; v1 = (f32x4){c.x, c.y, d.x, d.y}; }
                    v0 = v0 * sc; v1 = v1 * sc; u32x4 w; w.x = cvt_pk_bf16(v0[0], v0[1]); w.y = cvt_pk_bf16(v0[2], v0[3]); w.z = cvt_pk_bf16(v1[0], v1[1]); w.w = cvt_pk_bf16(v1[2], v1[3]);
                    *(u32x4*)(rowp + bj * HALF) = w; } }
    }
};
struct EpiResid {
    static constexpr bool PERM = true, AFTER_DRAIN = false;
    const float* base; float* out; bf16_t* hb; float* ss; int ldc;
    __device__ __forceinline__ void operator()(const f32x4 (&acc)[2][2][4][2], const Unit& u, int wr, int wc, int fr, int fq) const {
        const int row0 = u.pm * BM + wr * 64 + fr, col0 = u.pn * BM + wc * 32 + 8 * fq;
#pragma unroll
        for (int ai = 0; ai < 2; ++ai)
#pragma unroll
            for (int m = 0; m < 4; ++m) { const int row = row0 + ai * HALF + m * 16; const size_t off = (size_t)row * ldc + col0; float s = 0.f;
#pragma unroll
                for (int bj = 0; bj < 2; ++bj) {
                    const f32x4 b0 = *(const f32x4*)(base + off + bj * HALF), b1 = *(const f32x4*)(base + off + bj * HALF + 4);
                    const f32x4 v0 = acc[ai][bj][m][0] + b0, v1 = acc[ai][bj][m][1] + b1;
                    *(f32x4*)(out + off + bj * HALF) = v0; *(f32x4*)(out + off + bj * HALF + 4) = v1;
                    if (hb) { u32x4 w; w.x = cvt_pk_bf16(v0[0], v0[1]); w.y = cvt_pk_bf16(v0[2], v0[3]); w.z = cvt_pk_bf16(v1[0], v1[1]); w.w = cvt_pk_bf16(v1[2], v1[3]); *(u32x4*)(hb + off + bj * HALF) = w; }
                    s += (v0[0] * v0[0] + v0[1] * v0[1]) + (v0[2] * v0[2] + v0[3] * v0[3]) + (v1[0] * v1[0] + v1[1] * v1[1]) + (v1[2] * v1[2] + v1[3] * v1[3]);
                }
                if (ss) { s += __shfl_xor(s, 16); s += __shfl_xor(s, 32); if (fq == 0) (void)__hip_atomic_fetch_add(ss + row, s, __ATOMIC_RELAXED, __HIP_MEMORY_SCOPE_AGENT); }
                asm volatile("" ::: "memory"); }
    }
};
struct EpiSwiGLU {
    static constexpr bool PERM = true, AFTER_DRAIN = false;
    bf16_t* O; int ldc; const float* ss; float inv_d, eps;
    __device__ __forceinline__ void operator()(const f32x4 (&acc)[2][2][4][2], const Unit& u, int wr, int wc, int fr, int fq) const {
        const int row0 = u.pm * BM + wr * 64 + fr, col0 = u.pn * HALF + wc * 32 + 8 * fq;
#pragma unroll
        for (int ai = 0; ai < 2; ++ai)
#pragma unroll
            for (int m = 0; m < 4; ++m) { const int row = row0 + ai * HALF + m * 16; const float rstd = __builtin_amdgcn_rsqf(ss[row] * inv_d + eps);
                float a[8];
#pragma unroll
                for (int n = 0; n < 2; ++n)
#pragma unroll
                    for (int i = 0; i < 4; ++i) { const float g = acc[ai][0][m][n][i] * rstd, up = acc[ai][1][m][n][i] * rstd;
                        a[4 * n + i] = g * __builtin_amdgcn_rcpf(1.0f + __builtin_amdgcn_exp2f(-1.4426950408889634f * g)) * up; }
                u32x4 w; w.x = cvt_pk_bf16(a[0], a[1]); w.y = cvt_pk_bf16(a[2], a[3]); w.z = cvt_pk_bf16(a[4], a[5]); w.w = cvt_pk_bf16(a[6], a[7]);
                *(u32x4*)(O + (size_t)row * ldc + col0) = w; }
    }
};

struct EpiHeads {
    static constexpr bool PERM = true, AFTER_DRAIN = false;
    bf16_t* O; int Mrows;
    __device__ __forceinline__ void operator()(const f32x4 (&acc)[2][2][4][2], const Unit& u, int wr, int wc, int fr, int fq) const {
        const int row0 = u.pm * BM + wr * 64 + fr, col = wc * 32 + 8 * fq;
#pragma unroll
        for (int bj = 0; bj < 2; ++bj) { bf16_t* base = O + (size_t)(u.pn * 2 + bj) * Mrows * HALF + col;
#pragma unroll
            for (int ai = 0; ai < 2; ++ai)
#pragma unroll
                for (int m = 0; m < 4; ++m) { const f32x4 v0 = acc[ai][bj][m][0], v1 = acc[ai][bj][m][1];
                    u32x4 w; w.x = cvt_pk_bf16(v0[0], v0[1]); w.y = cvt_pk_bf16(v0[2], v0[3]); w.z = cvt_pk_bf16(v1[0], v1[1]); w.w = cvt_pk_bf16(v1[2], v1[3]);
                    *(u32x4*)(base + (size_t)(row0 + ai * HALF + m * 16) * HALF) = w; } }
    }
};
struct EpiNull {
    static constexpr bool PERM = true, AFTER_DRAIN = false;
    __device__ __forceinline__ void operator()(const f32x4 (&acc)[2][2][4][2], const Unit&, int, int, int, int) const {
#pragma unroll
        for (int ai = 0; ai < 2; ++ai)
#pragma unroll
            for (int bj = 0; bj < 2; ++bj)
#pragma unroll
                for (int m = 0; m < 4; ++m)
#pragma unroll
                    for (int n = 0; n < 2; ++n) asm volatile("" :: "v"(acc[ai][bj][m][n]));
    }
};

template <class Epi, class Sched, bool ALIGN_EPI = false, bool SP2 = false>
__device__ __forceinline__ void gemm_phase(PG8_LAS unsigned char* lds, const Gemm g, const Sched& S, const Epi& E) {
    int tid_ = threadIdx.x; asm volatile("" : "+v"(tid_));
    const int tid = tid_, wid = __builtin_amdgcn_readfirstlane(tid >> 6), lane = tid & 63, wr = wid >> 2, wc = wid & 3, fr = lane & 15, fq = lane >> 4;
    const int K = g.K, nt = K / BK;
    unsigned voffA[2], voffB[2];
#pragma unroll
    for (int i = 0; i < 2; ++i) { int R, C; stage_rc(tid * 16 + i * 8192, R, C); const int Rb = Epi::PERM ? ((R & ~31) + perm32(R & 31)) : R;
        voffA[i] = (unsigned)(R * K + C) * 2u; voffB[i] = (unsigned)(Rb * K + C) * 2u; }
    const size_t kstep = (size_t)(BK * 2);
    const size_t hstep = (size_t)HALF * K * 2;
    const size_t tstep = 2 * hstep;
    const unsigned ldsw = (unsigned)wid * 1024u;
    const int aoff = lds_byte(wr * 64 + fr, fq * 8), boff = lds_byte(wc * 32 + fr, fq * 8);
#define PG8_SA(b, h) (((b) * 2 + (h)) * HTB)
#define PG8_SB(b, h) ((4 + (b) * 2 + (h)) * HTB)
#define PG8_STAGE(bufoff, gbase, voff) do { _Pragma("unroll") for (int _i = 0; _i < 2; ++_i) \
        __builtin_amdgcn_global_load_lds((const unsigned*)((const char*)(gbase) + (voff)[_i]), (PG8_LAS unsigned*)(lds + (bufoff) + ldsw + _i * 8192), 16, 0, 0); } while (0)
#define PG8_LDA(dst, b, h) do { _Pragma("unroll") for (int m = 0; m < 4; ++m) _Pragma("unroll") for (int k = 0; k < 2; ++k) dst[m][k] = *(const PG8_LAS bf16x8*)(lds + PG8_SA(b, h) + aoff + m * 2048 + k * 1024); } while (0)
#define PG8_LDB(dst, b, h) do { _Pragma("unroll") for (int n = 0; n < 2; ++n) _Pragma("unroll") for (int k = 0; k < 2; ++k) dst[n][k] = *(const PG8_LAS bf16x8*)(lds + PG8_SB(b, h) + boff + n * 2048 + k * 1024); } while (0)
#define PG8_MMA(ai, bj, At, Bt) do { __builtin_amdgcn_s_setprio(1); _Pragma("unroll") for (int m = 0; m < 4; ++m) _Pragma("unroll") for (int n = 0; n < 2; ++n) _Pragma("unroll") for (int k = 0; k < 2; ++k) \
        acc[ai][bj][m][n] = __builtin_amdgcn_mfma_f32_16x16x32_bf16(Bt[n][k], At[m][k], acc[ai][bj][m][n], 0, 0, 0); __builtin_amdgcn_s_setprio(0); } while (0)
#define PG8_WAIT_V(n) asm volatile("s_waitcnt vmcnt(" #n ")" ::: "memory")
#define PG8_WAIT_L(n) asm volatile("s_waitcnt lgkmcnt(" #n ")" ::: "memory")
#define PG8_BAR __builtin_amdgcn_s_barrier()
#define PG8_SCHED __builtin_amdgcn_sched_barrier(0)
    Unit cur, nxt; int ui = 0;
    if (!S.next(0, cur)) return;
    f32x4 acc[2][2][4][2];
#pragma unroll
    for (int a = 0; a < 2; ++a)
#pragma unroll
        for (int b = 0; b < 2; ++b)
#pragma unroll
            for (int m = 0; m < 4; ++m)
#pragma unroll
                for (int n = 0; n < 2; ++n) acc[a][b][m][n] = (f32x4){0.f, 0.f, 0.f, 0.f};
    bf16x8 At[4][2], B0[2][2], B1[2][2];
    const char* cA = (const char*)g.A + (size_t)cur.pm * tstep; const char* cB = (const char*)g.Bt + (size_t)cur.pn * tstep;
    S.a_ready(cur);
    if constexpr (SP2) {
        PG8_STAGE(PG8_SB(0, 0), cB, voffB); PG8_STAGE(PG8_SB(0, 1), cB + hstep, voffB); PG8_STAGE(PG8_SA(0, 0), cA, voffA); PG8_STAGE(PG8_SA(0, 1), cA + hstep, voffA);
        if (wr == 1) PG8_BAR;
        PG8_WAIT_V(2); PG8_BAR;
        PG8_STAGE(PG8_SB(1, 0), cB + kstep, voffB); PG8_STAGE(PG8_SA(1, 0), cA + kstep, voffA); PG8_STAGE(PG8_SB(1, 1), cB + hstep + kstep, voffB);
        PG8_WAIT_V(6); PG8_BAR;
    } else {
        PG8_STAGE(PG8_SB(0, 0), cB, voffB); PG8_STAGE(PG8_SA(0, 0), cA, voffA); PG8_STAGE(PG8_SB(0, 1), cB + hstep, voffB); PG8_STAGE(PG8_SA(0, 1), cA + hstep, voffA);
        if (wr == 1) PG8_BAR;
        PG8_WAIT_V(4); PG8_BAR;
        PG8_STAGE(PG8_SB(1, 0), cB + kstep, voffB); PG8_STAGE(PG8_SA(1, 0), cA + kstep, voffA); PG8_STAGE(PG8_SB(1, 1), cB + hstep + kstep, voffB);
        PG8_WAIT_V(6); PG8_BAR;
    }
    for (;;) {
        const bool has_next = S.next(ui + 1, nxt);
        const char* nA = has_next ? (const char*)g.A + (size_t)nxt.pm * tstep : cA; const char* nB = has_next ? (const char*)g.Bt + (size_t)nxt.pn * tstep : cB;
        for (int t = 0; t < nt; t += 2) {
            const bool last = (t == nt - 2);
            const char* a1 = cA + (size_t)(t + 1) * kstep;
            const char* a2 = last ? nA : cA + (size_t)(t + 2) * kstep; const char* b2 = last ? nB : cB + (size_t)(t + 2) * kstep;
            const char* a3 = a2 + kstep; const char* b3 = b2 + kstep;
            if (last && has_next) S.a_ready(nxt);
            if constexpr (SP2) {
            PG8_LDB(B0, 0, 0); PG8_LDB(B1, 0, 1); PG8_SCHED; PG8_LDA(At, 0, 0); PG8_STAGE(PG8_SA(1, 1), a1 + hstep, voffA);
            PG8_WAIT_V(8); PG8_WAIT_L(0); PG8_BAR; PG8_MMA(0, 0, At, B0); PG8_MMA(0, 1, At, B1); PG8_BAR; PG8_SCHED;
            PG8_LDA(At, 0, 1); PG8_STAGE(PG8_SB(0, 0), b2, voffB); PG8_STAGE(PG8_SB(0, 1), b2 + hstep, voffB); PG8_STAGE(PG8_SA(0, 0), a2, voffA);
            PG8_WAIT_V(8); PG8_WAIT_L(0); PG8_BAR; PG8_MMA(1, 0, At, B0); PG8_MMA(1, 1, At, B1); PG8_BAR; PG8_SCHED;
            PG8_LDB(B0, 1, 0); PG8_LDB(B1, 1, 1); PG8_SCHED; PG8_LDA(At, 1, 0); PG8_STAGE(PG8_SA(0, 1), a2 + hstep, voffA);
            PG8_WAIT_V(8); PG8_WAIT_L(0); PG8_BAR; PG8_MMA(0, 0, At, B0); PG8_MMA(0, 1, At, B1); PG8_BAR; PG8_SCHED;
            PG8_LDA(At, 1, 1); PG8_STAGE(PG8_SB(1, 0), b3, voffB); PG8_STAGE(PG8_SB(1, 1), b3 + hstep, voffB); PG8_STAGE(PG8_SA(1, 0), a3, voffA);
            PG8_WAIT_V(8); PG8_WAIT_L(0); PG8_BAR; PG8_MMA(1, 0, At, B0); PG8_MMA(1, 1, At, B1); PG8_BAR; PG8_SCHED;
            } else {
            PG8_LDB(B0, 0, 0); PG8_SCHED; PG8_LDA(At, 0, 0); PG8_STAGE(PG8_SA(1, 1), a1 + hstep, voffA);
            PG8_WAIT_L(8); PG8_BAR; PG8_WAIT_L(0); PG8_MMA(0, 0, At, B0); PG8_BAR; PG8_SCHED;
            PG8_LDB(B1, 0, 1); PG8_STAGE(PG8_SB(0, 0), b2, voffB);
            PG8_BAR; PG8_WAIT_L(0); PG8_MMA(0, 1, At, B1); PG8_BAR;
            PG8_LDA(At, 0, 1); PG8_STAGE(PG8_SA(0, 0), a2, voffA);
            PG8_BAR; PG8_WAIT_L(0); PG8_MMA(1, 0, At, B0); PG8_BAR; PG8_SCHED;
            PG8_STAGE(PG8_SB(0, 1), b2 + hstep, voffB);
            PG8_WAIT_V(6); PG8_BAR; PG8_MMA(1, 1, At, B1); PG8_BAR;
            PG8_LDB(B0, 1, 0); PG8_SCHED; PG8_LDA(At, 1, 0); PG8_STAGE(PG8_SA(0, 1), a2 + hstep, voffA);
            PG8_WAIT_L(8); PG8_BAR; PG8_WAIT_L(0); PG8_MMA(0, 0, At, B0); PG8_BAR; PG8_SCHED;
            PG8_LDB(B1, 1, 1); PG8_STAGE(PG8_SB(1, 0), b3, voffB);
            PG8_BAR; PG8_WAIT_L(0); PG8_MMA(0, 1, At, B1); PG8_BAR;
            PG8_LDA(At, 1, 1); PG8_STAGE(PG8_SA(1, 0), a3, voffA);
            PG8_BAR; PG8_WAIT_L(0); PG8_MMA(1, 0, At, B0); PG8_BAR; PG8_SCHED;
            PG8_STAGE(PG8_SB(1, 1), b3 + hstep, voffB);
            PG8_WAIT_V(6); PG8_BAR; PG8_MMA(1, 1, At, B1); PG8_BAR;
            }
        }
        if constexpr (ALIGN_EPI) { if (wr == 0) PG8_BAR; }
        if constexpr (!Epi::AFTER_DRAIN) { E(acc, cur, wr, wc, fr, fq); S.done(cur); }
        if (!has_next) break;
#pragma unroll
        for (int a = 0; a < 2; ++a)
#pragma unroll
            for (int b = 0; b < 2; ++b)
#pragma unroll
                for (int m = 0; m < 4; ++m)
#pragma unroll
                    for (int n = 0; n < 2; ++n) acc[a][b][m][n] = (f32x4){0.f, 0.f, 0.f, 0.f};
        cur = nxt; cA = nA; cB = nB; ++ui;
        if constexpr (ALIGN_EPI) { if (wr == 1) PG8_BAR; }
    }
    PG8_WAIT_V(0);
    if constexpr (!ALIGN_EPI) { if (wr == 0) PG8_BAR; }
    PG8_BAR;
    if constexpr (Epi::AFTER_DRAIN) { E.fused(acc, cur, wr, wc, fr, fq, lds, wid, lane); S.done(cur); }
#undef PG8_SA
#undef PG8_SB
#undef PG8_STAGE
#undef PG8_LDA
#undef PG8_LDB
#undef PG8_MMA
#undef PG8_WAIT_V
#undef PG8_WAIT_L
#undef PG8_BAR
#undef PG8_SCHED
}
}

constexpr int NWAVES = 8;
#ifndef ATTN_NAIVE
#define ATTN_NAIVE 0
#endif
#ifndef ATTN_V1
#define ATTN_V1 0
#endif
#ifndef R1_NAIVE
#define R1_NAIVE 0
#endif
#ifndef R3_NAIVE
#define R3_NAIVE 0
#endif
#ifndef PROBE_REPEAT
#define PROBE_REPEAT 0
#endif
#ifndef PROBE_T
#define PROBE_T 0
#endif
#ifndef PROBE_MULT
#define PROBE_MULT 16
#endif
#ifndef PROBE_USE_B
#define PROBE_USE_B 0
#endif
#ifndef PROBE_BLOCK
#define PROBE_BLOCK 0
#endif
#ifndef MK_N_LAUNCHES
#define MK_N_LAUNCHES 1
#endif
constexpr int PER_PHASE = 9;
constexpr int N_LAUNCHES = MK_N_LAUNCHES;

constexpr int BATCH = 4, SEQ = 4096, D = 2048, M = BATCH * SEQ, HD = 128, NH = 8, DATT = 1024, DRET = 1024, DIN = 7168, DFF = 5632, NGU = 2 * DFF, CH = 128, NCH = SEQ / CH;
constexpr float EPS = 1e-6f;
constexpr int COL_QA = 0, COL_KA = 1024, COL_VA = 2048, COL_QR = 3072, COL_KR = 4096, COL_VR = 5120, COL_GR = 6144;

constexpr size_t MiB = 1u << 20;
constexpr size_t WS_CTL = 0, CTL_ZERO_BYTES = 1 * MiB;
constexpr size_t WS_WIN = 1 * MiB, WS_WOUT = 29 * MiB, WS_WGU = 37 * MiB, WS_WDN = 81 * MiB;
constexpr size_t WS_LSE = 103 * MiB;
constexpr size_t WS_XN = 105 * MiB;
constexpr size_t WS_PROJ = 169 * MiB;
constexpr size_t WS_MIX = 393 * MiB;
constexpr size_t WS_END = 457 * MiB;
static_assert(WS_WIN + (size_t)DIN * D * 2 <= WS_WOUT && WS_WOUT + (size_t)D * D * 2 <= WS_WGU && WS_WGU + (size_t)NGU * D * 2 <= WS_WDN && WS_WDN + (size_t)D * DFF * 2 <= WS_LSE, "weight map");
static_assert(WS_XN + (size_t)M * D * 2 <= WS_PROJ && WS_PROJ + (size_t)M * DIN * 2 <= WS_MIX && WS_MIX + (size_t)M * D * 2 <= WS_END, "activation map");
constexpr int CW_TMO = 0, CW_CODE = 1, CW_BAR = 4096;
constexpr size_t CTL_SS1 = 256 * 1024;
constexpr size_t ST_HALF = (size_t)BATCH * NH * NCH * HD * HD;

constexpr int RING_OFF = 0, RING_BYTES = 143360;
constexpr int LDSCTL_OFF = RING_BYTES, MISC_OFF = LDSCTL_OFF + 320;
constexpr int LDS_BYTES = 147456;
static_assert(MISC_OFF + 128 <= LDS_BYTES, "LDS map");

#define GAS __attribute__((address_space(1)))
#define LAS __attribute__((address_space(3)))
typedef unsigned short bf16;
typedef unsigned v4u __attribute__((ext_vector_type(4)));
typedef float f32x4 __attribute__((ext_vector_type(4)));
typedef GAS unsigned gu32;
#define RLX_AGENT __ATOMIC_RELAXED, __HIP_MEMORY_SCOPE_AGENT
#define LDS_WAIT() asm volatile("s_waitcnt lgkmcnt(0)" ::: "memory")
#define VM_WAIT() asm volatile("s_waitcnt vmcnt(0)" ::: "memory")
__device__ __forceinline__ unsigned f2bf(float f) { unsigned u = __builtin_bit_cast(unsigned, f); return (u + 0x7fffu + ((u >> 16) & 1u)) >> 16; }
__device__ __forceinline__ unsigned pk2(float lo, float hi) { return f2bf(lo) | (f2bf(hi) << 16); }
__device__ __forceinline__ float bflo(unsigned w) { return __builtin_bit_cast(float, w << 16); }
__device__ __forceinline__ float bfhi(unsigned w) { return __builtin_bit_cast(float, w & 0xffff0000u); }

#define XB_TMO      128
#define XB_XCNT(j)  (256  + 64 * (j))
#define XB_XSUB(j)  (1280 + 64 * (j))
#define XB_XGEN(j)  (2304 + 64 * (j))
#define XB_TOP      3328
#define XB_TOPGEN   3392
#define XCD_BAR_WORDS 3456
#define XB_SPIN_CAP (1u << 18)

__device__ __forceinline__ unsigned xb_ld(unsigned* p)              { return __hip_atomic_load(p, __ATOMIC_RELAXED, __HIP_MEMORY_SCOPE_AGENT); }
__device__ __forceinline__ unsigned xb_add(unsigned* p, unsigned v) { return __hip_atomic_fetch_add(p, v, __ATOMIC_RELAXED, __HIP_MEMORY_SCOPE_AGENT); }
__device__ __forceinline__ unsigned xb_xcc_id() { return (unsigned)__builtin_amdgcn_s_getreg((3 << 11) | 20) & 0xFu; }
#define XB_SPIN(cond, bar) do { unsigned _sp = 0; while (cond) { __builtin_amdgcn_s_sleep(1); \
    if ((++_sp & 255u) == 0u) { if (xb_ld(&(bar)[XB_TMO])) break; if (_sp > XB_SPIN_CAP) { atomicAdd(&(bar)[XB_TMO], 1u); break; } } } } while (0)

struct XcdBarrier {
    unsigned* bar; unsigned x;
    volatile LAS unsigned* st;
};

__device__ __forceinline__ XcdBarrier xcd_barrier_post(unsigned* bar, volatile LAS unsigned* st) {
    XcdBarrier b; b.bar = bar; b.x = xb_xcc_id(); b.st = st;
    if (threadIdx.x == 0) (void)xb_add(&bar[XB_XCNT(b.x)], 1u);
    return b;
}
__device__ __forceinline__ void xcd_barrier_complete(unsigned* bar, unsigned x, unsigned& nloc, unsigned& nx) {
    const unsigned G = gridDim.x * gridDim.y * gridDim.z;
    unsigned sum, cnt, mine, sp = 0u;
    for (;;) {
        sum = 0u; cnt = 0u; mine = 0u;
#pragma unroll
        for (unsigned j = 0; j < 16; ++j) { const unsigned c = xb_ld(&bar[XB_XCNT(j)]); sum += c; cnt += (c > 0u) ? 1u : 0u; mine = (j == x) ? c : mine; }
        if (sum == G) break;
        __builtin_amdgcn_s_sleep(1);
        if ((++sp & 255u) == 0u) { if (xb_ld(&bar[XB_TMO])) break; if (sp > XB_SPIN_CAP) { atomicAdd(&bar[XB_TMO], 1u); break; } }
    }
    nloc = mine > 0u ? mine : 1u; nx = cnt > 0u ? cnt : 1u;
}

__device__ __forceinline__ void xcd_barrier(const XcdBarrier& b) {
    asm volatile("s_waitcnt vmcnt(0)" ::: "memory");
    __syncthreads();
    if (threadIdx.x == 0) {
        unsigned* bar = b.bar;
        __builtin_amdgcn_s_waitcnt(0);
        unsigned nloc = b.st[0], nx = b.st[1];
        if (nloc == 0u) { xcd_barrier_complete(bar, b.x, nloc, nx); b.st[0] = nloc; b.st[1] = nx; }
        const unsigned old = xb_add(&bar[XB_XSUB(b.x)], 1u);
        const unsigned gen = old / nloc;
        if (old + 1u == (gen + 1u) * nloc) {
            __builtin_amdgcn_fence(__ATOMIC_RELEASE, "agent");
            asm volatile("s_waitcnt vmcnt(0)" ::: "memory");
            const unsigned og = xb_add(&bar[XB_TOP], 1u);
            const unsigned tg = og / nx;
            if (og + 1u == (tg + 1u) * nx) xb_add(&bar[XB_TOPGEN], 1u);
            else XB_SPIN(xb_ld(&bar[XB_TOPGEN]) == tg, bar);
            __builtin_amdgcn_fence(__ATOMIC_ACQUIRE, "agent");
            xb_add(&bar[XB_XGEN(b.x)], 1u);
            asm volatile("s_waitcnt vmcnt(0)" ::: "memory");
        } else {
            XB_SPIN(xb_ld(&bar[XB_XGEN(b.x)]) == gen, bar);
            __builtin_amdgcn_fence(__ATOMIC_ACQUIRE, "agent");
            asm volatile("s_waitcnt vmcnt(0)" ::: "memory");
        }
    }
    __syncthreads();
}

struct Frame {
    LAS unsigned char* lds;
    volatile LAS unsigned* MISC;
    gu32* ctl;
    int tid, lane, wave;
    int vcu, G;
    const float *x, *w_mix, *w_in, *decf, *decb, *w_retn, *w_out, *w_ffn, *w_gate, *w_up, *w_down, *w_fin; float* out;
    bf16 *Win_t, *Wout_t, *Wgu_t, *Wdn_t;
    bf16 *XN, *PROJ, *MIX, *ACT;
    float *STF, *STB, *SS1, *LSE;
    unsigned long long tA, tB;
};
#if PROBE_T
#define RT() __builtin_amdgcn_s_memrealtime()
#define T_ADD(acc, t0) do { __builtin_amdgcn_sched_barrier(0); (acc) += RT() - (t0); __builtin_amdgcn_sched_barrier(0); } while (0)
#define T_START(t0) do { __builtin_amdgcn_sched_barrier(0); (t0) = RT(); __builtin_amdgcn_sched_barrier(0); } while (0)
#else
#define T_ADD(acc, t0) do {} while (0)
#define T_START(t0) do {} while (0)
#endif

__device__ __forceinline__ float wave_sum(float v) {
#pragma unroll
    for (int o = 1; o < 64; o <<= 1) v += __shfl_xor(v, o);
    return v;
}
__device__ __forceinline__ float wave_max(float v) {
#pragma unroll
    for (int o = 1; o < 64; o <<= 1) v = fmaxf(v, __shfl_xor(v, o));
    return v;
}
__device__ __forceinline__ void p0_transpose_item(const float* W, int K, int N, bf16* WT, int row_base, const float* kscale, LAS float* scr, int k0, int n0, int lane) {
#pragma unroll 8
    for (int i = 0; i < 32; ++i) { const int kk = 2 * i + (lane >> 5); float v = W[(size_t)(k0 + kk) * N + n0 + (lane & 31)]; if (kscale) v *= kscale[k0 + kk]; scr[kk * 33 + (lane & 31)] = v; }
    LDS_WAIT(); asm volatile("" ::: "memory");
    const int c = lane & 7;
#pragma unroll
    for (int j = 0; j < 4; ++j) { const int n = (lane >> 3) + 8 * j; const LAS float* s = scr + (8 * c) * 33 + n;
        v4u o; o.x = pk2(s[0 * 33], s[1 * 33]); o.y = pk2(s[2 * 33], s[3 * 33]); o.z = pk2(s[4 * 33], s[5 * 33]); o.w = pk2(s[6 * 33], s[7 * 33]);
        *(GAS v4u*)(WT + (size_t)(row_base + n) * K + k0 + 8 * c) = o; }
    LDS_WAIT(); asm volatile("" ::: "memory");
}
__device__ __forceinline__ void p0_prologue(Frame& F) {
    LAS float* scr = (LAS float*)(F.lds + RING_OFF + F.wave * 16384);
    const int gw = F.vcu * NWAVES + F.wave, NGW = F.G * NWAVES;
    constexpr int I_IN = (D / 64) * (DIN / 32), I_OUT = (D / 64) * (D / 32), I_G = (D / 64) * (DFF / 32), I_DN = (DFF / 64) * (D / 32);
    constexpr int NITEMS = I_IN + I_OUT + 2 * I_G + I_DN;
    for (int it = gw; it < NITEMS; it += NGW) {
        int r = it;
        if (r < I_IN) { const int nblk = DIN / 32, kb = r / nblk, nb = r % nblk; p0_transpose_item(F.w_in, D, DIN, F.Win_t, 32 * nb, nullptr, scr, 64 * kb, 32 * nb, F.lane); continue; } r -= I_IN;
        if (r < I_OUT) { const int nblk = D / 32, kb = r / nblk, nb = r % nblk; p0_transpose_item(F.w_out, D, D, F.Wout_t, 32 * nb, nullptr, scr, 64 * kb, 32 * nb, F.lane); continue; } r -= I_OUT;
        if (r < 2 * I_G) { const int up = r >= I_G; if (up) r -= I_G; const int nblk = DFF / 32, kb = r / nblk, nb = r % nblk, n0 = 32 * nb;
            p0_transpose_item(up ? F.w_up : F.w_gate, D, DFF, F.Wgu_t, 256 * (n0 >> 7) + (n0 & 127) + (up ? 128 : 0), F.w_ffn, scr, 64 * kb, n0, F.lane); continue; } r -= 2 * I_G;
        { const int nblk = D / 32, kb = r / nblk, nb = r % nblk; p0_transpose_item(F.w_down, DFF, D, F.Wdn_t, 32 * nb, nullptr, scr, 64 * kb, 32 * nb, F.lane); }
    }
    for (int m = gw; m < M; m += NGW) {
        const GAS f32x4* xr = (const GAS f32x4*)(F.x + (size_t)m * D) + F.lane; const GAS f32x4* wr = (const GAS f32x4*)F.w_mix + F.lane;
        f32x4 v[8]; float s = 0.f;
#pragma unroll
        for (int j = 0; j < 8; ++j) { v[j] = xr[64 * j]; s += (v[j].x * v[j].x + v[j].y * v[j].y) + (v[j].z * v[j].z + v[j].w * v[j].w); }
        const float rstd = 1.0f / sqrtf(wave_sum(s) * (1.0f / D) + EPS);
        GAS unsigned long long* o8 = (GAS unsigned long long*)(F.XN + (size_t)m * D) + F.lane;
#pragma unroll
        for (int j = 0; j < 8; ++j) { const f32x4 w = wr[64 * j]; o8[64 * j] = (unsigned long long)pk2(v[j].x * rstd * w.x, v[j].y * rstd * w.y) | ((unsigned long long)pk2(v[j].z * rstd * w.z, v[j].w * rstd * w.w) << 32); }
    }
}

#define HP(col, h) (F.PROJ + (size_t)((col) / HD + (h)) * M * HD)
__device__ __forceinline__ void p2_attn_naive(Frame& F) {
    LAS float* qs = (LAS float*)(F.lds + RING_OFF + F.wave * 4096);
    LAS float* ps = qs + 128;
    const int gw = F.vcu * NWAVES + F.wave, NGW = F.G * NWAVES, lane = F.lane;
    for (int item = gw; item < BATCH * NH * SEQ; item += NGW) {
        const int bh = item >> 12, t = item & 4095, b = bh >> 3, h = bh & 7;
        const float slope = exp2f(-(float)(h + 1));
        const bf16* Qrow = HP(COL_QA, h) + (size_t)(b * SEQ + t) * HD;
        const bf16* Kb = HP(COL_KA, h) + (size_t)(b * SEQ) * HD;
        const bf16* Vb = HP(COL_VA, h) + (size_t)(b * SEQ) * HD;
        { const unsigned qq = *(const GAS unsigned*)(Qrow + 2 * lane); qs[2 * lane] = bflo(qq) * 0.08838834764831845f; qs[2 * lane + 1] = bfhi(qq) * 0.08838834764831845f; }
        LDS_WAIT();
        float sc[3][3]; float mx = -INFINITY;
#pragma unroll
        for (int p = 0; p < 3; ++p) { const int dil = 1 << (2 * p);
#pragma unroll
            for (int k = 0; k < 3; ++k) { const int idx = lane + 64 * k, j = idx - 64, s = t + j * dil; float v = -INFINITY;
                if (idx < 129 && s >= 0 && s < SEQ) { const GAS v4u* kr = (const GAS v4u*)(Kb + (size_t)s * HD); float dot = 0.f;
#pragma unroll 4
                    for (int c = 0; c < 16; ++c) { const v4u kk = kr[c]; const LAS float* q8 = qs + 8 * c;
                        dot += q8[0] * bflo(kk.x) + q8[1] * bfhi(kk.x) + q8[2] * bflo(kk.y) + q8[3] * bfhi(kk.y) + q8[4] * bflo(kk.z) + q8[5] * bfhi(kk.z) + q8[6] * bflo(kk.w) + q8[7] * bfhi(kk.w); }
                    v = dot - slope * (float)(dil * (j < 0 ? -j : j)); }
                sc[p][k] = v; mx = fmaxf(mx, v); } }
        mx = wave_max(mx);
        float l = 0.f;
#pragma unroll
        for (int p = 0; p < 3; ++p)
#pragma unroll
            for (int k = 0; k < 3; ++k) { const float e = __expf(sc[p][k] - mx); l += e; ps[p * 192 + lane + 64 * k] = e; }
        l = wave_sum(l);
        LDS_WAIT();
        float o0 = 0.f, o1 = 0.f;
#pragma unroll
        for (int p = 0; p < 3; ++p) { const int dil = 1 << (2 * p);
            for (int idx = 0; idx < 129; ++idx) { const int s = t + (idx - 64) * dil;
                if (s >= 0 && s < SEQ) { const float pv = ps[p * 192 + idx]; const unsigned vv = *(const GAS unsigned*)(Vb + (size_t)s * HD + 2 * lane); o0 += pv * bflo(vv); o1 += pv * bfhi(vv); } } }
        const float il = 1.0f / l;
        *(GAS unsigned*)(F.MIX + (size_t)(b * SEQ + t) * D + h * HD + 2 * lane) = pk2(o0 * il, o1 * il);
        LDS_WAIT();
    }
}
__device__ __forceinline__ void p2_r1_naive(Frame& F) {
    LAS float* Ks = (LAS float*)(F.lds + RING_OFF); LAS float* Vs = Ks + CH * HD;
    const int tid = F.tid;
    for (int item = F.vcu; item < BATCH * NH * NCH; item += F.G) {
        const int bh = item >> 5, c = item & 31, b = bh >> 3, h = bh & 7; const size_t row0 = (size_t)b * SEQ + c * CH;
        const bf16* Kg = HP(COL_KR, h) + row0 * HD; const bf16* Vg = HP(COL_VR, h) + row0 * HD;
        { const int row = tid >> 2, seg = tid & 3;
#pragma unroll
          for (int q = 0; q < 4; ++q) { const v4u kk = *(const GAS v4u*)(Kg + (size_t)row * HD + 32 * seg + 8 * q); const v4u vv = *(const GAS v4u*)(Vg + (size_t)row * HD + 32 * seg + 8 * q);
              LAS float* kd = Ks + row * HD + 32 * seg + 8 * q; LAS float* vd = Vs + row * HD + 32 * seg + 8 * q;
              kd[0] = bflo(kk.x); kd[1] = bfhi(kk.x); kd[2] = bflo(kk.y); kd[3] = bfhi(kk.y); kd[4] = bflo(kk.z); kd[5] = bfhi(kk.z); kd[6] = bflo(kk.w); kd[7] = bfhi(kk.w);
              vd[0] = bflo(vv.x); vd[1] = bfhi(vv.x); vd[2] = bflo(vv.y); vd[3] = bfhi(vv.y); vd[4] = bflo(vv.z); vd[5] = bfhi(vv.z); vd[6] = bflo(vv.w); vd[7] = bfhi(vv.w); } }
        __syncthreads();
        const float lgf = -__expf(F.decf[h]), lgb = -__expf(F.decb[h]);
        const int e = tid >> 2, dq = tid & 3;
        float af[32], ab[32];
#pragma unroll
        for (int i = 0; i < 32; ++i) { af[i] = 0.f; ab[i] = 0.f; }
        for (int j = 0; j < CH; ++j) { const float v = Vs[j * HD + e], vf = v * __expf(lgf * (float)(CH - 1 - j)), vb = v * __expf(lgb * (float)j);
            const LAS f32x4* k4 = (const LAS f32x4*)(Ks + j * HD + 32 * dq);
#pragma unroll
            for (int i = 0; i < 8; ++i) { const f32x4 k = k4[i];
                af[4 * i] += vf * k.x; af[4 * i + 1] += vf * k.y; af[4 * i + 2] += vf * k.z; af[4 * i + 3] += vf * k.w;
                ab[4 * i] += vb * k.x; ab[4 * i + 1] += vb * k.y; ab[4 * i + 2] += vb * k.z; ab[4 * i + 3] += vb * k.w; } }
        GAS f32x4* of = (GAS f32x4*)(F.STF + (size_t)item * HD * HD + e * HD + 32 * dq); GAS f32x4* ob = (GAS f32x4*)(F.STB + (size_t)item * HD * HD + e * HD + 32 * dq);
#pragma unroll
        for (int i = 0; i < 8; ++i) { of[i] = (f32x4){af[4 * i], af[4 * i + 1], af[4 * i + 2], af[4 * i + 3]}; ob[i] = (f32x4){ab[4 * i], ab[4 * i + 1], ab[4 * i + 2], ab[4 * i + 3]}; }
        __syncthreads();
    }
}
__device__ __forceinline__ bf16* sbf_row(bf16* proj, int slot, int e);
__device__ __forceinline__ void p3_scan(Frame& F) {
    const int gt = F.vcu * (NWAVES * 64) + F.tid, NT = F.G * NWAVES * 64;
    for (int idx = gt; idx < 2 * BATCH * NH * 4096; idx += NT) {
        const int dir = idx / (BATCH * NH * 4096), rem = idx % (BATCH * NH * 4096), bh = rem >> 12, q = rem & 4095, h = bh & 7;
        const float g = __expf(-__expf(dir ? F.decb[h] : F.decf[h]) * (float)CH);
        GAS f32x4* base = (GAS f32x4*)(dir ? F.STB : F.STF) + (size_t)bh * NCH * 4096 + q;
        f32x4 s = (f32x4){0.f, 0.f, 0.f, 0.f};
#pragma unroll 8
        for (int cc = 0; cc < NCH; ++cc) { const int c = dir ? NCH - 1 - cc : cc; const f32x4 t = base[(size_t)c * 4096];
#if R3_NAIVE
            base[(size_t)c * 4096] = s;
#else
            { unsigned long long o = (unsigned long long)pk2(s.x, s.y) | ((unsigned long long)pk2(s.z, s.w) << 32); *(GAS unsigned long long*)(sbf_row(F.PROJ, 2 * (bh * NCH + c) + dir, q >> 5) + 4 * (q & 31)) = o; }
#endif
            s = s * g + t; }
    }
}
__device__ __forceinline__ void p4_r3_naive(Frame& F) {
    LAS bf16* Qs = (LAS bf16*)(F.lds + RING_OFF); LAS bf16* KVs = Qs + CH * HD; LAS float* As = (LAS float*)(F.lds + RING_OFF + 65536);
    const int tid = F.tid; const float scale = 0.08838834764831845f;
    for (int item = F.vcu; item < BATCH * NH * NCH; item += F.G) {
        const int bh = item >> 5, c = item & 31, b = bh >> 3, h = bh & 7; const size_t row0 = (size_t)b * SEQ + c * CH;
        const bf16* Qg = HP(COL_QR, h) + row0 * HD; const bf16* Kg = HP(COL_KR, h) + row0 * HD;
        const bf16* Vg = HP(COL_VR, h) + row0 * HD; const bf16* Gg = HP(COL_GR, h) + row0 * HD;
        const float lgf = -__expf(F.decf[h]), lgb = -__expf(F.decb[h]);
        const int i = tid >> 2, part = tid & 3;
#pragma unroll
        for (int q = 0; q < 4; ++q) { *(LAS v4u*)(Qs + i * HD + 32 * part + 8 * q) = *(const GAS v4u*)(Qg + (size_t)i * HD + 32 * part + 8 * q);
                                      *(LAS v4u*)(KVs + i * HD + 32 * part + 8 * q) = *(const GAS v4u*)(Kg + (size_t)i * HD + 32 * part + 8 * q); }
        __syncthreads();
        for (int jj = 0; jj < 32; ++jj) { const int j = 32 * part + jj; float dot = 0.f;
#pragma unroll 4
            for (int c8 = 0; c8 < 16; ++c8) { const v4u qq = *(const LAS v4u*)(Qs + i * HD + 8 * c8), kk = *(const LAS v4u*)(KVs + j * HD + 8 * c8);
                dot += bflo(qq.x) * bflo(kk.x) + bfhi(qq.x) * bfhi(kk.x) + bflo(qq.y) * bflo(kk.y) + bfhi(qq.y) * bfhi(kk.y) + bflo(qq.z) * bflo(kk.z) + bfhi(qq.z) * bfhi(kk.z) + bflo(qq.w) * bflo(kk.w) + bfhi(qq.w) * bfhi(kk.w); }
            const float dec = (j <= i) ? __expf(lgf * (float)(i - j)) : __expf(lgb * (float)(j - i));
            As[i * CH + j] = dot * scale * dec; }
        __syncthreads();
#pragma unroll
        for (int q = 0; q < 4; ++q) *(LAS v4u*)(KVs + i * HD + 32 * part + 8 * q) = *(const GAS v4u*)(Vg + (size_t)i * HD + 32 * part + 8 * q);
        __syncthreads();
        const int e0 = 32 * part;
        float acc[32], accf[32], accb[32];
#pragma unroll
        for (int k = 0; k < 32; ++k) { acc[k] = 0.f; accf[k] = 0.f; accb[k] = 0.f; }
        for (int j = 0; j < CH; ++j) { const float a = As[i * CH + j];
#pragma unroll
            for (int q = 0; q < 4; ++q) { const v4u vv = *(const LAS v4u*)(KVs + j * HD + e0 + 8 * q);
                acc[8 * q] += a * bflo(vv.x); acc[8 * q + 1] += a * bfhi(vv.x); acc[8 * q + 2] += a * bflo(vv.y); acc[8 * q + 3] += a * bfhi(vv.y);
                acc[8 * q + 4] += a * bflo(vv.z); acc[8 * q + 5] += a * bfhi(vv.z); acc[8 * q + 6] += a * bflo(vv.w); acc[8 * q + 7] += a * bfhi(vv.w); } }
        const float* Sf = F.STF + (size_t)item * HD * HD; const float* Sb = F.STB + (size_t)item * HD * HD;
        for (int d4 = 0; d4 < HD; d4 += 4) { const unsigned long long qq = *(const LAS unsigned long long*)(Qs + i * HD + d4);
            const float q0 = bflo((unsigned)qq), q1 = bfhi((unsigned)qq), q2 = bflo((unsigned)(qq >> 32)), q3 = bfhi((unsigned)(qq >> 32));
#pragma unroll
            for (int k = 0; k < 32; ++k) { const f32x4 sf = *(const GAS f32x4*)(Sf + (size_t)(e0 + k) * HD + d4), sb = *(const GAS f32x4*)(Sb + (size_t)(e0 + k) * HD + d4);
                accf[k] += q0 * sf.x + q1 * sf.y + q2 * sf.z + q3 * sf.w; accb[k] += q0 * sb.x + q1 * sb.y + q2 * sb.z + q3 * sb.w; } }
        const float ff = __expf(lgf * (float)(i + 1)) * scale, fb = __expf(lgb * (float)(CH - i)) * scale;
        float ssq = 0.f;
#pragma unroll
        for (int k = 0; k < 32; ++k) { acc[k] += ff * accf[k] + fb * accb[k]; ssq += acc[k] * acc[k]; }
        ssq += __shfl_xor(ssq, 1); ssq += __shfl_xor(ssq, 2);
        const float rms = 1.0f / sqrtf(ssq * (1.0f / HD) + EPS);
        bf16* orow = F.MIX + (row0 + i) * D + DATT + h * HD + e0;
#pragma unroll
        for (int q = 0; q < 4; ++q) { const v4u gg = *(const GAS v4u*)(Gg + (size_t)i * HD + e0 + 8 * q); float r[8]; const float gv[8] = {bflo(gg.x), bfhi(gg.x), bflo(gg.y), bfhi(gg.y), bflo(gg.z), bfhi(gg.z), bflo(gg.w), bfhi(gg.w)};
#pragma unroll
            for (int k = 0; k < 8; ++k) { const float g = gv[k]; r[k] = acc[8 * q + k] * rms * F.w_retn[h * HD + e0 + 8 * q + k] * (g / (1.0f + __expf(-g))); }
            v4u o; o.x = pk2(r[0], r[1]); o.y = pk2(r[2], r[3]); o.z = pk2(r[4], r[5]); o.w = pk2(r[6], r[7]); *(GAS v4u*)(orow + 8 * q) = o; }
        __syncthreads();
    }
}
__device__ __forceinline__ void p8_final(Frame& F, bool dummy) {
    const int gw = F.vcu * NWAVES + F.wave, NGW = F.G * NWAVES;
    for (int m = gw; m < M; m += NGW) {
        GAS f32x4* xr = (GAS f32x4*)(F.out + (size_t)m * D) + F.lane; const GAS f32x4* wr = (const GAS f32x4*)F.w_fin + F.lane;
        f32x4 v[8]; float s = 0.f;
#pragma unroll
        for (int j = 0; j < 8; ++j) { v[j] = xr[64 * j]; s += (v[j].x * v[j].x + v[j].y * v[j].y) + (v[j].z * v[j].z + v[j].w * v[j].w); }
        const float rstd = 1.0f / sqrtf(wave_sum(s) * (1.0f / D) + EPS);
#pragma unroll
        for (int j = 0; j < 8; ++j) xr[64 * j] = dummy ? (v[j] + (rstd > 1e30f ? 1.0f : 0.0f)) : v[j] * rstd * wr[64 * j];
    }
}


typedef short bf16x8 __attribute__((ext_vector_type(8)));
typedef float f32x16 __attribute__((ext_vector_type(16)));
typedef unsigned u32x2 __attribute__((ext_vector_type(2)));
typedef float f32x2_t __attribute__((ext_vector_type(2))); typedef __bf16 bf16x2_t __attribute__((ext_vector_type(2)));
__device__ __forceinline__ unsigned cvtpk(float lo, float hi) { f32x2_t v = {lo, hi}; bf16x2_t b = __builtin_convertvector(v, bf16x2_t); return __builtin_bit_cast(unsigned, b); }
#define MFMA32(a, b, c) __builtin_amdgcn_mfma_f32_32x32x16_bf16((a), (b), (c), 0, 0, 0)
__device__ __forceinline__ f32x16 zero16() { f32x16 z;
#pragma unroll
    for (int i = 0; i < 16; ++i) z[i] = 0.f; return z; }
__device__ __forceinline__ bf16x8 pack8(const f32x16& x, int sp) {
    v4u p; p.x = cvtpk(x[8 * sp + 0], x[8 * sp + 1]); p.y = cvtpk(x[8 * sp + 2], x[8 * sp + 3]); p.z = cvtpk(x[8 * sp + 4], x[8 * sp + 5]); p.w = cvtpk(x[8 * sp + 6], x[8 * sp + 7]);
    return __builtin_bit_cast(bf16x8, p); }
__device__ __forceinline__ bf16x8 cat8(u32x2 lo, u32x2 hi) { v4u p; p.x = lo.x; p.y = lo.y; p.z = hi.x; p.w = hi.y; return __builtin_bit_cast(bf16x8, p); }
__device__ __forceinline__ unsigned elt16(const v4u& v, int i) { const unsigned w = v[i >> 1]; return (i & 1) ? (w >> 16) : (w & 0xffffu); }

__device__ __forceinline__ bf16* sbf_row(bf16* proj, int slot, int e) { return proj + ((size_t)slot * HD + e) * HD; }
__device__ __forceinline__ void p2_r1_mfma(Frame& F) {
    constexpr int P = 272;
    LAS unsigned char* KT = F.lds + RING_OFF; LAS unsigned char* VFT = KT + 128 * P; LAS unsigned char* VBT = VFT + 128 * P;
    const int w = F.wave;
    for (int item = F.vcu; item < BATCH * NH * NCH; item += F.G) {
        int tid = F.tid; asm volatile("" : "+v"(tid)); const int lane = tid & 63, r = lane & 31, hh = lane >> 5;
        const int bh = item >> 5, c = item & 31, b = bh >> 3, h = bh & 7; const size_t row0 = (size_t)b * SEQ + c * CH;
        const bf16* Kg = HP(COL_KR, h) + row0 * HD; const bf16* Vg = HP(COL_VR, h) + row0 * HD;
        const float lgf = -__expf(F.decf[h]), lgb = -__expf(F.decb[h]);
        {
            const int jg = tid & 31, dc = tid >> 5; v4u kr[4], vr[4]; float sf[4], sb[4];
#pragma unroll
            for (int q = 0; q < 4; ++q) { kr[q] = *(const GAS v4u*)(Kg + (size_t)(4 * jg + q) * HD + 8 * dc); vr[q] = *(const GAS v4u*)(Vg + (size_t)(4 * jg + q) * HD + 8 * dc);
                sf[q] = __expf(lgf * (float)(CH - 1 - (4 * jg + q))); sb[q] = __expf(lgb * (float)(4 * jg + q)); }
#pragma unroll
            for (int i = 0; i < 8; ++i) { const int off = (8 * dc + i) * P + 8 * jg;
                u32x2 kk; kk.x = elt16(kr[0], i) | (elt16(kr[1], i) << 16); kk.y = elt16(kr[2], i) | (elt16(kr[3], i) << 16); *(LAS u32x2*)(KT + off) = kk;
                const float v0 = __builtin_bit_cast(float, elt16(vr[0], i) << 16), v1 = __builtin_bit_cast(float, elt16(vr[1], i) << 16), v2 = __builtin_bit_cast(float, elt16(vr[2], i) << 16), v3 = __builtin_bit_cast(float, elt16(vr[3], i) << 16);
                u32x2 vf; vf.x = cvtpk(v0 * sf[0], v1 * sf[1]); vf.y = cvtpk(v2 * sf[2], v3 * sf[3]); *(LAS u32x2*)(VFT + off) = vf;
                u32x2 vb; vb.x = cvtpk(v0 * sb[0], v1 * sb[1]); vb.y = cvtpk(v2 * sb[2], v3 * sb[3]); *(LAS u32x2*)(VBT + off) = vb; }
        }
        __syncthreads();
        const int et = w & 3, dt0 = 2 * (w >> 2);
        f32x16 accf[2], accb[2]; accf[0] = zero16(); accf[1] = zero16(); accb[0] = zero16(); accb[1] = zero16();
#pragma unroll
        for (int s = 0; s < 8; ++s) {
            const bf16x8 af = *(const LAS bf16x8*)(VFT + (32 * et + r) * P + 32 * s + 16 * hh), ab = *(const LAS bf16x8*)(VBT + (32 * et + r) * P + 32 * s + 16 * hh);
#pragma unroll
            for (int t = 0; t < 2; ++t) { const bf16x8 bk = *(const LAS bf16x8*)(KT + (32 * (dt0 + t) + r) * P + 32 * s + 16 * hh);
                accf[t] = MFMA32(af, bk, accf[t]); accb[t] = MFMA32(ab, bk, accb[t]); }
        }
        float* of = F.STF + (size_t)item * HD * HD; float* ob = F.STB + (size_t)item * HD * HD;
#pragma unroll
        for (int t = 0; t < 2; ++t)
#pragma unroll
            for (int reg = 0; reg < 16; ++reg) { const int e = 32 * et + (reg & 3) + 8 * (reg >> 2) + 4 * hh, d = 32 * (dt0 + t) + r; of[e * HD + d] = accf[t][reg]; ob[e * HD + d] = accb[t][reg]; }
        __syncthreads();
    }
}
__device__ __forceinline__ void p4_r3_mfma(Frame& F) {
    constexpr int P = 264;
    LAS unsigned char* VT = F.lds + RING_OFF; LAS float* XS = (LAS float*)(F.lds + RING_OFF + 128 * P);
    const int w = F.wave, qt = w & 3, eh = w >> 2;
    const float scale = 0.08838834764831845f, L2E = 1.4426950408889634f;
    for (int item = F.vcu; item < BATCH * NH * NCH; item += F.G) {
        int tid = F.tid; asm volatile("" : "+v"(tid)); const int lane = tid & 63, r = lane & 31, hh = lane >> 5;
        const int bh = item >> 5, c = item & 31, b = bh >> 3, h = bh & 7; const size_t row0 = (size_t)b * SEQ + c * CH;
        const bf16* Qg = HP(COL_QR, h) + row0 * HD; const bf16* Kg = HP(COL_KR, h) + row0 * HD;
        const bf16* Vg = HP(COL_VR, h) + row0 * HD; const bf16* Gg = HP(COL_GR, h) + row0 * HD;
        const float lgf2 = -__expf(F.decf[h]) * L2E, lgb2 = -__expf(F.decb[h]) * L2E;
        {
            const int jg = tid & 31, dc = tid >> 5; v4u vr[4];
#pragma unroll
            for (int q = 0; q < 4; ++q) vr[q] = *(const GAS v4u*)(Vg + (size_t)(4 * jg + q) * HD + 8 * dc);
#pragma unroll
            for (int i = 0; i < 8; ++i) { u32x2 vv; vv.x = elt16(vr[0], i) | (elt16(vr[1], i) << 16); vv.y = elt16(vr[2], i) | (elt16(vr[3], i) << 16); *(LAS u32x2*)(VT + (8 * dc + i) * P + 8 * jg) = vv; }
        }
        const int iq = 32 * qt + r;
        bf16x8 qf[8];
#pragma unroll
        for (int s = 0; s < 8; ++s) qf[s] = *(const GAS bf16x8*)(Qg + (size_t)iq * HD + 64 * hh + 8 * s);
        f32x16 st[4];
#pragma unroll
        for (int kt = 0; kt < 4; ++kt) { st[kt] = zero16();
#pragma unroll
            for (int s = 0; s < 8; ++s) { const bf16x8 kf = *(const GAS bf16x8*)(Kg + (size_t)(32 * kt + r) * HD + 64 * hh + 8 * s); st[kt] = MFMA32(kf, qf[s], st[kt]); }
            __builtin_amdgcn_sched_barrier(0); }
        bf16x8 pf[4][2];
#pragma unroll
        for (int kt = 0; kt < 4; ++kt) {
#pragma unroll
            for (int reg = 0; reg < 16; ++reg) { const int j = 32 * kt + (reg & 3) + 8 * (reg >> 2) + 4 * hh, dj = iq - j;
                const float dec = __builtin_amdgcn_exp2f(dj >= 0 ? lgf2 * (float)dj : lgb2 * (float)(-dj)); st[kt][reg] *= scale * dec; }
            pf[kt][0] = pack8(st[kt], 0); pf[kt][1] = pack8(st[kt], 1); }
        const float ff = __builtin_amdgcn_exp2f(lgf2 * (float)(iq + 1)) * scale, fb = __builtin_amdgcn_exp2f(lgb2 * (float)(CH - iq)) * scale;
        f32x16 acc[2];
#pragma unroll
        for (int t = 0; t < 2; ++t) { const int e = 32 * (2 * eh + t) + r; f32x16 a1 = zero16(), a2 = zero16();
            const bf16* s1 = sbf_row(F.PROJ, 2 * item, e) + 64 * hh; const bf16* s2 = sbf_row(F.PROJ, 2 * item + 1, e) + 64 * hh;
#pragma unroll
            for (int s = 0; s < 8; ++s) { a1 = MFMA32(*(const GAS bf16x8*)(s1 + 8 * s), qf[s], a1); a2 = MFMA32(*(const GAS bf16x8*)(s2 + 8 * s), qf[s], a2); }
#pragma unroll
            for (int reg = 0; reg < 16; ++reg) acc[t][reg] = ff * a1[reg] + fb * a2[reg];
            __builtin_amdgcn_sched_barrier(0); }
        __syncthreads();
#pragma unroll
        for (int t = 0; t < 2; ++t) { const LAS unsigned char* vrow = VT + (32 * (2 * eh + t) + r) * P + 8 * hh;
#pragma unroll
            for (int kt = 0; kt < 4; ++kt)
#pragma unroll
                for (int sp = 0; sp < 2; ++sp) { const u32x2 lo = *(const LAS u32x2*)(vrow + 2 * (32 * kt + 16 * sp)), hi = *(const LAS u32x2*)(vrow + 2 * (32 * kt + 16 * sp + 8));
                    acc[t] = MFMA32(cat8(lo, hi), pf[kt][sp], acc[t]); } }
        float ssq = 0.f;
#pragma unroll
        for (int t = 0; t < 2; ++t)
#pragma unroll
            for (int reg = 0; reg < 16; ++reg) ssq += acc[t][reg] * acc[t][reg];
        ssq += __shfl_xor(ssq, 32);
        if (hh == 0) XS[w * 32 + r] = ssq;
        __syncthreads();
        const float rms = 1.0f / sqrtf((XS[w * 32 + r] + XS[(w ^ 4) * 32 + r]) * (1.0f / HD) + EPS);
#pragma unroll
        for (int t = 0; t < 2; ++t)
#pragma unroll
            for (int g = 0; g < 4; ++g) { const int e = 32 * (2 * eh + t) + 8 * g + 4 * hh;
                const u32x2 gg = *(const GAS u32x2*)(Gg + (size_t)iq * HD + e); const f32x4 wn = *(const GAS f32x4*)(F.w_retn + h * HD + e);
                const float g0 = bflo(gg.x), g1 = bfhi(gg.x), g2 = bflo(gg.y), g3 = bfhi(gg.y);
                const float o0 = acc[t][4 * g] * rms * wn.x * (g0 / (1.0f + __expf(-g0))), o1 = acc[t][4 * g + 1] * rms * wn.y * (g1 / (1.0f + __expf(-g1)));
                const float o2 = acc[t][4 * g + 2] * rms * wn.z * (g2 / (1.0f + __expf(-g2))), o3 = acc[t][4 * g + 3] * rms * wn.w * (g3 / (1.0f + __expf(-g3)));
                u32x2 o; o.x = cvtpk(o0, o1); o.y = cvtpk(o2, o3); *(GAS u32x2*)(F.MIX + (row0 + iq) * D + DATT + h * HD + e) = o; }
        __syncthreads();
    }
}
__device__ __forceinline__ void p2_attn_mfma(Frame& F) {
    constexpr int PK = 272, PV = 520;
    LAS unsigned char* KI = F.lds + RING_OFF; LAS unsigned char* VT = KI + 256 * PK;
    static_assert(256 * PK + 128 * PV <= RING_BYTES, "attention images fit the ring");
    const int w = F.wave, qt = w & 3, eh = w >> 2;
    const float scale = 0.08838834764831845f, L2E = 1.4426950408889634f;
    const int NU = BATCH * NH * 96;
    for (int n = F.vcu; n < NU; n += F.G) {
        int tid = F.tid; asm volatile("" : "+v"(tid)); const int lane = tid & 63, r = lane & 31, hh = lane >> 5;
        unsigned long long t0 = 0, t1 = 0; T_START(t0);
        int bh, u;
        if (F.G == 256) { const int it = n >> 8; bh = (F.vcu >> 5) + 8 * (it / 3); u = (F.vcu & 31) + 32 * (it % 3); }
        else { bh = n / 96; u = n % 96; }
        const int p = u >> 5, idx = u & 31, sh = 2 * p, dil = 1 << sh, nblk = 32 >> sh, cls = idx / nblk, l0 = 128 * (idx % nblk), L = SEQ >> sh;
        const int b = bh >> 3, h = bh & 7;
        const bf16* Qb = HP(COL_QA, h) + (size_t)(b * SEQ) * HD; const bf16* Kb = HP(COL_KA, h) + (size_t)(b * SEQ) * HD; const bf16* Vb = HP(COL_VA, h) + (size_t)(b * SEQ) * HD;
#pragma unroll
        for (int it = 0; it < 8; ++it) { const int pc = tid + 512 * it, row = pc >> 4, ch = pc & 15, lk = l0 - 64 + row;
            const int lkc = lk < 0 ? 0 : (lk >= L ? L - 1 : lk);
            *(LAS v4u*)(KI + row * PK + 16 * ch) = *(const GAS v4u*)(Kb + (size_t)(lkc * dil + cls) * HD + 8 * ch); }
#pragma unroll
        for (int it = 0; it < 2; ++it) { const int bid = tid + 512 * it, jg = bid & 63, dc = bid >> 6; v4u vr[4];
#pragma unroll
            for (int q = 0; q < 4; ++q) { const int lk = l0 - 64 + 4 * jg + q, lkc = lk < 0 ? 0 : (lk >= L ? L - 1 : lk); vr[q] = *(const GAS v4u*)(Vb + (size_t)(lkc * dil + cls) * HD + 8 * dc); }
#pragma unroll
            for (int i = 0; i < 8; ++i) { u32x2 vv; vv.x = elt16(vr[0], i) | (elt16(vr[1], i) << 16); vv.y = elt16(vr[2], i) | (elt16(vr[3], i) << 16); *(LAS u32x2*)(VT + (8 * dc + i) * PV + 8 * jg) = vv; } }
        const int lq = l0 + 32 * qt + r;
        const size_t qrow = (size_t)(lq * dil + cls);
        bf16x8 qf[8];
#pragma unroll
        for (int s = 0; s < 8; ++s) qf[s] = *(const GAS bf16x8*)(Qb + qrow * HD + 64 * hh + 8 * s);
        __syncthreads();
        if (PROBE_T == 1) T_ADD(F.tA, t0);
        T_START(t1);
        f32x16 st[5];
#pragma unroll
        for (int kt = 0; kt < 5; ++kt) { st[kt] = zero16(); const LAS unsigned char* krow = KI + (32 * qt + 32 * kt + r) * PK + 128 * hh;
#pragma unroll
            for (int s = 0; s < 8; ++s) st[kt] = MFMA32(*(const LAS bf16x8*)(krow + 16 * s), qf[s], st[kt]);
            __builtin_amdgcn_sched_barrier(0); }
        const float slope2 = exp2f(-(float)(h + 1)) * (float)dil * L2E, sc2 = scale * L2E;
        float mx = -INFINITY;
#pragma unroll
        for (int kt = 0; kt < 5; ++kt)
#pragma unroll
            for (int reg = 0; reg < 16; ++reg) { const int jl = 32 * kt + (reg & 3) + 8 * (reg >> 2) + 4 * hh, dist = r + 64 - jl, ad = dist < 0 ? -dist : dist, lk = l0 + 32 * qt - 64 + jl;
                const bool valid = (ad <= 64) && (lk >= 0) && (lk < L);
                const float s2 = valid ? st[kt][reg] * sc2 - slope2 * (float)ad : -INFINITY; st[kt][reg] = s2; mx = fmaxf(mx, s2); }
        mx = fmaxf(mx, __shfl_xor(mx, 32));
        if (PROBE_T == 3) { T_ADD(F.tA, t1); T_START(t1); }
        float l = 0.f;
#pragma unroll
        for (int kt = 0; kt < 5; ++kt)
#pragma unroll
            for (int reg = 0; reg < 16; ++reg) { const float e = __builtin_amdgcn_exp2f(st[kt][reg] - mx); st[kt][reg] = e; l += e; }
        l += __shfl_xor(l, 32);
        f32x16 acc[2]; acc[0] = zero16(); acc[1] = zero16();
#pragma unroll
        for (int kt = 0; kt < 5; ++kt)
#pragma unroll
            for (int sp = 0; sp < 2; ++sp) { const bf16x8 pfr = pack8(st[kt], sp);
#pragma unroll
                for (int t = 0; t < 2; ++t) { const LAS unsigned char* vrow = VT + (32 * (2 * eh + t) + r) * PV + 2 * (32 * qt + 32 * kt + 16 * sp + 4 * hh);
                    const u32x2 lo = *(const LAS u32x2*)(vrow), hi = *(const LAS u32x2*)(vrow + 16);
                    acc[t] = MFMA32(cat8(lo, hi), pfr, acc[t]); }
                __builtin_amdgcn_sched_barrier(0); }
        const float il = 1.0f / l; const size_t orow = (size_t)b * SEQ + qrow;
        bf16* ob = (p == 0) ? (F.MIX + orow * D + h * HD) : (F.XN + (size_t)(p - 1) * M * DATT + orow * DATT + h * HD);
#pragma unroll
        for (int t = 0; t < 2; ++t)
#pragma unroll
            for (int g = 0; g < 4; ++g) { const int e = 32 * (2 * eh + t) + 8 * g + 4 * hh; u32x2 o; o.x = cvtpk(acc[t][4 * g] * il, acc[t][4 * g + 1] * il); o.y = cvtpk(acc[t][4 * g + 2] * il, acc[t][4 * g + 3] * il); *(GAS u32x2*)(ob + e) = o; }
        if (eh == 0 && hh == 0) F.LSE[(size_t)p * M * NH + orow * NH + h] = (mx + __log2f(l)) * 0.6931471805599453f;
        __syncthreads();
        if (PROBE_T == 1) T_ADD(F.tB, t0);
        if (PROBE_T == 3) T_ADD(F.tB, t1);
    }
}
__device__ __forceinline__ void p3_merge(Frame& F) {
    const int gt = F.vcu * (NWAVES * 64) + F.tid, NT = F.G * NWAVES * 64;
    for (int idx = gt; idx < M * (DATT / 8); idx += NT) { const int row = idx >> 7, c8 = idx & 127, h = c8 >> 4;
        const float l1 = F.LSE[(size_t)row * NH + h], l4 = F.LSE[(size_t)M * NH + (size_t)row * NH + h], l16 = F.LSE[(size_t)2 * M * NH + (size_t)row * NH + h];
        const float mx = fmaxf(l1, fmaxf(l4, l16)); float w1 = __expf(l1 - mx), w4 = __expf(l4 - mx), w16 = __expf(l16 - mx); const float inv = 1.0f / (w1 + w4 + w16); w1 *= inv; w4 *= inv; w16 *= inv;
        GAS v4u* pm = (GAS v4u*)(F.MIX + (size_t)row * D + 8 * c8);
        const v4u a = *pm, bq = *(const GAS v4u*)(F.XN + (size_t)row * DATT + 8 * c8), cq = *(const GAS v4u*)(F.XN + (size_t)M * DATT + (size_t)row * DATT + 8 * c8);
        v4u o;
#pragma unroll
        for (int k = 0; k < 4; ++k) o[k] = cvtpk(w1 * bflo(a[k]) + w4 * bflo(bq[k]) + w16 * bflo(cq[k]), w1 * bfhi(a[k]) + w4 * bfhi(bq[k]) + w16 * bfhi(cq[k]));
        *pm = o; }
}
typedef short v4i16_t __attribute__((ext_vector_type(4)));
__device__ __forceinline__ unsigned swz16(unsigned row) { return ((row & 3u) << 2) | ((row >> 2) & 3u); }
struct AttnUnit { int b, h, p, dil, cls, l0, L; const bf16 *Qb, *Kb, *Vb; };
__device__ __forceinline__ AttnUnit attn_unit(const Frame& F, int n) {
    int bh, u;
    if (F.G == 256) { const int it = n >> 8; bh = (F.vcu >> 5) + 8 * (it / 3); u = (F.vcu & 31) + 32 * (it % 3); }
    else { bh = n / 96; u = n % 96; }
    AttnUnit U; U.p = u >> 5; const int idx = u & 31, sh = 2 * U.p, nblk = 32 >> sh; U.dil = 1 << sh; U.cls = idx / nblk; U.l0 = 128 * (idx % nblk); U.L = SEQ >> sh; U.b = bh >> 3; U.h = bh & 7;
    U.Qb = HP(COL_QA, U.h) + (size_t)(U.b * SEQ) * HD; U.Kb = HP(COL_KA, U.h) + (size_t)(U.b * SEQ) * HD; U.Vb = HP(COL_VA, U.h) + (size_t)(U.b * SEQ) * HD;
    return U;
}
__device__ __forceinline__ void attn_dma(LAS unsigned char* img, const bf16* Xb, const AttnUnit& U, int w, int lane) {
#pragma unroll
    for (int i = 0; i < 8; ++i) { const int pc = 8 * w + i, row = 4 * pc + (lane >> 4), ch = (lane & 15) ^ (int)swz16((unsigned)row);
        int lk = U.l0 - 64 + row; lk = lk < 0 ? 0 : (lk >= U.L ? U.L - 1 : lk);
        __builtin_amdgcn_global_load_lds((const unsigned*)(Xb + (size_t)(lk * U.dil + U.cls) * HD + 8 * ch), (LAS unsigned*)(img + pc * 1024), 16, 0, 0); }
}
__device__ __forceinline__ void p2_attn_dma(Frame& F) {
    LAS unsigned char* KI = F.lds + RING_OFF; LAS unsigned char* VI = KI + 65536;
    const int w = F.wave, qt = w & 3, eh = w >> 2;
    const float scale = 0.08838834764831845f, L2E = 1.4426950408889634f;
    const int NU = BATCH * NH * 96;
    int n = F.vcu; if (n >= NU) return;
    AttnUnit U = attn_unit(F, n);
    bf16x8 qf[8];
    { int tid = F.tid; asm volatile("" : "+v"(tid)); const int lane = tid & 63, r = lane & 31, hh = lane >> 5;
      attn_dma(KI, U.Kb, U, w, lane);
      const size_t qrow = (size_t)((U.l0 + 32 * qt + r) * U.dil + U.cls);
#pragma unroll
      for (int s = 0; s < 8; ++s) qf[s] = *(const GAS bf16x8*)(U.Qb + qrow * HD + 16 * s + 8 * hh); }
    for (;;) {
        int tid = F.tid; asm volatile("" : "+v"(tid)); const int lane = tid & 63, r = lane & 31, hh = lane >> 5;
        unsigned long long t0 = 0, t1 = 0; T_START(t0);
        __syncthreads();
        if (PROBE_T == 1) T_ADD(F.tA, t0);
        T_START(t1);
        attn_dma(VI, U.Vb, U, w, lane);
        const int lq0 = U.l0 + 32 * qt;
        f32x16 st[5];
        const unsigned swr = swz16((unsigned)r);
#pragma unroll
        for (int kt = 0; kt < 5; ++kt) { st[kt] = zero16(); const int lk0 = lq0 - 64 + 32 * kt;
            if (lk0 >= 0 && lk0 < U.L) { const LAS unsigned char* krow = KI + (32 * (qt + kt) + r) * 256;
#pragma unroll
                for (int s = 0; s < 8; ++s) st[kt] = MFMA32(*(const LAS bf16x8*)(krow + 16 * ((unsigned)(2 * s + hh) ^ swr)), qf[s], st[kt]); }
            __builtin_amdgcn_sched_barrier(0); }
        const float slope2 = exp2f(-(float)(U.h + 1)) * (float)U.dil * L2E, sc2 = scale * L2E, frr = (float)(r - 4 * hh);
        float mx = -INFINITY;
#pragma unroll
        for (int kt = 0; kt < 5; ++kt) { const int lk0 = lq0 - 64 + 32 * kt; const bool tin = (lk0 >= 0 && lk0 < U.L);
#pragma unroll
            for (int reg = 0; reg < 16; ++reg) { const float ad = fabsf(frr + (float)(64 - 32 * kt - ((reg & 3) + 8 * (reg >> 2))));
                float s2 = st[kt][reg] * sc2 - slope2 * ad;
                if (kt == 0 || kt == 4) s2 = (ad <= 64.0f) ? s2 : -INFINITY;
                s2 = tin ? s2 : -INFINITY;
                st[kt][reg] = s2; mx = fmaxf(mx, s2); } }
        mx = fmaxf(mx, __shfl_xor(mx, 32));
        if (PROBE_T == 3) { T_ADD(F.tA, t1); T_START(t1); }
        __syncthreads();
        const int nn = n + F.G; const bool has_next = nn < NU;
        AttnUnit Un = U; if (has_next) { Un = attn_unit(F, nn); attn_dma(KI, Un.Kb, Un, w, lane); }
        float l = 0.f;
#pragma unroll
        for (int kt = 0; kt < 5; ++kt)
#pragma unroll
            for (int reg = 0; reg < 16; ++reg) { const float e = __builtin_amdgcn_exp2f(st[kt][reg] - mx); st[kt][reg] = e; l += e; }
        l += __shfl_xor(l, 32);
        f32x16 acc[2]; acc[0] = zero16(); acc[1] = zero16();
        const int q4 = (lane & 15) >> 2, pp = lane & 3, blk = (lane >> 4) & 1;
        unsigned voff[2][2][2];
#pragma unroll
        for (int t2 = 0; t2 < 2; ++t2) { const unsigned rl = (unsigned)(4 * hh + 8 * t2 + q4), sw = swz16(rl);
#pragma unroll
            for (int t = 0; t < 2; ++t) { const unsigned chunk = (unsigned)(4 * (2 * eh + t) + 2 * blk + (pp >> 1)); voff[t2][t][0] = 256u * rl + 16u * (chunk ^ sw) + 8u * (unsigned)(pp & 1); voff[t2][t][1] = 0; } }
#pragma unroll
        for (int kt = 0; kt < 5; ++kt) { const int lk0 = lq0 - 64 + 32 * kt;
            if (lk0 >= 0 && lk0 < U.L) {
#pragma unroll
                for (int sp = 0; sp < 2; ++sp) { const bf16x8 pfr = pack8(st[kt], sp); const LAS unsigned char* vb = VI + (32 * (qt + kt) + 16 * sp) * 256;
#pragma unroll
                    for (int t = 0; t < 2; ++t) {
                        const v4i16_t lo = __builtin_amdgcn_ds_read_tr16_b64_v4i16((LAS v4i16_t*)(vb + voff[0][t][0])), hi = __builtin_amdgcn_ds_read_tr16_b64_v4i16((LAS v4i16_t*)(vb + voff[1][t][0]));
                        const bf16x8 vf = __builtin_shufflevector(lo, hi, 0, 1, 2, 3, 4, 5, 6, 7);
                        acc[t] = MFMA32(vf, pfr, acc[t]); } } }
            __builtin_amdgcn_sched_barrier(0); }
        const float il = 1.0f / l; const size_t qrow = (size_t)((lq0 + r) * U.dil + U.cls), orow = (size_t)U.b * SEQ + qrow;
        bf16* ob = (U.p == 0) ? (F.MIX + orow * D + U.h * HD) : (F.XN + (size_t)(U.p - 1) * M * DATT + orow * DATT + U.h * HD);
#pragma unroll
        for (int t = 0; t < 2; ++t)
#pragma unroll
            for (int g = 0; g < 4; ++g) { const int e = 32 * (2 * eh + t) + 8 * g + 4 * hh; u32x2 o; o.x = cvtpk(acc[t][4 * g] * il, acc[t][4 * g + 1] * il); o.y = cvtpk(acc[t][4 * g + 2] * il, acc[t][4 * g + 3] * il); __builtin_nontemporal_store(o, (GAS u32x2*)(ob + e)); }
        if (eh == 0 && hh == 0) F.LSE[(size_t)U.p * M * NH + orow * NH + U.h] = (mx + __log2f(l)) * 0.6931471805599453f;
        if (PROBE_T == 1) T_ADD(F.tB, t0);
        if (PROBE_T == 3) T_ADD(F.tB, t1);
        if (!has_next) break;
        U = Un; n = nn;
        { const size_t qr2 = (size_t)((U.l0 + 32 * qt + r) * U.dil + U.cls);
#pragma unroll
          for (int s = 0; s < 8; ++s) qf[s] = *(const GAS bf16x8*)(U.Qb + qr2 * HD + 16 * s + 8 * hh); }
    }
    __syncthreads();
}
struct Args { const float* in[12]; float* out; unsigned char* ws; int ph_lo, ph_hi, li, pad; };
__global__ void __launch_bounds__(NWAVES * 64, 2) mk_fwd(Args args) {
    extern __shared__ __attribute__((aligned(16))) unsigned char lds[];
    Frame F;
    F.lds = (LAS unsigned char*)lds;
    F.MISC = (volatile LAS unsigned*)(F.lds + MISC_OFF);
    F.tid = threadIdx.x; F.lane = F.tid & 63; F.wave = __builtin_amdgcn_readfirstlane(F.tid >> 6);
    F.G = gridDim.x; { const int bx = blockIdx.x; F.vcu = (F.G % 8 == 0) ? (bx % 8) * (F.G / 8) + bx / 8 : bx; }
    unsigned char* ws = args.ws;
    F.ctl = (gu32*)(ws + WS_CTL);
    F.x = args.in[0]; F.w_mix = args.in[1]; F.w_in = args.in[2]; F.decf = args.in[3]; F.decb = args.in[4]; F.w_retn = args.in[5]; F.w_out = args.in[6];
    F.w_ffn = args.in[7]; F.w_gate = args.in[8]; F.w_up = args.in[9]; F.w_down = args.in[10]; F.w_fin = args.in[11]; F.out = args.out;
    F.Win_t = (bf16*)(ws + WS_WIN); F.Wout_t = (bf16*)(ws + WS_WOUT); F.Wgu_t = (bf16*)(ws + WS_WGU); F.Wdn_t = (bf16*)(ws + WS_WDN);
    F.XN = (bf16*)(ws + WS_XN); F.PROJ = (bf16*)(ws + WS_PROJ); F.MIX = (bf16*)(ws + WS_MIX); F.ACT = (bf16*)(ws + WS_PROJ);
    F.STF = args.out; F.STB = args.out + ST_HALF; F.SS1 = (float*)(ws + WS_CTL + CTL_SS1); F.LSE = (float*)(ws + WS_LSE);
    F.tA = 0; F.tB = 0;
    for (int u = F.tid; u < (LDS_BYTES - LDSCTL_OFF) / 4; u += NWAVES * 64) ((LAS unsigned*)(F.lds + LDSCTL_OFF))[u] = 0u;
    __syncthreads();
    XcdBarrier bar; bar.bar = (unsigned*)(F.ctl + CW_BAR); bar.x = 0; bar.st = nullptr;
    if (N_LAUNCHES != PER_PHASE) bar = xcd_barrier_post((unsigned*)(F.ctl + CW_BAR), F.MISC + 8);
#define GRID_BAR(seam) do { if (N_LAUNCHES == PER_PHASE) { if (F.tid == 0) __hip_atomic_store(F.ctl + CW_TMO, 0xBADBA0u | (unsigned)(seam), RLX_AGENT); } else { xcd_barrier(bar); } } while (0)
    const int lo = args.ph_lo, hi = args.ph_hi;
#define IN(k) (lo <= (k) && (k) < hi)
#define BOTH(k) (IN(k) && IN((k) + 1))

#define REP(k) (((PROBE_REPEAT) >> (k)) & 1)
    if (IN(0)) { p0_prologue(F); if (REP(0)) p0_prologue(F); if (BOTH(0)) GRID_BAR(0); }
    if (IN(1)) {
        pg8::Gemm g{F.XN, F.Win_t, M, DIN, D}; pg8::StaticOrder S; S.init(M, DIN, F.G, (int)blockIdx.x);
        pg8::EpiHeads E{F.PROJ, M};
        for (int rep = 0; rep <= REP(1); ++rep) pg8::gemm_phase<pg8::EpiHeads, pg8::StaticOrder, true, true>(F.lds + RING_OFF, g, S, E);
        if (BOTH(1)) GRID_BAR(1);
    }
    if (IN(2)) {
        for (int rep = 0; rep <= REP(2); ++rep) {
#if ATTN_NAIVE
        p2_attn_naive(F); __syncthreads();
#elif ATTN_V1
        p2_attn_mfma(F);
#else
        p2_attn_dma(F);
#endif
#if R1_NAIVE
        p2_r1_naive(F);
#else
        { unsigned long long tR1 = 0; T_START(tR1); p2_r1_mfma(F); if (PROBE_T == 2) T_ADD(F.tA, tR1); }
#endif
        }
        if (BOTH(2)) GRID_BAR(2); }
    if (IN(3)) { p3_scan(F); if (REP(3)) p3_scan(F);
#if !ATTN_NAIVE
        p3_merge(F);
#endif
        if (BOTH(3)) GRID_BAR(3); }
    if (IN(4)) {
        for (int rep = 0; rep <= REP(4); ++rep) {
#if R3_NAIVE
        p4_r3_naive(F);
#else
        { unsigned long long tR3 = 0; T_START(tR3); p4_r3_mfma(F); if (PROBE_T == 2) T_ADD(F.tB, tR3); }
#endif
        }
        if (BOTH(4)) GRID_BAR(4); }
    if (IN(5)) {
        pg8::Gemm g{F.MIX, F.Wout_t, M, D, D}; pg8::StaticOrder S; S.init(M, D, F.G, (int)blockIdx.x);
        pg8::EpiResid E{F.x, F.out, F.XN, F.SS1, D};
        pg8::gemm_phase<pg8::EpiResid, pg8::StaticOrder, true, true>(F.lds + RING_OFF, g, S, E);
        if (REP(5)) { pg8::EpiResid E2{F.x, F.out, F.XN, nullptr, D}; pg8::gemm_phase<pg8::EpiResid, pg8::StaticOrder, true, true>(F.lds + RING_OFF, g, S, E2); }
        if (BOTH(5)) GRID_BAR(5);
    }
    if (IN(6)) {
        pg8::Gemm g{F.XN, F.Wgu_t, M, NGU, D}; pg8::StaticOrder S; S.init(M, NGU, F.G, (int)blockIdx.x);
        pg8::EpiSwiGLU E{F.ACT, DFF, F.SS1, 1.0f / D, EPS};
        for (int rep = 0; rep <= REP(6); ++rep) pg8::gemm_phase<pg8::EpiSwiGLU, pg8::StaticOrder, true, true>(F.lds + RING_OFF, g, S, E);
        if (BOTH(6)) GRID_BAR(6);
    }
    if (IN(7)) {
        pg8::Gemm g{F.ACT, F.Wdn_t, M, D, DFF}; pg8::StaticOrder S; S.init(M, D, F.G, (int)blockIdx.x);
        if (REP(7)) { pg8::EpiNull E0{}; pg8::gemm_phase<pg8::EpiNull, pg8::StaticOrder, true, true>(F.lds + RING_OFF, g, S, E0); }
        pg8::EpiResid E{F.out, F.out, nullptr, nullptr, D};
        pg8::gemm_phase<pg8::EpiResid, pg8::StaticOrder, true, true>(F.lds + RING_OFF, g, S, E);
        if (BOTH(7)) GRID_BAR(7);
    }
    if (IN(8)) { if (REP(8)) p8_final(F, true); p8_final(F, false); }
#if PROBE_T
    if (blockIdx.x == PROBE_BLOCK && F.tid == 0) {
        const unsigned long long t0 = RT(), span = (unsigned long long)PROBE_MULT * (PROBE_USE_B ? F.tB : F.tA);
        while (RT() - t0 < span) __builtin_amdgcn_s_sleep(8);
    }
#endif
#undef REP
#undef IN
#undef BOTH
}

extern "C" void kernel_launch(void* const* d_in, const int* in_sizes, int n_in, void* d_out, int out_size, void* d_ws, size_t ws_size, hipStream_t stream) {
    static int grid = 0;
    if (grid == 0) {
        if (n_in != 12 || in_sizes[0] != M * D || out_size != M * D || ws_size < WS_END) { fprintf(stderr, "kernel_launch: shape/workspace mismatch (n_in %d, in0 %d, out %d, ws %zu, need %zu)\n", n_in, n_in > 0 ? in_sizes[0] : -1, out_size, ws_size, (size_t)WS_END); grid = -1; return; }
        int dev = 0, cus = 0, per_cu = 0;
        if (hipGetDevice(&dev) != hipSuccess || hipDeviceGetAttribute(&cus, hipDeviceAttributeMultiprocessorCount, dev) != hipSuccess) { grid = -1; return; }
        if (hipFuncSetAttribute((const void*)mk_fwd, hipFuncAttributeMaxDynamicSharedMemorySize, LDS_BYTES) != hipSuccess) { fprintf(stderr, "kernel_launch: hipFuncSetAttribute failed\n"); grid = -1; return; }
        if (hipOccupancyMaxActiveBlocksPerMultiprocessor(&per_cu, (const void*)mk_fwd, NWAVES * 64, LDS_BYTES) != hipSuccess || per_cu < 1) fprintf(stderr, "kernel_launch: occupancy query reports %d\n", per_cu);
        (void)hipGetLastError();
        grid = cus;
    }
    if (grid < 0) return;
    (void)hipMemsetAsync((char*)d_ws + WS_CTL, 0, CTL_ZERO_BYTES, stream);
    Args a{};
    for (int i = 0; i < 12; ++i) a.in[i] = (const float*)d_in[i];
    a.out = (float*)d_out; a.ws = (unsigned char*)d_ws;
    if (N_LAUNCHES == 1) { a.ph_lo = 0; a.ph_hi = PER_PHASE; a.li = 0; hipLaunchKernelGGL(mk_fwd, dim3(grid), dim3(NWAVES * 64), LDS_BYTES, stream, a); }
    else for (int li = 0; li < PER_PHASE; ++li) { a.ph_lo = li; a.ph_hi = li + 1; a.li = li; hipLaunchKernelGGL(mk_fwd, dim3(grid), dim3(NWAVES * 64), LDS_BYTES, stream, a); }
}
```

```cpp
#include <hip/hip_runtime.h>
#include <cstdio>
#include <cstdint>
namespace pg8 {
#define PG8_LAS __attribute__((address_space(3)))
typedef unsigned short bf16_t;
typedef short bf16x8 __attribute__((ext_vector_type(8)));
typedef float f32x4 __attribute__((ext_vector_type(4)));
typedef unsigned u32x4 __attribute__((ext_vector_type(4)));
constexpr int BM = 256, BK = 64, HALF = 128, HTB = HALF * BK * 2  , STAGE_BYTES = 8 * HTB, NXCD = 8, WGM = 8;

__host__ __device__ __forceinline__ int lds_byte(int r, int c) { const int st = (r >> 4) * 2 + (c >> 5), rr = r & 15, cc = c & 31, ob = rr * 64 + cc * 2; return st * 1024 + (ob ^ (((ob >> 9) & 1) << 5)); }
__host__ __device__ __forceinline__ void stage_rc(int b, int& R, int& C) { const int st = b / 1024, sb = b % 1024, swz = sb ^ (((sb >> 9) & 1) << 5); R = (st >> 1) * 16 + swz / 64; C = (st & 1) * 32 + (swz % 64) / 2; }
__host__ __device__ __forceinline__ int perm32(int rho) { const int n = rho >> 4, i = rho & 15; return 8 * (i >> 2) + 4 * n + (i & 3); }

struct Unit { int pm, pn; };
struct Gemm { const bf16_t* A; const bf16_t* Bt; int M, N, K; };

struct StaticOrder {
    int nM, nN, nwg, G, c;
    __host__ __device__ void init(int M, int N, int G_, int c_) { nM = M / BM; nN = N / BM; nwg = nM * nN; G = G_; c = c_; }
    __host__ __device__ bool next(int i, Unit& u) const {
        const long L = (long)i * G + c; if (L >= nwg) return false;
        int wgid = (int)L; { const int q = nwg / NXCD, r = nwg % NXCD, xcd = wgid % NXCD, off = wgid / NXCD; wgid = (xcd < r ? xcd * (q + 1) : r * (q + 1) + (xcd - r) * q) + off; }
        const int nig = WGM * nN, gid = wgid / nig, fm = gid * WGM, gsz = (nM - fm) < WGM ? (nM - fm) : WGM;
        u.pm = fm + ((wgid % nig) % gsz); u.pn = (wgid % nig) / gsz; return true;
    }
    __device__ __forceinline__ void a_ready(const Unit&) const {}
    __device__ __forceinline__ void done(const Unit&) const {}
};

__device__ __forceinline__ unsigned cvt_pk_bf16(float lo, float hi) { unsigned r; asm volatile("v_cvt_pk_bf16_f32 %0, %1, %2" : "=v"(r) : "v"(lo), "v"(hi)); return r; }
typedef float f32x2 __attribute__((ext_vector_type(2)));
__device__ __forceinline__ f32x2 gelu_pk(f32x2 v) {
    const f32x2 av = __builtin_elementwise_abs(v), d = av * 0.2316418882f + 1.0f;
    f32x2 t; t.x = __builtin_amdgcn_rcpf(d.x); t.y = __builtin_amdgcn_rcpf(d.y);
    f32x2 q = t * 0.5307027145f + (-0.7265760135f); q = q * t + 0.7107068705f; q = q * t + (-0.142248368f); q = q * t + 0.127414796f; q = q * t;
    const f32x2 s = (v * v) * (-0.72134752044f);
    f32x2 e; e.x = __builtin_amdgcn_exp2f(s.x); e.y = __builtin_amdgcn_exp2f(s.y);
    const f32x2 m = v * (q * e), r = v - m;
    f32x2 o; o.x = v.x < 0.f ? m.x : r.x; o.y = v.y < 0.f ? m.y : r.y; return o;
}

template <int ACT  > struct EpiBf16 {
    static constexpr bool PERM = true, AFTER_DRAIN = false; static_assert(ACT == 0 || ACT == 1, "EpiBf16: ACT is 0 (none) or 1 (gelu_pk)");
    bf16_t* O; int ldc; const float* bias; int split_cols; size_t split_stride; float scale0;
    __device__ __forceinline__ void operator()(const f32x4 (&acc)[2][2][4][2], const Unit& u, int wr, int wc, int fr, int fq) const {
        const int row0 = u.pm * BM + wr * 64 + fr; int colt = u.pn * BM; bf16_t* base = O;
        float sc = 1.f; if (split_cols) { const int t = colt / split_cols; base += (size_t)t * split_stride; colt -= t * split_cols; if (t == 0) sc = scale0; }
        const int col0 = colt + wc * 32 + 8 * fq, bcol0 = u.pn * BM + wc * 32 + 8 * fq;
        f32x4 bv[2][2];
#pragma unroll
        for (int bj = 0; bj < 2; ++bj)
#pragma unroll
            for (int n = 0; n < 2; ++n) bv[bj][n] = bias ? *(const f32x4*)(bias + bcol0 + bj * HALF + 4 * n) : (f32x4){0.f, 0.f, 0.f, 0.f};
#pragma unroll
        for (int ai = 0; ai < 2; ++ai)
#pragma unroll
            for (int m = 0; m < 4; ++m) { bf16_t* rowp = base + (size_t)(row0 + ai * HALF + m * 16) * ldc + col0;
#pragma unroll
                for (int bj = 0; bj < 2; ++bj) { f32x4 v0 = acc[ai][bj][m][0] + bv[bj][0], v1 = acc[ai][bj][m][1] + bv[bj][1];
                    if (ACT == 1) { f32x2 a = gelu_pk((f32x2){v0[0], v0[1]}), b = gelu_pk((f32x2){v0[2], v0[3]}), c = gelu_pk((f32x2){v1[0], v1[1]}), d = gelu_pk((f32x2){v1[2], v1[3]});
                        v0 = (f32x4){a.x, a.y, b.x, b.y}; v1 = (f32x4){c.x, c.y, d.x, d.y}; }
                    v0 = v0 * sc; v1 = v1 * sc; u32x4 w; w.x = cvt_pk_bf16(v0[0], v0[1]); w.y = cvt_pk_bf16(v0[2], v0[3]); w.z = cvt_pk_bf16(v1[0], v1[1]); w.w = cvt_pk_bf16(v1[2], v1[3]);
                    *(u32x4*)(rowp + bj * HALF) = w; } }
    }
};
struct EpiResid {
    static constexpr bool PERM = true, AFTER_DRAIN = false;
    const float* base; float* out; bf16_t* hb; float* ss; int ldc;
    __device__ __forceinline__ void operator()(const f32x4 (&acc)[2][2][4][2], const Unit& u, int wr, int wc, int fr, int fq) const {
        const int row0 = u.pm * BM + wr * 64 + fr, col0 = u.pn * BM + wc * 32 + 8 * fq;
#pragma unroll
        for (int ai = 0; ai < 2; ++ai)
#pragma unroll
            for (int m = 0; m < 4; ++m) { const int row = row0 + ai * HALF + m * 16; const size_t off = (size_t)row * ldc + col0; float s = 0.f;
#pragma unroll
                for (int bj = 0; bj < 2; ++bj) {
                    const f32x4 b0 = *(const f32x4*)(base + off + bj * HALF), b1 = *(const f32x4*)(base + off + bj * HALF + 4);
                    const f32x4 v0 = acc[ai][bj][m][0] + b0, v1 = acc[ai][bj][m][1] + b1;
                    *(f32x4*)(out + off + bj * HALF) = v0; *(f32x4*)(out + off + bj * HALF + 4) = v1;
                    if (hb) { u32x4 w; w.x = cvt_pk_bf16(v0[0], v0[1]); w.y = cvt_pk_bf16(v0[2], v0[3]); w.z = cvt_pk_bf16(v1[0], v1[1]); w.w = cvt_pk_bf16(v1[2], v1[3]); *(u32x4*)(hb + off + bj * HALF) = w; }
                    s += (v0[0] * v0[0] + v0[1] * v0[1]) + (v0[2] * v0[2] + v0[3] * v0[3]) + (v1[0] * v1[0] + v1[1] * v1[1]) + (v1[2] * v1[2] + v1[3] * v1[3]);
                }
                if (ss) { s += __shfl_xor(s, 16); s += __shfl_xor(s, 32); if (fq == 0) (void)__hip_atomic_fetch_add(ss + row, s, __ATOMIC_RELAXED, __HIP_MEMORY_SCOPE_AGENT); }
                asm volatile("" ::: "memory"); }
    }
};
struct EpiSwiGLU {
    static constexpr bool PERM = true, AFTER_DRAIN = false;
    bf16_t* O; int ldc; const float* ss; float inv_d, eps;
    __device__ __forceinline__ void operator()(const f32x4 (&acc)[2][2][4][2], const Unit& u, int wr, int wc, int fr, int fq) const {
        const int row0 = u.pm * BM + wr * 64 + fr, col0 = u.pn * HALF + wc * 32 + 8 * fq;
#pragma unroll
        for (int ai = 0; ai < 2; ++ai)
#pragma unroll
            for (int m = 0; m < 4; ++m) { const int row = row0 + ai * HALF + m * 16; const float rstd = __builtin_amdgcn_rsqf(ss[row] * inv_d + eps);
                float a[8];
#pragma unroll
                for (int n = 0; n < 2; ++n)
#pragma unroll
                    for (int i = 0; i < 4; ++i) { const float g = acc[ai][0][m][n][i] * rstd, up = acc[ai][1][m][n][i] * rstd;
                        a[4 * n + i] = g * __builtin_amdgcn_rcpf(1.0f + __builtin_amdgcn_exp2f(-1.4426950408889634f * g)) * up; }
                u32x4 w; w.x = cvt_pk_bf16(a[0], a[1]); w.y = cvt_pk_bf16(a[2], a[3]); w.z = cvt_pk_bf16(a[4], a[5]); w.w = cvt_pk_bf16(a[6], a[7]);
                *(u32x4*)(O + (size_t)row * ldc + col0) = w; }
    }
};

struct EpiHeads {
    static constexpr bool PERM = true, AFTER_DRAIN = false;
    bf16_t* O; int Mrows;
    __device__ __forceinline__ void operator()(const f32x4 (&acc)[2][2][4][2], const Unit& u, int wr, int wc, int fr, int fq) const {
        const int row0 = u.pm * BM + wr * 64 + fr, col = wc * 32 + 8 * fq;
#pragma unroll
        for (int bj = 0; bj < 2; ++bj) { bf16_t* base = O + (size_t)(u.pn * 2 + bj) * Mrows * HALF + col;
#pragma unroll
            for (int ai = 0; ai < 2; ++ai)
#pragma unroll
                for (int m = 0; m < 4; ++m) { const f32x4 v0 = acc[ai][bj][m][0], v1 = acc[ai][bj][m][1];
                    u32x4 w; w.x = cvt_pk_bf16(v0[0], v0[1]); w.y = cvt_pk_bf16(v0[2], v0[3]); w.z = cvt_pk_bf16(v1[0], v1[1]); w.w = cvt_pk_bf16(v1[2], v1[3]);
                    *(u32x4*)(base + (size_t)(row0 + ai * HALF + m * 16) * HALF) = w; } }
    }
};
struct EpiNull {
    static constexpr bool PERM = true, AFTER_DRAIN = false;
    __device__ __forceinline__ void operator()(const f32x4 (&acc)[2][2][4][2], const Unit&, int, int, int, int) const {
#pragma unroll
        for (int ai = 0; ai < 2; ++ai)
#pragma unroll
            for (int bj = 0; bj < 2; ++bj)
#pragma unroll
                for (int m = 0; m < 4; ++m)
#pragma unroll
                    for (int n = 0; n < 2; ++n) asm volatile("" :: "v"(acc[ai][bj][m][n]));
    }
};

template <class Epi, class Sched, bool ALIGN_EPI = false, bool SP2 = false>
__device__ __forceinline__ void gemm_phase(PG8_LAS unsigned char* lds, const Gemm g, const Sched& S, const Epi& E) {
    int tid_ = threadIdx.x; asm volatile("" : "+v"(tid_));
    const int tid = tid_, wid = __builtin_amdgcn_readfirstlane(tid >> 6), lane = tid & 63, wr = wid >> 2, wc = wid & 3, fr = lane & 15, fq = lane >> 4;
    const int K = g.K, nt = K / BK;
    unsigned voffA[2], voffB[2];
#pragma unroll
    for (int i = 0; i < 2; ++i) { int R, C; stage_rc(tid * 16 + i * 8192, R, C); const int Rb = Epi::PERM ? ((R & ~31) + perm32(R & 31)) : R;
        voffA[i] = (unsigned)(R * K + C) * 2u; voffB[i] = (unsigned)(Rb * K + C) * 2u; }
    const size_t kstep = (size_t)(BK * 2);
    const size_t hstep = (size_t)HALF * K * 2;
    const size_t tstep = 2 * hstep;
    const unsigned ldsw = (unsigned)wid * 1024u;
    const int aoff = lds_byte(wr * 64 + fr, fq * 8), boff = lds_byte(wc * 32 + fr, fq * 8);
#define PG8_SA(b, h) (((b) * 2 + (h)) * HTB)
#define PG8_SB(b, h) ((4 + (b) * 2 + (h)) * HTB)
#define PG8_STAGE(bufoff, gbase, voff) do { _Pragma("unroll") for (int _i = 0; _i < 2; ++_i) \
        __builtin_amdgcn_global_load_lds((const unsigned*)((const char*)(gbase) + (voff)[_i]), (PG8_LAS unsigned*)(lds + (bufoff) + ldsw + _i * 8192), 16, 0, 0); } while (0)
#define PG8_LDA(dst, b, h) do { _Pragma("unroll") for (int m = 0; m < 4; ++m) _Pragma("unroll") for (int k = 0; k < 2; ++k) dst[m][k] = *(const PG8_LAS bf16x8*)(lds + PG8_SA(b, h) + aoff + m * 2048 + k * 1024); } while (0)
#define PG8_LDB(dst, b, h) do { _Pragma("unroll") for (int n = 0; n < 2; ++n) _Pragma("unroll") for (int k = 0; k < 2; ++k) dst[n][k] = *(const PG8_LAS bf16x8*)(lds + PG8_SB(b, h) + boff + n * 2048 + k * 1024); } while (0)
#define PG8_MMA(ai, bj, At, Bt) do { __builtin_amdgcn_s_setprio(1); _Pragma("unroll") for (int m = 0; m < 4; ++m) _Pragma("unroll") for (int n = 0; n < 2; ++n) _Pragma("unroll") for (int k = 0; k < 2; ++k) \
        acc[ai][bj][m][n] = __builtin_amdgcn_mfma_f32_16x16x32_bf16(Bt[n][k], At[m][k], acc[ai][bj][m][n], 0, 0, 0); __builtin_amdgcn_s_setprio(0); } while (0)
#define PG8_WAIT_V(n) asm volatile("s_waitcnt vmcnt(" #n ")" ::: "memory")
#define PG8_WAIT_L(n) asm volatile("s_waitcnt lgkmcnt(" #n ")" ::: "memory")
#define PG8_BAR __builtin_amdgcn_s_barrier()
#define PG8_SCHED __builtin_amdgcn_sched_barrier(0)
    Unit cur, nxt; int ui = 0;
    if (!S.next(0, cur)) return;
    f32x4 acc[2][2][4][2];
#pragma unroll
    for (int a = 0; a < 2; ++a)
#pragma unroll
        for (int b = 0; b < 2; ++b)
#pragma unroll
            for (int m = 0; m < 4; ++m)
#pragma unroll
                for (int n = 0; n < 2; ++n) acc[a][b][m][n] = (f32x4){0.f, 0.f, 0.f, 0.f};
    bf16x8 At[4][2], B0[2][2], B1[2][2];
    const char* cA = (const char*)g.A + (size_t)cur.pm * tstep; const char* cB = (const char*)g.Bt + (size_t)cur.pn * tstep;
    S.a_ready(cur);
    if constexpr (SP2) {
        PG8_STAGE(PG8_SB(0, 0), cB, voffB); PG8_STAGE(PG8_SB(0, 1), cB + hstep, voffB); PG8_STAGE(PG8_SA(0, 0), cA, voffA); PG8_STAGE(PG8_SA(0, 1), cA + hstep, voffA);
        if (wr == 1) PG8_BAR;
        PG8_WAIT_V(2); PG8_BAR;
        PG8_STAGE(PG8_SB(1, 0), cB + kstep, voffB); PG8_STAGE(PG8_SA(1, 0), cA + kstep, voffA); PG8_STAGE(PG8_SB(1, 1), cB + hstep + kstep, voffB);
        PG8_WAIT_V(6); PG8_BAR;
    } else {
        PG8_STAGE(PG8_SB(0, 0), cB, voffB); PG8_STAGE(PG8_SA(0, 0), cA, voffA); PG8_STAGE(PG8_SB(0, 1), cB + hstep, voffB); PG8_STAGE(PG8_SA(0, 1), cA + hstep, voffA);
        if (wr == 1) PG8_BAR;
        PG8_WAIT_V(4); PG8_BAR;
        PG8_STAGE(PG8_SB(1, 0), cB + kstep, voffB); PG8_STAGE(PG8_SA(1, 0), cA + kstep, voffA); PG8_STAGE(PG8_SB(1, 1), cB + hstep + kstep, voffB);
        PG8_WAIT_V(6); PG8_BAR;
    }
    for (;;) {
        const bool has_next = S.next(ui + 1, nxt);
        const char* nA = has_next ? (const char*)g.A + (size_t)nxt.pm * tstep : cA; const char* nB = has_next ? (const char*)g.Bt + (size_t)nxt.pn * tstep : cB;
        for (int t = 0; t < nt; t += 2) {
            const bool last = (t == nt - 2);
            const char* a1 = cA + (size_t)(t + 1) * kstep;
            const char* a2 = last ? nA : cA + (size_t)(t + 2) * kstep; const char* b2 = last ? nB : cB + (size_t)(t + 2) * kstep;
            const char* a3 = a2 + kstep; const char* b3 = b2 + kstep;
            if (last && has_next) S.a_ready(nxt);
            if constexpr (SP2) {
            PG8_LDB(B0, 0, 0); PG8_LDB(B1, 0, 1); PG8_SCHED; PG8_LDA(At, 0, 0); PG8_STAGE(PG8_SA(1, 1), a1 + hstep, voffA);
            PG8_WAIT_V(8); PG8_WAIT_L(0); PG8_BAR; PG8_MMA(0, 0, At, B0); PG8_MMA(0, 1, At, B1); PG8_BAR; PG8_SCHED;
            PG8_LDA(At, 0, 1); PG8_STAGE(PG8_SB(0, 0), b2, voffB); PG8_STAGE(PG8_SB(0, 1), b2 + hstep, voffB); PG8_STAGE(PG8_SA(0, 0), a2, voffA);
            PG8_WAIT_V(8); PG8_WAIT_L(0); PG8_BAR; PG8_MMA(1, 0, At, B0); PG8_MMA(1, 1, At, B1); PG8_BAR; PG8_SCHED;
            PG8_LDB(B0, 1, 0); PG8_LDB(B1, 1, 1); PG8_SCHED; PG8_LDA(At, 1, 0); PG8_STAGE(PG8_SA(0, 1), a2 + hstep, voffA);
            PG8_WAIT_V(8); PG8_WAIT_L(0); PG8_BAR; PG8_MMA(0, 0, At, B0); PG8_MMA(0, 1, At, B1); PG8_BAR; PG8_SCHED;
            PG8_LDA(At, 1, 1); PG8_STAGE(PG8_SB(1, 0), b3, voffB); PG8_STAGE(PG8_SB(1, 1), b3 + hstep, voffB); PG8_STAGE(PG8_SA(1, 0), a3, voffA);
            PG8_WAIT_V(8); PG8_WAIT_L(0); PG8_BAR; PG8_MMA(1, 0, At, B0); PG8_MMA(1, 1, At, B1); PG8_BAR; PG8_SCHED;
            } else {
            PG8_LDB(B0, 0, 0); PG8_SCHED; PG8_LDA(At, 0, 0); PG8_STAGE(PG8_SA(1, 1), a1 + hstep, voffA);
            PG8_WAIT_L(8); PG8_BAR; PG8_WAIT_L(0); PG8_MMA(0, 0, At, B0); PG8_BAR; PG8_SCHED;
            PG8_LDB(B1, 0, 1); PG8_STAGE(PG8_SB(0, 0), b2, voffB);
            PG8_BAR; PG8_WAIT_L(0); PG8_MMA(0, 1, At, B1); PG8_BAR;
            PG8_LDA(At, 0, 1); PG8_STAGE(PG8_SA(0, 0), a2, voffA);
            PG8_BAR; PG8_WAIT_L(0); PG8_MMA(1, 0, At, B0); PG8_BAR; PG8_SCHED;
            PG8_STAGE(PG8_SB(0, 1), b2 + hstep, voffB);
            PG8_WAIT_V(6); PG8_BAR; PG8_MMA(1, 1, At, B1); PG8_BAR;
            PG8_LDB(B0, 1, 0); PG8_SCHED; PG8_LDA(At, 1, 0); PG8_STAGE(PG8_SA(0, 1), a2 + hstep, voffA);
            PG8_WAIT_L(8); PG8_BAR; PG8_WAIT_L(0); PG8_MMA(0, 0, At, B0); PG8_BAR; PG8_SCHED;
            PG8_LDB(B1, 1, 1); PG8_STAGE(PG8_SB(1, 0), b3, voffB);
            PG8_BAR; PG8_WAIT_L(0); PG8_MMA(0, 1, At, B1); PG8_BAR;
            PG8_LDA(At, 1, 1); PG8_STAGE(PG8_SA(1, 0), a3, voffA);
            PG8_BAR; PG8_WAIT_L(0); PG8_MMA(1, 0, At, B0); PG8_BAR; PG8_SCHED;
            PG8_STAGE(PG8_SB(1, 1), b3 + hstep, voffB);
            PG8_WAIT_V(6); PG8_BAR; PG8_MMA(1, 1, At, B1); PG8_BAR;
            }
        }
        if constexpr (ALIGN_EPI) { if (wr == 0) PG8_BAR; }
        if constexpr (!Epi::AFTER_DRAIN) { E(acc, cur, wr, wc, fr, fq); S.done(cur); }
        if (!has_next) break;
#pragma unroll
        for (int a = 0; a < 2; ++a)
#pragma unroll
            for (int b = 0; b < 2; ++b)
#pragma unroll
                for (int m = 0; m < 4; ++m)
#pragma unroll
                    for (int n = 0; n < 2; ++n) acc[a][b][m][n] = (f32x4){0.f, 0.f, 0.f, 0.f};
        cur = nxt; cA = nA; cB = nB; ++ui;
        if constexpr (ALIGN_EPI) { if (wr == 1) PG8_BAR; }
    }
    PG8_WAIT_V(0);
    if constexpr (!ALIGN_EPI) { if (wr == 0) PG8_BAR; }
    PG8_BAR;
    if constexpr (Epi::AFTER_DRAIN) { E.fused(acc, cur, wr, wc, fr, fq, lds, wid, lane); S.done(cur); }
#undef PG8_SA
#undef PG8_SB
#undef PG8_STAGE
#undef PG8_LDA
#undef PG8_LDB
#undef PG8_MMA
#undef PG8_WAIT_V
#undef PG8_WAIT_L
#undef PG8_BAR
#undef PG8_SCHED
}
}

constexpr int NWAVES = 8;
#ifndef ATTN_NAIVE
#define ATTN_NAIVE 0
#endif
#ifndef ATTN_V1
#define ATTN_V1 0
#endif
#ifndef R1_NAIVE
#define R1_NAIVE 0
#endif
#ifndef R3_NAIVE
#define R3_NAIVE 0
#endif
#ifndef PROBE_REPEAT
#define PROBE_REPEAT 0
#endif
#ifndef PROBE_T
#define PROBE_T 0
#endif
#ifndef PROBE_MULT
#define PROBE_MULT 16
#endif
#ifndef PROBE_USE_B
#define PROBE_USE_B 0
#endif
#ifndef PROBE_BLOCK
#define PROBE_BLOCK 0
#endif
#ifndef MK_N_LAUNCHES
#define MK_N_LAUNCHES 1
#endif
constexpr int PER_PHASE = 9;
constexpr int N_LAUNCHES = MK_N_LAUNCHES;

constexpr int BATCH = 4, SEQ = 4096, D = 2048, M = BATCH * SEQ, HD = 128, NH = 8, DATT = 1024, DRET = 1024, DIN = 7168, DFF = 5632, NGU = 2 * DFF, CH = 128, NCH = SEQ / CH;
constexpr float EPS = 1e-6f;
constexpr int COL_QA = 0, COL_KA = 1024, COL_VA = 2048, COL_QR = 3072, COL_KR = 4096, COL_VR = 5120, COL_GR = 6144;

constexpr size_t MiB = 1u << 20;
constexpr size_t WS_CTL = 0, CTL_ZERO_BYTES = 1 * MiB;
constexpr size_t WS_WIN = 1 * MiB, WS_WOUT = 29 * MiB, WS_WGU = 37 * MiB, WS_WDN = 81 * MiB;
constexpr size_t WS_LSE = 103 * MiB;
constexpr size_t WS_XN = 105 * MiB;
constexpr size_t WS_PROJ = 169 * MiB;
constexpr size_t WS_MIX = 393 * MiB;
constexpr size_t WS_END = 457 * MiB;
static_assert(WS_WIN + (size_t)DIN * D * 2 <= WS_WOUT && WS_WOUT + (size_t)D * D * 2 <= WS_WGU && WS_WGU + (size_t)NGU * D * 2 <= WS_WDN && WS_WDN + (size_t)D * DFF * 2 <= WS_LSE, "weight map");
static_assert(WS_XN + (size_t)M * D * 2 <= WS_PROJ && WS_PROJ + (size_t)M * DIN * 2 <= WS_MIX && WS_MIX + (size_t)M * D * 2 <= WS_END, "activation map");
constexpr int CW_TMO = 0, CW_CODE = 1, CW_BAR = 4096;
constexpr size_t CTL_SS1 = 256 * 1024;
constexpr size_t ST_HALF = (size_t)BATCH * NH * NCH * HD * HD;

constexpr int RING_OFF = 0, RING_BYTES = 143360;
constexpr int LDSCTL_OFF = RING_BYTES, MISC_OFF = LDSCTL_OFF + 320;
constexpr int LDS_BYTES = 147456;
static_assert(MISC_OFF + 128 <= LDS_BYTES, "LDS map");

#define GAS __attribute__((address_space(1)))
#define LAS __attribute__((address_space(3)))
typedef unsigned short bf16;
typedef unsigned v4u __attribute__((ext_vector_type(4)));
typedef float f32x4 __attribute__((ext_vector_type(4)));
typedef GAS unsigned gu32;
#define RLX_AGENT __ATOMIC_RELAXED, __HIP_MEMORY_SCOPE_AGENT
#define LDS_WAIT() asm volatile("s_waitcnt lgkmcnt(0)" ::: "memory")
#define VM_WAIT() asm volatile("s_waitcnt vmcnt(0)" ::: "memory")
__device__ __forceinline__ unsigned f2bf(float f) { unsigned u = __builtin_bit_cast(unsigned, f); return (u + 0x7fffu + ((u >> 16) & 1u)) >> 16; }
__device__ __forceinline__ unsigned pk2(float lo, float hi) { return f2bf(lo) | (f2bf(hi) << 16); }
__device__ __forceinline__ float bflo(unsigned w) { return __builtin_bit_cast(float, w << 16); }
__device__ __forceinline__ float bfhi(unsigned w) { return __builtin_bit_cast(float, w & 0xffff0000u); }

#define XB_TMO      128
#define XB_XCNT(j)  (256  + 64 * (j))
#define XB_XSUB(j)  (1280 + 64 * (j))
#define XB_XGEN(j)  (2304 + 64 * (j))
#define XB_TOP      3328
#define XB_TOPGEN   3392
#define XCD_BAR_WORDS 3456
#define XB_SPIN_CAP (1u << 18)

__device__ __forceinline__ unsigned xb_ld(unsigned* p)              { return __hip_atomic_load(p, __ATOMIC_RELAXED, __HIP_MEMORY_SCOPE_AGENT); }
__device__ __forceinline__ unsigned xb_add(unsigned* p, unsigned v) { return __hip_atomic_fetch_add(p, v, __ATOMIC_RELAXED, __HIP_MEMORY_SCOPE_AGENT); }
__device__ __forceinline__ unsigned xb_xcc_id() { return (unsigned)__builtin_amdgcn_s_getreg((3 << 11) | 20) & 0xFu; }
#define XB_SPIN(cond, bar) do { unsigned _sp = 0; while (cond) { __builtin_amdgcn_s_sleep(1); \
    if ((++_sp & 255u) == 0u) { if (xb_ld(&(bar)[XB_TMO])) break; if (_sp > XB_SPIN_CAP) { atomicAdd(&(bar)[XB_TMO], 1u); break; } } } } while (0)

struct XcdBarrier {
    unsigned* bar; unsigned x;
    volatile LAS unsigned* st;
};

__device__ __forceinline__ XcdBarrier xcd_barrier_post(unsigned* bar, volatile LAS unsigned* st) {
    XcdBarrier b; b.bar = bar; b.x = xb_xcc_id(); b.st = st;
    if (threadIdx.x == 0) st[2] = xb_add(&bar[XB_XCNT(b.x)], 1u);
    return b;
}
__device__ __forceinline__ void xcd_barrier_complete(unsigned* bar, unsigned x, unsigned& nloc, unsigned& nx) {
    const unsigned G = gridDim.x * gridDim.y * gridDim.z;
    unsigned sum, cnt, mine, sp = 0u;
    for (;;) {
        sum = 0u; cnt = 0u; mine = 0u;
#pragma unroll
        for (unsigned j = 0; j < 16; ++j) { const unsigned c = xb_ld(&bar[XB_XCNT(j)]); sum += c; cnt += (c > 0u) ? 1u : 0u; mine = (j == x) ? c : mine; }
        if (sum == G) break;
        __builtin_amdgcn_s_sleep(1);
        if ((++sp & 255u) == 0u) { if (xb_ld(&bar[XB_TMO])) break; if (sp > XB_SPIN_CAP) { atomicAdd(&bar[XB_TMO], 1u); break; } }
    }
    nloc = mine > 0u ? mine : 1u; nx = cnt > 0u ? cnt : 1u;
}

__device__ __forceinline__ void xcd_barrier(const XcdBarrier& b) {
    asm volatile("s_waitcnt vmcnt(0)" ::: "memory");
    __syncthreads();
    if (threadIdx.x == 0) {
        unsigned* bar = b.bar;
        __builtin_amdgcn_s_waitcnt(0);
        unsigned nloc = b.st[0], nx = b.st[1];
        if (nloc == 0u) { xcd_barrier_complete(bar, b.x, nloc, nx); b.st[0] = nloc; b.st[1] = nx; }
        const unsigned old = xb_add(&bar[XB_XSUB(b.x)], 1u);
        const unsigned gen = old / nloc;
        if (old + 1u == (gen + 1u) * nloc) {
            __builtin_amdgcn_fence(__ATOMIC_RELEASE, "agent");
            asm volatile("s_waitcnt vmcnt(0)" ::: "memory");
            const unsigned og = xb_add(&bar[XB_TOP], 1u);
            const unsigned tg = og / nx;
            if (og + 1u == (tg + 1u) * nx) xb_add(&bar[XB_TOPGEN], 1u);
            else XB_SPIN(xb_ld(&bar[XB_TOPGEN]) == tg, bar);
            __builtin_amdgcn_fence(__ATOMIC_ACQUIRE, "agent");
            xb_add(&bar[XB_XGEN(b.x)], 1u);
            asm volatile("s_waitcnt vmcnt(0)" ::: "memory");
        } else {
            XB_SPIN(xb_ld(&bar[XB_XGEN(b.x)]) == gen, bar);
            __builtin_amdgcn_fence(__ATOMIC_ACQUIRE, "agent");
            asm volatile("s_waitcnt vmcnt(0)" ::: "memory");
        }
    }
    __syncthreads();
}

struct Frame {
    LAS unsigned char* lds;
    volatile LAS unsigned* MISC;
    gu32* ctl;
    int tid, lane, wave;
    int vcu, G;
    const float *x, *w_mix, *w_in, *decf, *decb, *w_retn, *w_out, *w_ffn, *w_gate, *w_up, *w_down, *w_fin; float* out;
    bf16 *Win_t, *Wout_t, *Wgu_t, *Wdn_t;
    bf16 *XN, *PROJ, *MIX, *ACT;
    float *STF, *STB, *SS1, *LSE;
    unsigned long long tA, tB;
};
#if PROBE_T
#define RT() __builtin_amdgcn_s_memrealtime()
#define T_ADD(acc, t0) do { __builtin_amdgcn_sched_barrier(0); (acc) += RT() - (t0); __builtin_amdgcn_sched_barrier(0); } while (0)
#define T_START(t0) do { __builtin_amdgcn_sched_barrier(0); (t0) = RT(); __builtin_amdgcn_sched_barrier(0); } while (0)
#else
#define T_ADD(acc, t0) do {} while (0)
#define T_START(t0) do {} while (0)
#endif

__device__ __forceinline__ float wave_sum(float v) {
#pragma unroll
    for (int o = 1; o < 64; o <<= 1) v += __shfl_xor(v, o);
    return v;
}
__device__ __forceinline__ float wave_max(float v) {
#pragma unroll
    for (int o = 1; o < 64; o <<= 1) v = fmaxf(v, __shfl_xor(v, o));
    return v;
}
__device__ __forceinline__ void p0_transpose_item(const float* W, int K, int N, bf16* WT, int row_base, const float* kscale, LAS float* scr, int k0, int n0, int lane) {
#pragma unroll 8
    for (int i = 0; i < 32; ++i) { const int kk = 2 * i + (lane >> 5); float v = W[(size_t)(k0 + kk) * N + n0 + (lane & 31)]; if (kscale) v *= kscale[k0 + kk]; scr[kk * 33 + (lane & 31)] = v; }
    LDS_WAIT(); asm volatile("" ::: "memory");
    const int c = lane & 7;
#pragma unroll
    for (int j = 0; j < 4; ++j) { const int n = (lane >> 3) + 8 * j; const LAS float* s = scr + (8 * c) * 33 + n;
        v4u o; o.x = pk2(s[0 * 33], s[1 * 33]); o.y = pk2(s[2 * 33], s[3 * 33]); o.z = pk2(s[4 * 33], s[5 * 33]); o.w = pk2(s[6 * 33], s[7 * 33]);
        *(GAS v4u*)(WT + (size_t)(row_base + n) * K + k0 + 8 * c) = o; }
    LDS_WAIT(); asm volatile("" ::: "memory");
}
__device__ __forceinline__ void p0_prologue(Frame& F) {
    LAS float* scr = (LAS float*)(F.lds + RING_OFF + F.wave * 16384);
    const int gw = F.vcu * NWAVES + F.wave, NGW = F.G * NWAVES;
    constexpr int I_IN = (D / 64) * (DIN / 32), I_OUT = (D / 64) * (D / 32), I_G = (D / 64) * (DFF / 32), I_DN = (DFF / 64) * (D / 32);
    constexpr int NITEMS = I_IN + I_OUT + 2 * I_G + I_DN;
    for (int it = gw; it < NITEMS; it += NGW) {
        int r = it;
        if (r < I_IN) { const int nblk = DIN / 32, kb = r / nblk, nb = r % nblk; p0_transpose_item(F.w_in, D, DIN, F.Win_t, 32 * nb, nullptr, scr, 64 * kb, 32 * nb, F.lane); continue; } r -= I_IN;
        if (r < I_OUT) { const int nblk = D / 32, kb = r / nblk, nb = r % nblk; p0_transpose_item(F.w_out, D, D, F.Wout_t, 32 * nb, nullptr, scr, 64 * kb, 32 * nb, F.lane); continue; } r -= I_OUT;
        if (r < 2 * I_G) { const int up = r >= I_G; if (up) r -= I_G; const int nblk = DFF / 32, kb = r / nblk, nb = r % nblk, n0 = 32 * nb;
            p0_transpose_item(up ? F.w_up : F.w_gate, D, DFF, F.Wgu_t, 256 * (n0 >> 7) + (n0 & 127) + (up ? 128 : 0), F.w_ffn, scr, 64 * kb, n0, F.lane); continue; } r -= 2 * I_G;
        { const int nblk = D / 32, kb = r / nblk, nb = r % nblk; p0_transpose_item(F.w_down, DFF, D, F.Wdn_t, 32 * nb, nullptr, scr, 64 * kb, 32 * nb, F.lane); }
    }
    for (int m = gw; m < M; m += NGW) {
        const GAS f32x4* xr = (const GAS f32x4*)(F.x + (size_t)m * D) + F.lane; const GAS f32x4* wr = (const GAS f32x4*)F.w_mix + F.lane;
        f32x4 v[8]; float s = 0.f;
#pragma unroll
        for (int j = 0; j < 8; ++j) { v[j] = xr[64 * j]; s += (v[j].x * v[j].x + v[j].y * v[j].y) + (v[j].z * v[j].z + v[j].w * v[j].w); }
        const float rstd = 1.0f / sqrtf(wave_sum(s) * (1.0f / D) + EPS);
        GAS unsigned long long* o8 = (GAS unsigned long long*)(F.XN + (size_t)m * D) + F.lane;
#pragma unroll
        for (int j = 0; j < 8; ++j) { const f32x4 w = wr[64 * j]; o8[64 * j] = (unsigned long long)pk2(v[j].x * rstd * w.x, v[j].y * rstd * w.y) | ((unsigned long long)pk2(v[j].z * rstd * w.z, v[j].w * rstd * w.w) << 32); }
    }
}

#define HP(col, h) (F.PROJ + (size_t)((col) / HD + (h)) * M * HD)
__device__ __forceinline__ void p2_attn_naive(Frame& F) {
    LAS float* qs = (LAS float*)(F.lds + RING_OFF + F.wave * 4096);
    LAS float* ps = qs + 128;
    const int gw = F.vcu * NWAVES + F.wave, NGW = F.G * NWAVES, lane = F.lane;
    for (int item = gw; item < BATCH * NH * SEQ; item += NGW) {
        const int bh = item >> 12, t = item & 4095, b = bh >> 3, h = bh & 7;
        const float slope = exp2f(-(float)(h + 1));
        const bf16* Qrow = HP(COL_QA, h) + (size_t)(b * SEQ + t) * HD;
        const bf16* Kb = HP(COL_KA, h) + (size_t)(b * SEQ) * HD;
        const bf16* Vb = HP(COL_VA, h) + (size_t)(b * SEQ) * HD;
        { const unsigned qq = *(const GAS unsigned*)(Qrow + 2 * lane); qs[2 * lane] = bflo(qq) * 0.08838834764831845f; qs[2 * lane + 1] = bfhi(qq) * 0.08838834764831845f; }
        LDS_WAIT();
        float sc[3][3]; float mx = -INFINITY;
#pragma unroll
        for (int p = 0; p < 3; ++p) { const int dil = 1 << (2 * p);
#pragma unroll
            for (int k = 0; k < 3; ++k) { const int idx = lane + 64 * k, j = idx - 64, s = t + j * dil; float v = -INFINITY;
                if (idx < 129 && s >= 0 && s < SEQ) { const GAS v4u* kr = (const GAS v4u*)(Kb + (size_t)s * HD); float dot = 0.f;
#pragma unroll 4
                    for (int c = 0; c < 16; ++c) { const v4u kk = kr[c]; const LAS float* q8 = qs + 8 * c;
                        dot += q8[0] * bflo(kk.x) + q8[1] * bfhi(kk.x) + q8[2] * bflo(kk.y) + q8[3] * bfhi(kk.y) + q8[4] * bflo(kk.z) + q8[5] * bfhi(kk.z) + q8[6] * bflo(kk.w) + q8[7] * bfhi(kk.w); }
                    v = dot - slope * (float)(dil * (j < 0 ? -j : j)); }
                sc[p][k] = v; mx = fmaxf(mx, v); } }
        mx = wave_max(mx);
        float l = 0.f;
#pragma unroll
        for (int p = 0; p < 3; ++p)
#pragma unroll
            for (int k = 0; k < 3; ++k) { const float e = __expf(sc[p][k] - mx); l += e; ps[p * 192 + lane + 64 * k] = e; }
        l = wave_sum(l);
        LDS_WAIT();
        float o0 = 0.f, o1 = 0.f;
#pragma unroll
        for (int p = 0; p < 3; ++p) { const int dil = 1 << (2 * p);
            for (int idx = 0; idx < 129; ++idx) { const int s = t + (idx - 64) * dil;
                if (s >= 0 && s < SEQ) { const float pv = ps[p * 192 + idx]; const unsigned vv = *(const GAS unsigned*)(Vb + (size_t)s * HD + 2 * lane); o0 += pv * bflo(vv); o1 += pv * bfhi(vv); } } }
        const float il = 1.0f / l;
        *(GAS unsigned*)(F.MIX + (size_t)(b * SEQ + t) * D + h * HD + 2 * lane) = pk2(o0 * il, o1 * il);
        LDS_WAIT();
    }
}
__device__ __forceinline__ void p2_r1_naive(Frame& F) {
    LAS float* Ks = (LAS float*)(F.lds + RING_OFF); LAS float* Vs = Ks + CH * HD;
    const int tid = F.tid;
    for (int item = F.vcu; item < BATCH * NH * NCH; item += F.G) {
        const int bh = item >> 5, c = item & 31, b = bh >> 3, h = bh & 7; const size_t row0 = (size_t)b * SEQ + c * CH;
        const bf16* Kg = HP(COL_KR, h) + row0 * HD; const bf16* Vg = HP(COL_VR, h) + row0 * HD;
        { const int row = tid >> 2, seg = tid & 3;
#pragma unroll
          for (int q = 0; q < 4; ++q) { const v4u kk = *(const GAS v4u*)(Kg + (size_t)row * HD + 32 * seg + 8 * q); const v4u vv = *(const GAS v4u*)(Vg + (size_t)row * HD + 32 * seg + 8 * q);
              LAS float* kd = Ks + row * HD + 32 * seg + 8 * q; LAS float* vd = Vs + row * HD + 32 * seg + 8 * q;
              kd[0] = bflo(kk.x); kd[1] = bfhi(kk.x); kd[2] = bflo(kk.y); kd[3] = bfhi(kk.y); kd[4] = bflo(kk.z); kd[5] = bfhi(kk.z); kd[6] = bflo(kk.w); kd[7] = bfhi(kk.w);
              vd[0] = bflo(vv.x); vd[1] = bfhi(vv.x); vd[2] = bflo(vv.y); vd[3] = bfhi(vv.y); vd[4] = bflo(vv.z); vd[5] = bfhi(vv.z); vd[6] = bflo(vv.w); vd[7] = bfhi(vv.w); } }
        __syncthreads();
        const float lgf = -__expf(F.decf[h]), lgb = -__expf(F.decb[h]);
        const int e = tid >> 2, dq = tid & 3;
        float af[32], ab[32];
#pragma unroll
        for (int i = 0; i < 32; ++i) { af[i] = 0.f; ab[i] = 0.f; }
        for (int j = 0; j < CH; ++j) { const float v = Vs[j * HD + e], vf = v * __expf(lgf * (float)(CH - 1 - j)), vb = v * __expf(lgb * (float)j);
            const LAS f32x4* k4 = (const LAS f32x4*)(Ks + j * HD + 32 * dq);
#pragma unroll
            for (int i = 0; i < 8; ++i) { const f32x4 k = k4[i];
                af[4 * i] += vf * k.x; af[4 * i + 1] += vf * k.y; af[4 * i + 2] += vf * k.z; af[4 * i + 3] += vf * k.w;
                ab[4 * i] += vb * k.x; ab[4 * i + 1] += vb * k.y; ab[4 * i + 2] += vb * k.z; ab[4 * i + 3] += vb * k.w; } }
        GAS f32x4* of = (GAS f32x4*)(F.STF + (size_t)item * HD * HD + e * HD + 32 * dq); GAS f32x4* ob = (GAS f32x4*)(F.STB + (size_t)item * HD * HD + e * HD + 32 * dq);
#pragma unroll
        for (int i = 0; i < 8; ++i) { of[i] = (f32x4){af[4 * i], af[4 * i + 1], af[4 * i + 2], af[4 * i + 3]}; ob[i] = (f32x4){ab[4 * i], ab[4 * i + 1], ab[4 * i + 2], ab[4 * i + 3]}; }
        __syncthreads();
    }
}
__device__ __forceinline__ bf16* sbf_row(bf16* proj, int slot, int e);
__device__ __forceinline__ void p3_scan(Frame& F) {
    const int gt = F.vcu * (NWAVES * 64) + F.tid, NT = F.G * NWAVES * 64;
    for (int idx = gt; idx < 2 * BATCH * NH * 4096; idx += NT) {
        const int dir = idx / (BATCH * NH * 4096), rem = idx % (BATCH * NH * 4096), bh = rem >> 12, q = rem & 4095, h = bh & 7;
        const float g = __expf(-__expf(dir ? F.decb[h] : F.decf[h]) * (float)CH);
        GAS f32x4* base = (GAS f32x4*)(dir ? F.STB : F.STF) + (size_t)bh * NCH * 4096 + q;
        f32x4 s = (f32x4){0.f, 0.f, 0.f, 0.f};
#pragma unroll 8
        for (int cc = 0; cc < NCH; ++cc) { const int c = dir ? NCH - 1 - cc : cc; const f32x4 t = base[(size_t)c * 4096];
#if R3_NAIVE
            base[(size_t)c * 4096] = s;
#else
            { unsigned long long o = (unsigned long long)pk2(s.x, s.y) | ((unsigned long long)pk2(s.z, s.w) << 32); *(GAS unsigned long long*)(sbf_row(F.PROJ, 2 * (bh * NCH + c) + dir, q >> 5) + 4 * (q & 31)) = o; }
#endif
            s = s * g + t; }
    }
}
__device__ __forceinline__ void p4_r3_naive(Frame& F) {
    LAS bf16* Qs = (LAS bf16*)(F.lds + RING_OFF); LAS bf16* KVs = Qs + CH * HD; LAS float* As = (LAS float*)(F.lds + RING_OFF + 65536);
    const int tid = F.tid; const float scale = 0.08838834764831845f;
    for (int item = F.vcu; item < BATCH * NH * NCH; item += F.G) {
        const int bh = item >> 5, c = item & 31, b = bh >> 3, h = bh & 7; const size_t row0 = (size_t)b * SEQ + c * CH;
        const bf16* Qg = HP(COL_QR, h) + row0 * HD; const bf16* Kg = HP(COL_KR, h) + row0 * HD;
        const bf16* Vg = HP(COL_VR, h) + row0 * HD; const bf16* Gg = HP(COL_GR, h) + row0 * HD;
        const float lgf = -__expf(F.decf[h]), lgb = -__expf(F.decb[h]);
        const int i = tid >> 2, part = tid & 3;
#pragma unroll
        for (int q = 0; q < 4; ++q) { *(LAS v4u*)(Qs + i * HD + 32 * part + 8 * q) = *(const GAS v4u*)(Qg + (size_t)i * HD + 32 * part + 8 * q);
                                      *(LAS v4u*)(KVs + i * HD + 32 * part + 8 * q) = *(const GAS v4u*)(Kg + (size_t)i * HD + 32 * part + 8 * q); }
        __syncthreads();
        for (int jj = 0; jj < 32; ++jj) { const int j = 32 * part + jj; float dot = 0.f;
#pragma unroll 4
            for (int c8 = 0; c8 < 16; ++c8) { const v4u qq = *(const LAS v4u*)(Qs + i * HD + 8 * c8), kk = *(const LAS v4u*)(KVs + j * HD + 8 * c8);
                dot += bflo(qq.x) * bflo(kk.x) + bfhi(qq.x) * bfhi(kk.x) + bflo(qq.y) * bflo(kk.y) + bfhi(qq.y) * bfhi(kk.y) + bflo(qq.z) * bflo(kk.z) + bfhi(qq.z) * bfhi(kk.z) + bflo(qq.w) * bflo(kk.w) + bfhi(qq.w) * bfhi(kk.w); }
            const float dec = (j <= i) ? __expf(lgf * (float)(i - j)) : __expf(lgb * (float)(j - i));
            As[i * CH + j] = dot * scale * dec; }
        __syncthreads();
#pragma unroll
        for (int q = 0; q < 4; ++q) *(LAS v4u*)(KVs + i * HD + 32 * part + 8 * q) = *(const GAS v4u*)(Vg + (size_t)i * HD + 32 * part + 8 * q);
        __syncthreads();
        const int e0 = 32 * part;
        float acc[32], accf[32], accb[32];
#pragma unroll
        for (int k = 0; k < 32; ++k) { acc[k] = 0.f; accf[k] = 0.f; accb[k] = 0.f; }
        for (int j = 0; j < CH; ++j) { const float a = As[i * CH + j];
#pragma unroll
            for (int q = 0; q < 4; ++q) { const v4u vv = *(const LAS v4u*)(KVs + j * HD + e0 + 8 * q);
                acc[8 * q] += a * bflo(vv.x); acc[8 * q + 1] += a * bfhi(vv.x); acc[8 * q + 2] += a * bflo(vv.y); acc[8 * q + 3] += a * bfhi(vv.y);
                acc[8 * q + 4] += a * bflo(vv.z); acc[8 * q + 5] += a * bfhi(vv.z); acc[8 * q + 6] += a * bflo(vv.w); acc[8 * q + 7] += a * bfhi(vv.w); } }
        const float* Sf = F.STF + (size_t)item * HD * HD; const float* Sb = F.STB + (size_t)item * HD * HD;
        for (int d4 = 0; d4 < HD; d4 += 4) { const unsigned long long qq = *(const LAS unsigned long long*)(Qs + i * HD + d4);
            const float q0 = bflo((unsigned)qq), q1 = bfhi((unsigned)qq), q2 = bflo((unsigned)(qq >> 32)), q3 = bfhi((unsigned)(qq >> 32));
#pragma unroll
            for (int k = 0; k < 32; ++k) { const f32x4 sf = *(const GAS f32x4*)(Sf + (size_t)(e0 + k) * HD + d4), sb = *(const GAS f32x4*)(Sb + (size_t)(e0 + k) * HD + d4);
                accf[k] += q0 * sf.x + q1 * sf.y + q2 * sf.z + q3 * sf.w; accb[k] += q0 * sb.x + q1 * sb.y + q2 * sb.z + q3 * sb.w; } }
        const float ff = __expf(lgf * (float)(i + 1)) * scale, fb = __expf(lgb * (float)(CH - i)) * scale;
        float ssq = 0.f;
#pragma unroll
        for (int k = 0; k < 32; ++k) { acc[k] += ff * accf[k] + fb * accb[k]; ssq += acc[k] * acc[k]; }
        ssq += __shfl_xor(ssq, 1); ssq += __shfl_xor(ssq, 2);
        const float rms = 1.0f / sqrtf(ssq * (1.0f / HD) + EPS);
        bf16* orow = F.MIX + (row0 + i) * D + DATT + h * HD + e0;
#pragma unroll
        for (int q = 0; q < 4; ++q) { const v4u gg = *(const GAS v4u*)(Gg + (size_t)i * HD + e0 + 8 * q); float r[8]; const float gv[8] = {bflo(gg.x), bfhi(gg.x), bflo(gg.y), bfhi(gg.y), bflo(gg.z), bfhi(gg.z), bflo(gg.w), bfhi(gg.w)};
#pragma unroll
            for (int k = 0; k < 8; ++k) { const float g = gv[k]; r[k] = acc[8 * q + k] * rms * F.w_retn[h * HD + e0 + 8 * q + k] * (g / (1.0f + __expf(-g))); }
            v4u o; o.x = pk2(r[0], r[1]); o.y = pk2(r[2], r[3]); o.z = pk2(r[4], r[5]); o.w = pk2(r[6], r[7]); *(GAS v4u*)(orow + 8 * q) = o; }
        __syncthreads();
    }
}
__device__ __forceinline__ void p8_final(Frame& F, bool dummy) {
    const int gw = F.vcu * NWAVES + F.wave, NGW = F.G * NWAVES;
    for (int m = gw; m < M; m += NGW) {
        GAS f32x4* xr = (GAS f32x4*)(F.out + (size_t)m * D) + F.lane; const GAS f32x4* wr = (const GAS f32x4*)F.w_fin + F.lane;
        f32x4 v[8]; float s = 0.f;
#pragma unroll
        for (int j = 0; j < 8; ++j) { v[j] = xr[64 * j]; s += (v[j].x * v[j].x + v[j].y * v[j].y) + (v[j].z * v[j].z + v[j].w * v[j].w); }
        const float rstd = 1.0f / sqrtf(wave_sum(s) * (1.0f / D) + EPS);
#pragma unroll
        for (int j = 0; j < 8; ++j) xr[64 * j] = dummy ? (v[j] + (rstd > 1e30f ? 1.0f : 0.0f)) : v[j] * rstd * wr[64 * j];
    }
}


typedef short bf16x8 __attribute__((ext_vector_type(8)));
typedef float f32x16 __attribute__((ext_vector_type(16)));
typedef unsigned u32x2 __attribute__((ext_vector_type(2)));
typedef float f32x2_t __attribute__((ext_vector_type(2))); typedef __bf16 bf16x2_t __attribute__((ext_vector_type(2)));
__device__ __forceinline__ unsigned cvtpk(float lo, float hi) { f32x2_t v = {lo, hi}; bf16x2_t b = __builtin_convertvector(v, bf16x2_t); return __builtin_bit_cast(unsigned, b); }
#define MFMA32(a, b, c) __builtin_amdgcn_mfma_f32_32x32x16_bf16((a), (b), (c), 0, 0, 0)
__device__ __forceinline__ f32x16 zero16() { f32x16 z;
#pragma unroll
    for (int i = 0; i < 16; ++i) z[i] = 0.f; return z; }
__device__ __forceinline__ bf16x8 pack8(const f32x16& x, int sp) {
    v4u p; p.x = cvtpk(x[8 * sp + 0], x[8 * sp + 1]); p.y = cvtpk(x[8 * sp + 2], x[8 * sp + 3]); p.z = cvtpk(x[8 * sp + 4], x[8 * sp + 5]); p.w = cvtpk(x[8 * sp + 6], x[8 * sp + 7]);
    return __builtin_bit_cast(bf16x8, p); }
__device__ __forceinline__ bf16x8 cat8(u32x2 lo, u32x2 hi) { v4u p; p.x = lo.x; p.y = lo.y; p.z = hi.x; p.w = hi.y; return __builtin_bit_cast(bf16x8, p); }
__device__ __forceinline__ unsigned elt16(const v4u& v, int i) { const unsigned w = v[i >> 1]; return (i & 1) ? (w >> 16) : (w & 0xffffu); }

__device__ __forceinline__ bf16* sbf_row(bf16* proj, int slot, int e) { return proj + ((size_t)slot * HD + e) * HD; }
__device__ __forceinline__ void p2_r1_mfma(Frame& F) {
    constexpr int P = 272;
    LAS unsigned char* KT = F.lds + RING_OFF; LAS unsigned char* VFT = KT + 128 * P; LAS unsigned char* VBT = VFT + 128 * P;
    const int w = F.wave;
    for (int item = F.vcu; item < BATCH * NH * NCH; item += F.G) {
        int tid = F.tid; asm volatile("" : "+v"(tid)); const int lane = tid & 63, r = lane & 31, hh = lane >> 5;
        const int bh = item >> 5, c = item & 31, b = bh >> 3, h = bh & 7; const size_t row0 = (size_t)b * SEQ + c * CH;
        const bf16* Kg = HP(COL_KR, h) + row0 * HD; const bf16* Vg = HP(COL_VR, h) + row0 * HD;
        const float lgf = -__expf(F.decf[h]), lgb = -__expf(F.decb[h]);
        {
            const int jg = tid & 31, dc = tid >> 5; v4u kr[4], vr[4]; float sf[4], sb[4];
#pragma unroll
            for (int q = 0; q < 4; ++q) { kr[q] = *(const GAS v4u*)(Kg + (size_t)(4 * jg + q) * HD + 8 * dc); vr[q] = *(const GAS v4u*)(Vg + (size_t)(4 * jg + q) * HD + 8 * dc);
                sf[q] = __expf(lgf * (float)(CH - 1 - (4 * jg + q))); sb[q] = __expf(lgb * (float)(4 * jg + q)); }
#pragma unroll
            for (int i = 0; i < 8; ++i) { const int off = (8 * dc + i) * P + 8 * jg;
                u32x2 kk; kk.x = elt16(kr[0], i) | (elt16(kr[1], i) << 16); kk.y = elt16(kr[2], i) | (elt16(kr[3], i) << 16); *(LAS u32x2*)(KT + off) = kk;
                const float v0 = __builtin_bit_cast(float, elt16(vr[0], i) << 16), v1 = __builtin_bit_cast(float, elt16(vr[1], i) << 16), v2 = __builtin_bit_cast(float, elt16(vr[2], i) << 16), v3 = __builtin_bit_cast(float, elt16(vr[3], i) << 16);
                u32x2 vf; vf.x = cvtpk(v0 * sf[0], v1 * sf[1]); vf.y = cvtpk(v2 * sf[2], v3 * sf[3]); *(LAS u32x2*)(VFT + off) = vf;
                u32x2 vb; vb.x = cvtpk(v0 * sb[0], v1 * sb[1]); vb.y = cvtpk(v2 * sb[2], v3 * sb[3]); *(LAS u32x2*)(VBT + off) = vb; }
        }
        __syncthreads();
        const int et = w & 3, dt0 = 2 * (w >> 2);
        f32x16 accf[2], accb[2]; accf[0] = zero16(); accf[1] = zero16(); accb[0] = zero16(); accb[1] = zero16();
#pragma unroll
        for (int s = 0; s < 8; ++s) {
            const bf16x8 af = *(const LAS bf16x8*)(VFT + (32 * et + r) * P + 32 * s + 16 * hh), ab = *(const LAS bf16x8*)(VBT + (32 * et + r) * P + 32 * s + 16 * hh);
#pragma unroll
            for (int t = 0; t < 2; ++t) { const bf16x8 bk = *(const LAS bf16x8*)(KT + (32 * (dt0 + t) + r) * P + 32 * s + 16 * hh);
                accf[t] = MFMA32(af, bk, accf[t]); accb[t] = MFMA32(ab, bk, accb[t]); }
        }
        float* of = F.STF + (size_t)item * HD * HD; float* ob = F.STB + (size_t)item * HD * HD;
#pragma unroll
        for (int t = 0; t < 2; ++t)
#pragma unroll
            for (int reg = 0; reg < 16; ++reg) { const int e = 32 * et + (reg & 3) + 8 * (reg >> 2) + 4 * hh, d = 32 * (dt0 + t) + r; of[e * HD + d] = accf[t][reg]; ob[e * HD + d] = accb[t][reg]; }
        __syncthreads();
    }
}
__device__ __forceinline__ void p4_r3_mfma(Frame& F) {
    constexpr int P = 264;
    LAS unsigned char* VT = F.lds + RING_OFF; LAS float* XS = (LAS float*)(F.lds + RING_OFF + 128 * P);
    const int w = F.wave, qt = w & 3, eh = w >> 2;
    const float scale = 0.08838834764831845f, L2E = 1.4426950408889634f;
    for (int item = F.vcu; item < BATCH * NH * NCH; item += F.G) {
        int tid = F.tid; asm volatile("" : "+v"(tid)); const int lane = tid & 63, r = lane & 31, hh = lane >> 5;
        const int bh = item >> 5, c = item & 31, b = bh >> 3, h = bh & 7; const size_t row0 = (size_t)b * SEQ + c * CH;
        const bf16* Qg = HP(COL_QR, h) + row0 * HD; const bf16* Kg = HP(COL_KR, h) + row0 * HD;
        const bf16* Vg = HP(COL_VR, h) + row0 * HD; const bf16* Gg = HP(COL_GR, h) + row0 * HD;
        const float lgf2 = -__expf(F.decf[h]) * L2E, lgb2 = -__expf(F.decb[h]) * L2E;
        {
            const int jg = tid & 31, dc = tid >> 5; v4u vr[4];
#pragma unroll
            for (int q = 0; q < 4; ++q) vr[q] = *(const GAS v4u*)(Vg + (size_t)(4 * jg + q) * HD + 8 * dc);
#pragma unroll
            for (int i = 0; i < 8; ++i) { u32x2 vv; vv.x = elt16(vr[0], i) | (elt16(vr[1], i) << 16); vv.y = elt16(vr[2], i) | (elt16(vr[3], i) << 16); *(LAS u32x2*)(VT + (8 * dc + i) * P + 8 * jg) = vv; }
        }
        const int iq = 32 * qt + r;
        bf16x8 qf[8];
#pragma unroll
        for (int s = 0; s < 8; ++s) qf[s] = *(const GAS bf16x8*)(Qg + (size_t)iq * HD + 64 * hh + 8 * s);
        f32x16 st[4];
#pragma unroll
        for (int kt = 0; kt < 4; ++kt) { st[kt] = zero16();
#pragma unroll
            for (int s = 0; s < 8; ++s) { const bf16x8 kf = *(const GAS bf16x8*)(Kg + (size_t)(32 * kt + r) * HD + 64 * hh + 8 * s); st[kt] = MFMA32(kf, qf[s], st[kt]); }
            __builtin_amdgcn_sched_barrier(0); }
        bf16x8 pf[4][2];
#pragma unroll
        for (int kt = 0; kt < 4; ++kt) {
#pragma unroll
            for (int reg = 0; reg < 16; ++reg) { const int j = 32 * kt + (reg & 3) + 8 * (reg >> 2) + 4 * hh, dj = iq - j;
                const float dec = __builtin_amdgcn_exp2f(dj >= 0 ? lgf2 * (float)dj : lgb2 * (float)(-dj)); st[kt][reg] *= scale * dec; }
            pf[kt][0] = pack8(st[kt], 0); pf[kt][1] = pack8(st[kt], 1); }
        const float ff = __builtin_amdgcn_exp2f(lgf2 * (float)(iq + 1)) * scale, fb = __builtin_amdgcn_exp2f(lgb2 * (float)(CH - iq)) * scale;
        f32x16 acc[2];
#pragma unroll
        for (int t = 0; t < 2; ++t) { const int e = 32 * (2 * eh + t) + r; f32x16 a1 = zero16(), a2 = zero16();
            const bf16* s1 = sbf_row(F.PROJ, 2 * item, e) + 64 * hh; const bf16* s2 = sbf_row(F.PROJ, 2 * item + 1, e) + 64 * hh;
#pragma unroll
            for (int s = 0; s < 8; ++s) { a1 = MFMA32(*(const GAS bf16x8*)(s1 + 8 * s), qf[s], a1); a2 = MFMA32(*(const GAS bf16x8*)(s2 + 8 * s), qf[s], a2); }
#pragma unroll
            for (int reg = 0; reg < 16; ++reg) acc[t][reg] = ff * a1[reg] + fb * a2[reg];
            __builtin_amdgcn_sched_barrier(0); }
        __syncthreads();
#pragma unroll
        for (int t = 0; t < 2; ++t) { const LAS unsigned char* vrow = VT + (32 * (2 * eh + t) + r) * P + 8 * hh;
#pragma unroll
            for (int kt = 0; kt < 4; ++kt)
#pragma unroll
                for (int sp = 0; sp < 2; ++sp) { const u32x2 lo = *(const LAS u32x2*)(vrow + 2 * (32 * kt + 16 * sp)), hi = *(const LAS u32x2*)(vrow + 2 * (32 * kt + 16 * sp + 8));
                    acc[t] = MFMA32(cat8(lo, hi), pf[kt][sp], acc[t]); } }
        float ssq = 0.f;
#pragma unroll
        for (int t = 0; t < 2; ++t)
#pragma unroll
            for (int reg = 0; reg < 16; ++reg) ssq += acc[t][reg] * acc[t][reg];
        ssq += __shfl_xor(ssq, 32);
        if (hh == 0) XS[w * 32 + r] = ssq;
        __syncthreads();
        const float rms = 1.0f / sqrtf((XS[w * 32 + r] + XS[(w ^ 4) * 32 + r]) * (1.0f / HD) + EPS);
#pragma unroll
        for (int t = 0; t < 2; ++t)
#pragma unroll
            for (int g = 0; g < 4; ++g) { const int e = 32 * (2 * eh + t) + 8 * g + 4 * hh;
                const u32x2 gg = *(const GAS u32x2*)(Gg + (size_t)iq * HD + e); const f32x4 wn = *(const GAS f32x4*)(F.w_retn + h * HD + e);
                const float g0 = bflo(gg.x), g1 = bfhi(gg.x), g2 = bflo(gg.y), g3 = bfhi(gg.y);
                const float o0 = acc[t][4 * g] * rms * wn.x * (g0 / (1.0f + __expf(-g0))), o1 = acc[t][4 * g + 1] * rms * wn.y * (g1 / (1.0f + __expf(-g1)));
                const float o2 = acc[t][4 * g + 2] * rms * wn.z * (g2 / (1.0f + __expf(-g2))), o3 = acc[t][4 * g + 3] * rms * wn.w * (g3 / (1.0f + __expf(-g3)));
                u32x2 o; o.x = cvtpk(o0, o1); o.y = cvtpk(o2, o3); *(GAS u32x2*)(F.MIX + (row0 + iq) * D + DATT + h * HD + e) = o; }
        __syncthreads();
    }
}
__device__ __forceinline__ void p2_attn_mfma(Frame& F) {
    constexpr int PK = 272, PV = 520;
    LAS unsigned char* KI = F.lds + RING_OFF; LAS unsigned char* VT = KI + 256 * PK;
    static_assert(256 * PK + 128 * PV <= RING_BYTES, "attention images fit the ring");
    const int w = F.wave, qt = w & 3, eh = w >> 2;
    const float scale = 0.08838834764831845f, L2E = 1.4426950408889634f;
    const int NU = BATCH * NH * 96;
    for (int n = F.vcu; n < NU; n += F.G) {
        int tid = F.tid; asm volatile("" : "+v"(tid)); const int lane = tid & 63, r = lane & 31, hh = lane >> 5;
        unsigned long long t0 = 0, t1 = 0; T_START(t0);
        int bh, u;
        if (F.G == 256) { const int it = n >> 8; bh = (F.vcu >> 5) + 8 * (it / 3); u = (F.vcu & 31) + 32 * (it % 3); }
        else { bh = n / 96; u = n % 96; }
        const int p = u >> 5, idx = u & 31, sh = 2 * p, dil = 1 << sh, nblk = 32 >> sh, cls = idx / nblk, l0 = 128 * (idx % nblk), L = SEQ >> sh;
        const int b = bh >> 3, h = bh & 7;
        const bf16* Qb = HP(COL_QA, h) + (size_t)(b * SEQ) * HD; const bf16* Kb = HP(COL_KA, h) + (size_t)(b * SEQ) * HD; const bf16* Vb = HP(COL_VA, h) + (size_t)(b * SEQ) * HD;
#pragma unroll
        for (int it = 0; it < 8; ++it) { const int pc = tid + 512 * it, row = pc >> 4, ch = pc & 15, lk = l0 - 64 + row;
            const int lkc = lk < 0 ? 0 : (lk >= L ? L - 1 : lk);
            *(LAS v4u*)(KI + row * PK + 16 * ch) = *(const GAS v4u*)(Kb + (size_t)(lkc * dil + cls) * HD + 8 * ch); }
#pragma unroll
        for (int it = 0; it < 2; ++it) { const int bid = tid + 512 * it, jg = bid & 63, dc = bid >> 6; v4u vr[4];
#pragma unroll
            for (int q = 0; q < 4; ++q) { const int lk = l0 - 64 + 4 * jg + q, lkc = lk < 0 ? 0 : (lk >= L ? L - 1 : lk); vr[q] = *(const GAS v4u*)(Vb + (size_t)(lkc * dil + cls) * HD + 8 * dc); }
#pragma unroll
            for (int i = 0; i < 8; ++i) { u32x2 vv; vv.x = elt16(vr[0], i) | (elt16(vr[1], i) << 16); vv.y = elt16(vr[2], i) | (elt16(vr[3], i) << 16); *(LAS u32x2*)(VT + (8 * dc + i) * PV + 8 * jg) = vv; } }
        const int lq = l0 + 32 * qt + r;
        const size_t qrow = (size_t)(lq * dil + cls);
        bf16x8 qf[8];
#pragma unroll
        for (int s = 0; s < 8; ++s) qf[s] = *(const GAS bf16x8*)(Qb + qrow * HD + 64 * hh + 8 * s);
        __syncthreads();
        if (PROBE_T == 1) T_ADD(F.tA, t0);
        T_START(t1);
        f32x16 st[5];
#pragma unroll
        for (int kt = 0; kt < 5; ++kt) { st[kt] = zero16(); const LAS unsigned char* krow = KI + (32 * qt + 32 * kt + r) * PK + 128 * hh;
#pragma unroll
            for (int s = 0; s < 8; ++s) st[kt] = MFMA32(*(const LAS bf16x8*)(krow + 16 * s), qf[s], st[kt]);
            __builtin_amdgcn_sched_barrier(0); }
        const float slope2 = exp2f(-(float)(h + 1)) * (float)dil * L2E, sc2 = scale * L2E;
        float mx = -INFINITY;
#pragma unroll
        for (int kt = 0; kt < 5; ++kt)
#pragma unroll
            for (int reg = 0; reg < 16; ++reg) { const int jl = 32 * kt + (reg & 3) + 8 * (reg >> 2) + 4 * hh, dist = r + 64 - jl, ad = dist < 0 ? -dist : dist, lk = l0 + 32 * qt - 64 + jl;
                const bool valid = (ad <= 64) && (lk >= 0) && (lk < L);
                const float s2 = valid ? st[kt][reg] * sc2 - slope2 * (float)ad : -INFINITY; st[kt][reg] = s2; mx = fmaxf(mx, s2); }
        mx = fmaxf(mx, __shfl_xor(mx, 32));
        if (PROBE_T == 3) { T_ADD(F.tA, t1); T_START(t1); }
        float l = 0.f;
#pragma unroll
        for (int kt = 0; kt < 5; ++kt)
#pragma unroll
            for (int reg = 0; reg < 16; ++reg) { const float e = __builtin_amdgcn_exp2f(st[kt][reg] - mx); st[kt][reg] = e; l += e; }
        l += __shfl_xor(l, 32);
        f32x16 acc[2]; acc[0] = zero16(); acc[1] = zero16();
#pragma unroll
        for (int kt = 0; kt < 5; ++kt)
#pragma unroll
            for (int sp = 0; sp < 2; ++sp) { const bf16x8 pfr = pack8(st[kt], sp);
#pragma unroll
                for (int t = 0; t < 2; ++t) { const LAS unsigned char* vrow = VT + (32 * (2 * eh + t) + r) * PV + 2 * (32 * qt + 32 * kt + 16 * sp + 4 * hh);
                    const u32x2 lo = *(const LAS u32x2*)(vrow), hi = *(const LAS u32x2*)(vrow + 16);
                    acc[t] = MFMA32(cat8(lo, hi), pfr, acc[t]); }
                __builtin_amdgcn_sched_barrier(0); }
        const float il = 1.0f / l; const size_t orow = (size_t)b * SEQ + qrow;
        bf16* ob = (p == 0) ? (F.MIX + orow * D + h * HD) : (F.XN + (size_t)(p - 1) * M * DATT + orow * DATT + h * HD);
#pragma unroll
        for (int t = 0; t < 2; ++t)
#pragma unroll
            for (int g = 0; g < 4; ++g) { const int e = 32 * (2 * eh + t) + 8 * g + 4 * hh; u32x2 o; o.x = cvtpk(acc[t][4 * g] * il, acc[t][4 * g + 1] * il); o.y = cvtpk(acc[t][4 * g + 2] * il, acc[t][4 * g + 3] * il); *(GAS u32x2*)(ob + e) = o; }
        if (eh == 0 && hh == 0) F.LSE[(size_t)p * M * NH + orow * NH + h] = (mx + __log2f(l)) * 0.6931471805599453f;
        __syncthreads();
        if (PROBE_T == 1) T_ADD(F.tB, t0);
        if (PROBE_T == 3) T_ADD(F.tB, t1);
    }
}
__device__ __forceinline__ void p3_merge(Frame& F) {
    const int gt = F.vcu * (NWAVES * 64) + F.tid, NT = F.G * NWAVES * 64;
    for (int idx = gt; idx < M * (DATT / 8); idx += NT) { const int row = idx >> 7, c8 = idx & 127, h = c8 >> 4;
        const float l1 = F.LSE[(size_t)row * NH + h], l4 = F.LSE[(size_t)M * NH + (size_t)row * NH + h], l16 = F.LSE[(size_t)2 * M * NH + (size_t)row * NH + h];
        const float mx = fmaxf(l1, fmaxf(l4, l16)); float w1 = __expf(l1 - mx), w4 = __expf(l4 - mx), w16 = __expf(l16 - mx); const float inv = 1.0f / (w1 + w4 + w16); w1 *= inv; w4 *= inv; w16 *= inv;
        GAS v4u* pm = (GAS v4u*)(F.MIX + (size_t)row * D + 8 * c8);
        const v4u a = *pm, bq = *(const GAS v4u*)(F.XN + (size_t)row * DATT + 8 * c8), cq = *(const GAS v4u*)(F.XN + (size_t)M * DATT + (size_t)row * DATT + 8 * c8);
        v4u o;
#pragma unroll
        for (int k = 0; k < 4; ++k) o[k] = cvtpk(w1 * bflo(a[k]) + w4 * bflo(bq[k]) + w16 * bflo(cq[k]), w1 * bfhi(a[k]) + w4 * bfhi(bq[k]) + w16 * bfhi(cq[k]));
        *pm = o; }
}
typedef short v4i16_t __attribute__((ext_vector_type(4)));
__device__ __forceinline__ unsigned swz16(unsigned row) { return ((row & 3u) << 2) | ((row >> 2) & 3u); }
struct AttnUnit { int b, h, p, dil, cls, l0, L; const bf16 *Qb, *Kb, *Vb; };
__device__ __forceinline__ AttnUnit attn_unit(const Frame& F, int n) {
    int bh, u;
    if (F.G == 256) { const int it = n >> 8; bh = (F.vcu >> 5) + 8 * (it / 3); u = (F.vcu & 31) + 32 * (it % 3); }
    else { bh = n / 96; u = n % 96; }
    AttnUnit U; U.p = u >> 5; const int idx = u & 31, sh = 2 * U.p, nblk = 32 >> sh; U.dil = 1 << sh; U.cls = idx / nblk; U.l0 = 128 * (idx % nblk); U.L = SEQ >> sh; U.b = bh >> 3; U.h = bh & 7;
    U.Qb = HP(COL_QA, U.h) + (size_t)(U.b * SEQ) * HD; U.Kb = HP(COL_KA, U.h) + (size_t)(U.b * SEQ) * HD; U.Vb = HP(COL_VA, U.h) + (size_t)(U.b * SEQ) * HD;
    return U;
}
__device__ __forceinline__ void attn_dma(LAS unsigned char* img, const bf16* Xb, const AttnUnit& U, int w, int lane) {
#pragma unroll
    for (int i = 0; i < 8; ++i) { const int pc = 8 * w + i, row = 4 * pc + (lane >> 4), ch = (lane & 15) ^ (int)swz16((unsigned)row);
        int lk = U.l0 - 64 + row; lk = lk < 0 ? 0 : (lk >= U.L ? U.L - 1 : lk);
        __builtin_amdgcn_global_load_lds((const unsigned*)(Xb + (size_t)(lk * U.dil + U.cls) * HD + 8 * ch), (LAS unsigned*)(img + pc * 1024), 16, 0, 0); }
}
__device__ __forceinline__ void p2_attn_dma(Frame& F) {
    LAS unsigned char* KI = F.lds + RING_OFF; LAS unsigned char* VI = KI + 65536;
    const int w = F.wave, qt = w & 3, eh = w >> 2;
    const float scale = 0.08838834764831845f, L2E = 1.4426950408889634f;
    const int NU = BATCH * NH * 96;
    int n = F.vcu; if (n >= NU) return;
    AttnUnit U = attn_unit(F, n);
    bf16x8 qf[8];
    { int tid = F.tid; asm volatile("" : "+v"(tid)); const int lane = tid & 63, r = lane & 31, hh = lane >> 5;
      attn_dma(KI, U.Kb, U, w, lane);
      const size_t qrow = (size_t)((U.l0 + 32 * qt + r) * U.dil + U.cls);
#pragma unroll
      for (int s = 0; s < 8; ++s) qf[s] = *(const GAS bf16x8*)(U.Qb + qrow * HD + 16 * s + 8 * hh); }
    for (;;) {
        int tid = F.tid; asm volatile("" : "+v"(tid)); const int lane = tid & 63, r = lane & 31, hh = lane >> 5;
        unsigned long long t0 = 0, t1 = 0; T_START(t0);
        __syncthreads();
        if (PROBE_T == 1) T_ADD(F.tA, t0);
        T_START(t1);
        attn_dma(VI, U.Vb, U, w, lane);
        const int lq0 = U.l0 + 32 * qt;
        f32x16 st[5];
        const unsigned swr = swz16((unsigned)r);
#pragma unroll
        for (int kt = 0; kt < 5; ++kt) { st[kt] = zero16(); const int lk0 = lq0 - 64 + 32 * kt;
            if (lk0 >= 0 && lk0 < U.L) { const LAS unsigned char* krow = KI + (32 * (qt + kt) + r) * 256;
#pragma unroll
                for (int s = 0; s < 8; ++s) st[kt] = MFMA32(*(const LAS bf16x8*)(krow + 16 * ((unsigned)(2 * s + hh) ^ swr)), qf[s], st[kt]); }
            __builtin_amdgcn_sched_barrier(0); }
        const float slope2 = exp2f(-(float)(U.h + 1)) * (float)U.dil * L2E, sc2 = scale * L2E, frr = (float)(r - 4 * hh);
        float mx = -INFINITY;
#pragma unroll
        for (int kt = 0; kt < 5; ++kt) { const int lk0 = lq0 - 64 + 32 * kt; const bool tin = (lk0 >= 0 && lk0 < U.L);
#pragma unroll
            for (int reg = 0; reg < 16; ++reg) { const float ad = fabsf(frr + (float)(64 - 32 * kt - ((reg & 3) + 8 * (reg >> 2))));
                float s2 = st[kt][reg] * sc2 - slope2 * ad;
                if (kt == 0 || kt == 4) s2 = (ad <= 64.0f) ? s2 : -INFINITY;
                s2 = tin ? s2 : -INFINITY;
                st[kt][reg] = s2; mx = fmaxf(mx, s2); } }
        mx = fmaxf(mx, __shfl_xor(mx, 32));
        if (PROBE_T == 3) { T_ADD(F.tA, t1); T_START(t1); }
        __syncthreads();
        const int nn = n + F.G; const bool has_next = nn < NU;
        AttnUnit Un = U; if (has_next) { Un = attn_unit(F, nn); attn_dma(KI, Un.Kb, Un, w, lane); }
        float l = 0.f;
#pragma unroll
        for (int kt = 0; kt < 5; ++kt)
#pragma unroll
            for (int reg = 0; reg < 16; ++reg) { const float e = __builtin_amdgcn_exp2f(st[kt][reg] - mx); st[kt][reg] = e; l += e; }
        l += __shfl_xor(l, 32);
        f32x16 acc[2]; acc[0] = zero16(); acc[1] = zero16();
        const int q4 = (lane & 15) >> 2, pp = lane & 3, blk = (lane >> 4) & 1;
        unsigned voff[2][2][2];
#pragma unroll
        for (int t2 = 0; t2 < 2; ++t2) { const unsigned rl = (unsigned)(4 * hh + 8 * t2 + q4), sw = swz16(rl);
#pragma unroll
            for (int t = 0; t < 2; ++t) { const unsigned chunk = (unsigned)(4 * (2 * eh + t) + 2 * blk + (pp >> 1)); voff[t2][t][0] = 256u * rl + 16u * (chunk ^ sw) + 8u * (unsigned)(pp & 1); voff[t2][t][1] = 0; } }
#pragma unroll
        for (int kt = 0; kt < 5; ++kt) { const int lk0 = lq0 - 64 + 32 * kt;
            if (lk0 >= 0 && lk0 < U.L) {
#pragma unroll
                for (int sp = 0; sp < 2; ++sp) { const bf16x8 pfr = pack8(st[kt], sp); const LAS unsigned char* vb = VI + (32 * (qt + kt) + 16 * sp) * 256;
#pragma unroll
                    for (int t = 0; t < 2; ++t) {
                        const v4i16_t lo = __builtin_amdgcn_ds_read_tr16_b64_v4i16((LAS v4i16_t*)(vb + voff[0][t][0])), hi = __builtin_amdgcn_ds_read_tr16_b64_v4i16((LAS v4i16_t*)(vb + voff[1][t][0]));
                        const bf16x8 vf = __builtin_shufflevector(lo, hi, 0, 1, 2, 3, 4, 5, 6, 7);
                        acc[t] = MFMA32(vf, pfr, acc[t]); } } }
            __builtin_amdgcn_sched_barrier(0); }
        const float il = 1.0f / l; const size_t qrow = (size_t)((lq0 + r) * U.dil + U.cls), orow = (size_t)U.b * SEQ + qrow;
        bf16* ob = (U.p == 0) ? (F.MIX + orow * D + U.h * HD) : (F.XN + (size_t)(U.p - 1) * M * DATT + orow * DATT + U.h * HD);
#pragma unroll
        for (int t = 0; t < 2; ++t)
#pragma unroll
            for (int g = 0; g < 4; ++g) { const int e = 32 * (2 * eh + t) + 8 * g + 4 * hh; u32x2 o; o.x = cvtpk(acc[t][4 * g] * il, acc[t][4 * g + 1] * il); o.y = cvtpk(acc[t][4 * g + 2] * il, acc[t][4 * g + 3] * il); *(GAS u32x2*)(ob + e) = o; }
        if (eh == 0 && hh == 0) F.LSE[(size_t)U.p * M * NH + orow * NH + U.h] = (mx + __log2f(l)) * 0.6931471805599453f;
        if (PROBE_T == 1) T_ADD(F.tB, t0);
        if (PROBE_T == 3) T_ADD(F.tB, t1);
        if (!has_next) break;
        U = Un; n = nn;
        { const size_t qr2 = (size_t)((U.l0 + 32 * qt + r) * U.dil + U.cls);
#pragma unroll
          for (int s = 0; s < 8; ++s) qf[s] = *(const GAS bf16x8*)(U.Qb + qr2 * HD + 16 * s + 8 * hh); }
    }
    __syncthreads();
}
struct Args { const float* in[12]; float* out; unsigned char* ws; int ph_lo, ph_hi, li, pad; };
__global__ void __launch_bounds__(NWAVES * 64, 2) mk_fwd(Args args) {
    extern __shared__ __attribute__((aligned(16))) unsigned char lds[];
    Frame F;
    F.lds = (LAS unsigned char*)lds;
    F.MISC = (volatile LAS unsigned*)(F.lds + MISC_OFF);
    F.tid = threadIdx.x; F.lane = F.tid & 63; F.wave = __builtin_amdgcn_readfirstlane(F.tid >> 6);
    F.G = gridDim.x; { const int bx = blockIdx.x; F.vcu = (F.G % 8 == 0) ? (bx % 8) * (F.G / 8) + bx / 8 : bx; }
    unsigned char* ws = args.ws;
    F.ctl = (gu32*)(ws + WS_CTL);
    F.x = args.in[0]; F.w_mix = args.in[1]; F.w_in = args.in[2]; F.decf = args.in[3]; F.decb = args.in[4]; F.w_retn = args.in[5]; F.w_out = args.in[6];
    F.w_ffn = args.in[7]; F.w_gate = args.in[8]; F.w_up = args.in[9]; F.w_down = args.in[10]; F.w_fin = args.in[11]; F.out = args.out;
    F.Win_t = (bf16*)(ws + WS_WIN); F.Wout_t = (bf16*)(ws + WS_WOUT); F.Wgu_t = (bf16*)(ws + WS_WGU); F.Wdn_t = (bf16*)(ws + WS_WDN);
    F.XN = (bf16*)(ws + WS_XN); F.PROJ = (bf16*)(ws + WS_PROJ); F.MIX = (bf16*)(ws + WS_MIX); F.ACT = (bf16*)(ws + WS_PROJ);
    F.STF = args.out; F.STB = args.out + ST_HALF; F.SS1 = (float*)(ws + WS_CTL + CTL_SS1); F.LSE = (float*)(ws + WS_LSE);
    F.tA = 0; F.tB = 0;
    for (int u = F.tid; u < (LDS_BYTES - LDSCTL_OFF) / 4; u += NWAVES * 64) ((LAS unsigned*)(F.lds + LDSCTL_OFF))[u] = 0u;
    __syncthreads();
    XcdBarrier bar; bar.bar = (unsigned*)(F.ctl + CW_BAR); bar.x = 0; bar.st = nullptr;
    if (N_LAUNCHES != PER_PHASE) bar = xcd_barrier_post((unsigned*)(F.ctl + CW_BAR), F.MISC + 8);
#define GRID_BAR(seam) do { if (N_LAUNCHES == PER_PHASE) { if (F.tid == 0) __hip_atomic_store(F.ctl + CW_TMO, 0xBADBA0u | (unsigned)(seam), RLX_AGENT); } else { xcd_barrier(bar); } } while (0)
    const int lo = args.ph_lo, hi = args.ph_hi;
#define IN(k) (lo <= (k) && (k) < hi)
#define BOTH(k) (IN(k) && IN((k) + 1))

#define REP(k) (((PROBE_REPEAT) >> (k)) & 1)
    if (IN(0)) { p0_prologue(F); if (REP(0)) p0_prologue(F); if (BOTH(0)) GRID_BAR(0); }
    if (N_LAUNCHES != PER_PHASE && lo == 0 && hi > 1) {
        unsigned pre = 0;
        for (unsigned j = 0; j < bar.x; ++j) pre += xb_ld(&bar.bar[XB_XCNT(j)]);
        F.vcu = (int)(pre + F.MISC[10]);
    }
    if (IN(1)) {
        pg8::Gemm g{F.XN, F.Win_t, M, DIN, D}; pg8::StaticOrder S; S.init(M, DIN, F.G, (int)blockIdx.x);
        pg8::EpiHeads E{F.PROJ, M};
        for (int rep = 0; rep <= REP(1); ++rep) pg8::gemm_phase<pg8::EpiHeads, pg8::StaticOrder, true, true>(F.lds + RING_OFF, g, S, E);
        if (BOTH(1)) GRID_BAR(1);
    }
    if (IN(2)) {
        for (int rep = 0; rep <= REP(2); ++rep) {
#if ATTN_NAIVE
        p2_attn_naive(F); __syncthreads();
#elif ATTN_V1
        p2_attn_mfma(F);
#else
        p2_attn_dma(F);
#endif
#if R1_NAIVE
        p2_r1_naive(F);
#else
        { unsigned long long tR1 = 0; T_START(tR1); p2_r1_mfma(F); if (PROBE_T == 2) T_ADD(F.tA, tR1); }
#endif
        }
        if (BOTH(2)) GRID_BAR(2); }
    if (IN(3)) { p3_scan(F); if (REP(3)) p3_scan(F);
#if !ATTN_NAIVE
        p3_merge(F);
#endif
        if (BOTH(3)) GRID_BAR(3); }
    if (IN(4)) {
        for (int rep = 0; rep <= REP(4); ++rep) {
#if R3_NAIVE
        p4_r3_naive(F);
#else
        { unsigned long long tR3 = 0; T_START(tR3); p4_r3_mfma(F); if (PROBE_T == 2) T_ADD(F.tB, tR3); }
#endif
        }
        if (BOTH(4)) GRID_BAR(4); }
    if (IN(5)) {
        pg8::Gemm g{F.MIX, F.Wout_t, M, D, D}; pg8::StaticOrder S; S.init(M, D, F.G, (int)blockIdx.x);
        pg8::EpiResid E{F.x, F.out, F.XN, F.SS1, D};
        pg8::gemm_phase<pg8::EpiResid, pg8::StaticOrder, true, true>(F.lds + RING_OFF, g, S, E);
        if (REP(5)) { pg8::EpiResid E2{F.x, F.out, F.XN, nullptr, D}; pg8::gemm_phase<pg8::EpiResid, pg8::StaticOrder, true, true>(F.lds + RING_OFF, g, S, E2); }
        if (BOTH(5)) GRID_BAR(5);
    }
    if (IN(6)) {
        pg8::Gemm g{F.XN, F.Wgu_t, M, NGU, D}; pg8::StaticOrder S; S.init(M, NGU, F.G, (int)blockIdx.x);
        pg8::EpiSwiGLU E{F.ACT, DFF, F.SS1, 1.0f / D, EPS};
        for (int rep = 0; rep <= REP(6); ++rep) pg8::gemm_phase<pg8::EpiSwiGLU, pg8::StaticOrder, true, true>(F.lds + RING_OFF, g, S, E);
        if (BOTH(6)) GRID_BAR(6);
    }
    if (IN(7)) {
        pg8::Gemm g{F.ACT, F.Wdn_t, M, D, DFF}; pg8::StaticOrder S; S.init(M, D, F.G, (int)blockIdx.x);
        if (REP(7)) { pg8::EpiNull E0{}; pg8::gemm_phase<pg8::EpiNull, pg8::StaticOrder, true, true>(F.lds + RING_OFF, g, S, E0); }
        pg8::EpiResid E{F.out, F.out, nullptr, nullptr, D};
        pg8::gemm_phase<pg8::EpiResid, pg8::StaticOrder, true, true>(F.lds + RING_OFF, g, S, E);
        if (BOTH(7)) GRID_BAR(7);
    }
    if (IN(8)) { if (REP(8)) p8_final(F, true); p8_final(F, false); }
#if PROBE_T
    if (blockIdx.x == PROBE_BLOCK && F.tid == 0) {
        const unsigned long long t0 = RT(), span = (unsigned long long)PROBE_MULT * (PROBE_USE_B ? F.tB : F.tA);
        while (RT() - t0 < span) __builtin_amdgcn_s_sleep(8);
    }
#endif
#undef REP
#undef IN
#undef BOTH
}

extern "C" void kernel_launch(void* const* d_in, const int* in_sizes, int n_in, void* d_out, int out_size, void* d_ws, size_t ws_size, hipStream_t stream) {
    static int grid = 0;
    if (grid == 0) {
        if (n_in != 12 || in_sizes[0] != M * D || out_size != M * D || ws_size < WS_END) { fprintf(stderr, "kernel_launch: shape/workspace mismatch (n_in %d, in0 %d, out %d, ws %zu, need %zu)\n", n_in, n_in > 0 ? in_sizes[0] : -1, out_size, ws_size, (size_t)WS_END); grid = -1; return; }
        int dev = 0, cus = 0, per_cu = 0;
        if (hipGetDevice(&dev) != hipSuccess || hipDeviceGetAttribute(&cus, hipDeviceAttributeMultiprocessorCount, dev) != hipSuccess) { grid = -1; return; }
        if (hipFuncSetAttribute((const void*)mk_fwd, hipFuncAttributeMaxDynamicSharedMemorySize, LDS_BYTES) != hipSuccess) { fprintf(stderr, "kernel_launch: hipFuncSetAttribute failed\n"); grid = -1; return; }
        if (hipOccupancyMaxActiveBlocksPerMultiprocessor(&per_cu, (const void*)mk_fwd, NWAVES * 64, LDS_BYTES) != hipSuccess || per_cu < 1) fprintf(stderr, "kernel_launch: occupancy query reports %d\n", per_cu);
        (void)hipGetLastError();
        grid = cus;
    }
    if (grid < 0) return;
    (void)hipMemsetAsync((char*)d_ws + WS_CTL, 0, CTL_ZERO_BYTES, stream);
    Args a{};
    for (int i = 0; i < 12; ++i) a.in[i] = (const float*)d_in[i];
    a.out = (float*)d_out; a.ws = (unsigned char*)d_ws;
    if (N_LAUNCHES == 1) { a.ph_lo = 0; a.ph_hi = PER_PHASE; a.li = 0; hipLaunchKernelGGL(mk_fwd, dim3(grid), dim3(NWAVES * 64), LDS_BYTES, stream, a); }
    else for (int li = 0; li < PER_PHASE; ++li) { a.ph_lo = li; a.ph_hi = li + 1; a.li = li; hipLaunchKernelGGL(mk_fwd, dim3(grid), dim3(NWAVES * 64), LDS_BYTES, stream, a); }
}
```

```cpp
#include <hip/hip_runtime.h>
#include <cstdio>
#include <cstdint>
namespace pg8 {
#define PG8_LAS __attribute__((address_space(3)))
typedef unsigned short bf16_t;
typedef short bf16x8 __attribute__((ext_vector_type(8)));
typedef float f32x4 __attribute__((ext_vector_type(4)));
typedef unsigned u32x4 __attribute__((ext_vector_type(4)));
constexpr int BM = 256, BK = 64, HALF = 128, HTB = HALF * BK * 2  , STAGE_BYTES = 8 * HTB, NXCD = 8, WGM = 8;

__host__ __device__ __forceinline__ int lds_byte(int r, int c) { const int st = (r >> 4) * 2 + (c >> 5), rr = r & 15, cc = c & 31, ob = rr * 64 + cc * 2; return st * 1024 + (ob ^ (((ob >> 9) & 1) << 5)); }
__host__ __device__ __forceinline__ void stage_rc(int b, int& R, int& C) { const int st = b / 1024, sb = b % 1024, swz = sb ^ (((sb >> 9) & 1) << 5); R = (st >> 1) * 16 + swz / 64; C = (st & 1) * 32 + (swz % 64) / 2; }
__host__ __device__ __forceinline__ int perm32(int rho) { const int n = rho >> 4, i = rho & 15; return 8 * (i >> 2) + 4 * n + (i & 3); }

struct Unit { int pm, pn; };
struct Gemm { const bf16_t* A; const bf16_t* Bt; int M, N, K; };

struct StaticOrder {
    int nM, nN, nwg, G, c;
    __host__ __device__ void init(int M, int N, int G_, int c_) { nM = M / BM; nN = N / BM; nwg = nM * nN; G = G_; c = c_; }
    __host__ __device__ bool next(int i, Unit& u) const {
        const long L = (long)i * G + c; if (L >= nwg) return false;
        int wgid = (int)L; { const int q = nwg / NXCD, r = nwg % NXCD, xcd = wgid % NXCD, off = wgid / NXCD; wgid = (xcd < r ? xcd * (q + 1) : r * (q + 1) + (xcd - r) * q) + off; }
        const int nig = WGM * nN, gid = wgid / nig, fm = gid * WGM, gsz = (nM - fm) < WGM ? (nM - fm) : WGM;
        u.pm = fm + ((wgid % nig) % gsz); u.pn = (wgid % nig) / gsz; return true;
    }
    __device__ __forceinline__ void a_ready(const Unit&) const {}
    __device__ __forceinline__ void done(const Unit&) const {}
};

__device__ __forceinline__ unsigned cvt_pk_bf16(float lo, float hi) { unsigned r; asm volatile("v_cvt_pk_bf16_f32 %0, %1, %2" : "=v"(r) : "v"(lo), "v"(hi)); return r; }
typedef float f32x2 __attribute__((ext_vector_type(2)));
__device__ __forceinline__ f32x2 gelu_pk(f32x2 v) {
    const f32x2 av = __builtin_elementwise_abs(v), d = av * 0.2316418882f + 1.0f;
    f32x2 t; t.x = __builtin_amdgcn_rcpf(d.x); t.y = __builtin_amdgcn_rcpf(d.y);
    f32x2 q = t * 0.5307027145f + (-0.7265760135f); q = q * t + 0.7107068705f; q = q * t + (-0.142248368f); q = q * t + 0.127414796f; q = q * t;
    const f32x2 s = (v * v) * (-0.72134752044f);
    f32x2 e; e.x = __builtin_amdgcn_exp2f(s.x); e.y = __builtin_amdgcn_exp2f(s.y);
    const f32x2 m = v * (q * e), r = v - m;
    f32x2 o; o.x = v.x < 0.f ? m.x : r.x; o.y = v.y < 0.f ? m.y : r.y; return o;
}

template <int ACT  > struct EpiBf16 {
    static constexpr bool PERM = true, AFTER_DRAIN = false; static_assert(ACT == 0 || ACT == 1, "EpiBf16: ACT is 0 (none) or 1 (gelu_pk)");
    bf16_t* O; int ldc; const float* bias; int split_cols; size_t split_stride; float scale0;
    __device__ __forceinline__ void operator()(const f32x4 (&acc)[2][2][4][2], const Unit& u, int wr, int wc, int fr, int fq) const {
        const int row0 = u.pm * BM + wr * 64 + fr; int colt = u.pn * BM; bf16_t* base = O;
        float sc = 1.f; if (split_cols) { const int t = colt / split_cols; base += (size_t)t * split_stride; colt -= t * split_cols; if (t == 0) sc = scale0; }
        const int col0 = colt + wc * 32 + 8 * fq, bcol0 = u.pn * BM + wc * 32 + 8 * fq;
        f32x4 bv[2][2];
#pragma unroll
        for (int bj = 0; bj < 2; ++bj)
#pragma unroll
            for (int n = 0; n < 2; ++n) bv[bj][n] = bias ? *(const f32x4*)(bias + bcol0 + bj * HALF + 4 * n) : (f32x4){0.f, 0.f, 0.f, 0.f};
#pragma unroll
        for (int ai = 0; ai < 2; ++ai)
#pragma unroll
            for (int m = 0; m < 4; ++m) { bf16_t* rowp = base + (size_t)(row0 + ai * HALF + m * 16) * ldc + col0;
#pragma unroll
                for (int bj = 0; bj < 2; ++bj) { f32x4 v0 = acc[ai][bj][m][0] + bv[bj][0], v1 = acc[ai][bj][m][1] + bv[bj][1];
                    if (ACT == 1) { f32x2 a = gelu_pk((f32x2){v0[0], v0[1]}), b = gelu_pk((f32x2){v0[2], v0[3]}), c = gelu_pk((f32x2){v1[0], v1[1]}), d = gelu_pk((f32x2){v1[2], v1[3]});
                        v0 = (f32x4){a.x, a.y, b.x, b.y}; v1 = (f32x4){c.x, c.y, d.x, d.y}; }
                    v0 = v0 * sc; v1 = v1 * sc; u32x4 w; w.x = cvt_pk_bf16(v0[0], v0[1]); w.y = cvt_pk_bf16(v0[2], v0[3]); w.z = cvt_pk_bf16(v1[0], v1[1]); w.w = cvt_pk_bf16(v1[2], v1[3]);
                    *(u32x4*)(rowp + bj * HALF) = w; } }
    }
};
struct EpiResid {
    static constexpr bool PERM = true, AFTER_DRAIN = false;
    const float* base; float* out; bf16_t* hb; float* ss; int ldc;
    __device__ __forceinline__ void operator()(const f32x4 (&acc)[2][2][4][2], const Unit& u, int wr, int wc, int fr, int fq) const {
        const int row0 = u.pm * BM + wr * 64 + fr, col0 = u.pn * BM + wc * 32 + 8 * fq;
#pragma unroll
        for (int ai = 0; ai < 2; ++ai)
#pragma unroll
            for (int m = 0; m < 4; ++m) { const int row = row0 + ai * HALF + m * 16; const size_t off = (size_t)row * ldc + col0; float s = 0.f;
#pragma unroll
                for (int bj = 0; bj < 2; ++bj) {
                    const f32x4 b0 = *(const f32x4*)(base + off + bj * HALF), b1 = *(const f32x4*)(base + off + bj * HALF + 4);
                    const f32x4 v0 = acc[ai][bj][m][0] + b0, v1 = acc[ai][bj][m][1] + b1;
                    *(f32x4*)(out + off + bj * HALF) = v0; *(f32x4*)(out + off + bj * HALF + 4) = v1;
                    if (hb) { u32x4 w; w.x = cvt_pk_bf16(v0[0], v0[1]); w.y = cvt_pk_bf16(v0[2], v0[3]); w.z = cvt_pk_bf16(v1[0], v1[1]); w.w = cvt_pk_bf16(v1[2], v1[3]); *(u32x4*)(hb + off + bj * HALF) = w; }
                    s += (v0[0] * v0[0] + v0[1] * v0[1]) + (v0[2] * v0[2] + v0[3] * v0[3]) + (v1[0] * v1[0] + v1[1] * v1[1]) + (v1[2] * v1[2] + v1[3] * v1[3]);
                }
                if (ss) { s += __shfl_xor(s, 16); s += __shfl_xor(s, 32); if (fq == 0) (void)__hip_atomic_fetch_add(ss + row, s, __ATOMIC_RELAXED, __HIP_MEMORY_SCOPE_AGENT); }
                asm volatile("" ::: "memory"); }
    }
};
struct EpiSwiGLU {
    static constexpr bool PERM = true, AFTER_DRAIN = false;
    bf16_t* O; int ldc; const float* ss; float inv_d, eps;
    __device__ __forceinline__ void operator()(const f32x4 (&acc)[2][2][4][2], const Unit& u, int wr, int wc, int fr, int fq) const {
        const int row0 = u.pm * BM + wr * 64 + fr, col0 = u.pn * HALF + wc * 32 + 8 * fq;
#pragma unroll
        for (int ai = 0; ai < 2; ++ai)
#pragma unroll
            for (int m = 0; m < 4; ++m) { const int row = row0 + ai * HALF + m * 16; const float rstd = __builtin_amdgcn_rsqf(ss[row] * inv_d + eps);
                float a[8];
#pragma unroll
                for (int n = 0; n < 2; ++n)
#pragma unroll
                    for (int i = 0; i < 4; ++i) { const float g = acc[ai][0][m][n][i] * rstd, up = acc[ai][1][m][n][i] * rstd;
                        a[4 * n + i] = g * __builtin_amdgcn_rcpf(1.0f + __builtin_amdgcn_exp2f(-1.4426950408889634f * g)) * up; }
                u32x4 w; w.x = cvt_pk_bf16(a[0], a[1]); w.y = cvt_pk_bf16(a[2], a[3]); w.z = cvt_pk_bf16(a[4], a[5]); w.w = cvt_pk_bf16(a[6], a[7]);
                *(u32x4*)(O + (size_t)row * ldc + col0) = w; }
    }
};

struct EpiHeads {
    static constexpr bool PERM = true, AFTER_DRAIN = false;
    bf16_t* O; int Mrows;
    __device__ __forceinline__ void operator()(const f32x4 (&acc)[2][2][4][2], const Unit& u, int wr, int wc, int fr, int fq) const {
        const int row0 = u.pm * BM + wr * 64 + fr, col = wc * 32 + 8 * fq;
#pragma unroll
        for (int bj = 0; bj < 2; ++bj) { bf16_t* base = O + (size_t)(u.pn * 2 + bj) * Mrows * HALF + col;
#pragma unroll
            for (int ai = 0; ai < 2; ++ai)
#pragma unroll
                for (int m = 0; m < 4; ++m) { const f32x4 v0 = acc[ai][bj][m][0], v1 = acc[ai][bj][m][1];
                    u32x4 w; w.x = cvt_pk_bf16(v0[0], v0[1]); w.y = cvt_pk_bf16(v0[2], v0[3]); w.z = cvt_pk_bf16(v1[0], v1[1]); w.w = cvt_pk_bf16(v1[2], v1[3]);
                    *(u32x4*)(base + (size_t)(row0 + ai * HALF + m * 16) * HALF) = w; } }
    }
};
struct EpiNull {
    static constexpr bool PERM = true, AFTER_DRAIN = false;
    __device__ __forceinline__ void operator()(const f32x4 (&acc)[2][2][4][2], const Unit&, int, int, int, int) const {
#pragma unroll
        for (int ai = 0; ai < 2; ++ai)
#pragma unroll
            for (int bj = 0; bj < 2; ++bj)
#pragma unroll
                for (int m = 0; m < 4; ++m)
#pragma unroll
                    for (int n = 0; n < 2; ++n) asm volatile("" :: "v"(acc[ai][bj][m][n]));
    }
};

template <class Epi, class Sched, bool ALIGN_EPI = false, bool SP2 = false>
__device__ __forceinline__ void gemm_phase(PG8_LAS unsigned char* lds, const Gemm g, const Sched& S, const Epi& E) {
    int tid_ = threadIdx.x; asm volatile("" : "+v"(tid_));
    const int tid = tid_, wid = __builtin_amdgcn_readfirstlane(tid >> 6), lane = tid & 63, wr = wid >> 2, wc = wid & 3, fr = lane & 15, fq = lane >> 4;
    const int K = g.K, nt = K / BK;
    unsigned voffA[2], voffB[2];
#pragma unroll
    for (int i = 0; i < 2; ++i) { int R, C; stage_rc(tid * 16 + i * 8192, R, C); const int Rb = Epi::PERM ? ((R & ~31) + perm32(R & 31)) : R;
        voffA[i] = (unsigned)(R * K + C) * 2u; voffB[i] = (unsigned)(Rb * K + C) * 2u; }
    const size_t kstep = (size_t)(BK * 2);
    const size_t hstep = (size_t)HALF * K * 2;
    const size_t tstep = 2 * hstep;
    const unsigned ldsw = (unsigned)wid * 1024u;
    const int aoff = lds_byte(wr * 64 + fr, fq * 8), boff = lds_byte(wc * 32 + fr, fq * 8);
#define PG8_SA(b, h) (((b) * 2 + (h)) * HTB)
#define PG8_SB(b, h) ((4 + (b) * 2 + (h)) * HTB)
#define PG8_STAGE(bufoff, gbase, voff) do { _Pragma("unroll") for (int _i = 0; _i < 2; ++_i) \
        __builtin_amdgcn_global_load_lds((const unsigned*)((const char*)(gbase) + (voff)[_i]), (PG8_LAS unsigned*)(lds + (bufoff) + ldsw + _i * 8192), 16, 0, 0); } while (0)
#define PG8_LDA(dst, b, h) do { _Pragma("unroll") for (int m = 0; m < 4; ++m) _Pragma("unroll") for (int k = 0; k < 2; ++k) dst[m][k] = *(const PG8_LAS bf16x8*)(lds + PG8_SA(b, h) + aoff + m * 2048 + k * 1024); } while (0)
#define PG8_LDB(dst, b, h) do { _Pragma("unroll") for (int n = 0; n < 2; ++n) _Pragma("unroll") for (int k = 0; k < 2; ++k) dst[n][k] = *(const PG8_LAS bf16x8*)(lds + PG8_SB(b, h) + boff + n * 2048 + k * 1024); } while (0)
#define PG8_MMA(ai, bj, At, Bt) do { __builtin_amdgcn_s_setprio(1); _Pragma("unroll") for (int m = 0; m < 4; ++m) _Pragma("unroll") for (int n = 0; n < 2; ++n) _Pragma("unroll") for (int k = 0; k < 2; ++k) \
        acc[ai][bj][m][n] = __builtin_amdgcn_mfma_f32_16x16x32_bf16(Bt[n][k], At[m][k], acc[ai][bj][m][n], 0, 0, 0); __builtin_amdgcn_s_setprio(0); } while (0)
#define PG8_WAIT_V(n) asm volatile("s_waitcnt vmcnt(" #n ")" ::: "memory")
#define PG8_WAIT_L(n) asm volatile("s_waitcnt lgkmcnt(" #n ")" ::: "memory")
#define PG8_BAR __builtin_amdgcn_s_barrier()
#define PG8_SCHED __builtin_amdgcn_sched_barrier(0)
    Unit cur, nxt; int ui = 0;
    if (!S.next(0, cur)) return;
    f32x4 acc[2][2][4][2];
#pragma unroll
    for (int a = 0; a < 2; ++a)
#pragma unroll
        for (int b = 0; b < 2; ++b)
#pragma unroll
            for (int m = 0; m < 4; ++m)
#pragma unroll
                for (int n = 0; n < 2; ++n) acc[a][b][m][n] = (f32x4){0.f, 0.f, 0.f, 0.f};
    bf16x8 At[4][2], B0[2][2], B1[2][2];
    const char* cA = (const char*)g.A + (size_t)cur.pm * tstep; const char* cB = (const char*)g.Bt + (size_t)cur.pn * tstep;
    S.a_ready(cur);
    if constexpr (SP2) {
        PG8_STAGE(PG8_SB(0, 0), cB, voffB); PG8_STAGE(PG8_SB(0, 1), cB + hstep, voffB); PG8_STAGE(PG8_SA(0, 0), cA, voffA); PG8_STAGE(PG8_SA(0, 1), cA + hstep, voffA);
        if (wr == 1) PG8_BAR;
        PG8_WAIT_V(2); PG8_BAR;
        PG8_STAGE(PG8_SB(1, 0), cB + kstep, voffB); PG8_STAGE(PG8_SA(1, 0), cA + kstep, voffA); PG8_STAGE(PG8_SB(1, 1), cB + hstep + kstep, voffB);
        PG8_WAIT_V(6); PG8_BAR;
    } else {
        PG8_STAGE(PG8_SB(0, 0), cB, voffB); PG8_STAGE(PG8_SA(0, 0), cA, voffA); PG8_STAGE(PG8_SB(0, 1), cB + hstep, voffB); PG8_STAGE(PG8_SA(0, 1), cA + hstep, voffA);
        if (wr == 1) PG8_BAR;
        PG8_WAIT_V(4); PG8_BAR;
        PG8_STAGE(PG8_SB(1, 0), cB + kstep, voffB); PG8_STAGE(PG8_SA(1, 0), cA + kstep, voffA); PG8_STAGE(PG8_SB(1, 1), cB + hstep + kstep, voffB);
        PG8_WAIT_V(6); PG8_BAR;
    }
    for (;;) {
        const bool has_next = S.next(ui + 1, nxt);
        const char* nA = has_next ? (const char*)g.A + (size_t)nxt.pm * tstep : cA; const char* nB = has_next ? (const char*)g.Bt + (size_t)nxt.pn * tstep : cB;
        for (int t = 0; t < nt; t += 2) {
            const bool last = (t == nt - 2);
            const char* a1 = cA + (size_t)(t + 1) * kstep;
            const char* a2 = last ? nA : cA + (size_t)(t + 2) * kstep; const char* b2 = last ? nB : cB + (size_t)(t + 2) * kstep;
            const char* a3 = a2 + kstep; const char* b3 = b2 + kstep;
            if (last && has_next) S.a_ready(nxt);
            if constexpr (SP2) {
            PG8_LDB(B0, 0, 0); PG8_LDB(B1, 0, 1); PG8_SCHED; PG8_LDA(At, 0, 0); PG8_STAGE(PG8_SA(1, 1), a1 + hstep, voffA);
            PG8_WAIT_V(8); PG8_WAIT_L(0); PG8_BAR; PG8_MMA(0, 0, At, B0); PG8_MMA(0, 1, At, B1); PG8_BAR; PG8_SCHED;
            PG8_LDA(At, 0, 1); PG8_STAGE(PG8_SB(0, 0), b2, voffB); PG8_STAGE(PG8_SB(0, 1), b2 + hstep, voffB); PG8_STAGE(PG8_SA(0, 0), a2, voffA);
            PG8_WAIT_V(8); PG8_WAIT_L(0); PG8_BAR; PG8_MMA(1, 0, At, B0); PG8_MMA(1, 1, At, B1); PG8_BAR; PG8_SCHED;
            PG8_LDB(B0, 1, 0); PG8_LDB(B1, 1, 1); PG8_SCHED; PG8_LDA(At, 1, 0); PG8_STAGE(PG8_SA(0, 1), a2 + hstep, voffA);
            PG8_WAIT_V(8); PG8_WAIT_L(0); PG8_BAR; PG8_MMA(0, 0, At, B0); PG8_MMA(0, 1, At, B1); PG8_BAR; PG8_SCHED;
            PG8_LDA(At, 1, 1); PG8_STAGE(PG8_SB(1, 0), b3, voffB); PG8_STAGE(PG8_SB(1, 1), b3 + hstep, voffB); PG8_STAGE(PG8_SA(1, 0), a3, voffA);
            PG8_WAIT_V(8); PG8_WAIT_L(0); PG8_BAR; PG8_MMA(1, 0, At, B0); PG8_MMA(1, 1, At, B1); PG8_BAR; PG8_SCHED;
            } else {
            PG8_LDB(B0, 0, 0); PG8_SCHED; PG8_LDA(At, 0, 0); PG8_STAGE(PG8_SA(1, 1), a1 + hstep, voffA);
            PG8_WAIT_L(8); PG8_BAR; PG8_WAIT_L(0); PG8_MMA(0, 0, At, B0); PG8_BAR; PG8_SCHED;
            PG8_LDB(B1, 0, 1); PG8_STAGE(PG8_SB(0, 0), b2, voffB);
            PG8_BAR; PG8_WAIT_L(0); PG8_MMA(0, 1, At, B1); PG8_BAR;
            PG8_LDA(At, 0, 1); PG8_STAGE(PG8_SA(0, 0), a2, voffA);
            PG8_BAR; PG8_WAIT_L(0); PG8_MMA(1, 0, At, B0); PG8_BAR; PG8_SCHED;
            PG8_STAGE(PG8_SB(0, 1), b2 + hstep, voffB);
            PG8_WAIT_V(6); PG8_BAR; PG8_MMA(1, 1, At, B1); PG8_BAR;
            PG8_LDB(B0, 1, 0); PG8_SCHED; PG8_LDA(At, 1, 0); PG8_STAGE(PG8_SA(0, 1), a2 + hstep, voffA);
            PG8_WAIT_L(8); PG8_BAR; PG8_WAIT_L(0); PG8_MMA(0, 0, At, B0); PG8_BAR; PG8_SCHED;
            PG8_LDB(B1, 1, 1); PG8_STAGE(PG8_SB(1, 0), b3, voffB);
            PG8_BAR; PG8_WAIT_L(0); PG8_MMA(0, 1, At, B1); PG8_BAR;
            PG8_LDA(At, 1, 1); PG8_STAGE(PG8_SA(1, 0), a3, voffA);
            PG8_BAR; PG8_WAIT_L(0); PG8_MMA(1, 0, At, B0); PG8_BAR; PG8_SCHED;
            PG8_STAGE(PG8_SB(1, 1), b3 + hstep, voffB);
            PG8_WAIT_V(6); PG8_BAR; PG8_MMA(1, 1, At, B1); PG8_BAR;
            }
        }
        if constexpr (ALIGN_EPI) { if (wr == 0) PG8_BAR; }
        if constexpr (!Epi::AFTER_DRAIN) { E(acc, cur, wr, wc, fr, fq); S.done(cur); }
        if (!has_next) break;
#pragma unroll
        for (int a = 0; a < 2; ++a)
#pragma unroll
            for (int b = 0; b < 2; ++b)
#pragma unroll
                for (int m = 0; m < 4; ++m)
#pragma unroll
                    for (int n = 0; n < 2; ++n) acc[a][b][m][n] = (f32x4){0.f, 0.f, 0.f, 0.f};
        cur = nxt; cA = nA; cB = nB; ++ui;
        if constexpr (ALIGN_EPI) { if (wr == 1) PG8_BAR; }
    }
    PG8_WAIT_V(0);
    if constexpr (!ALIGN_EPI) { if (wr == 0) PG8_BAR; }
    PG8_BAR;
    if constexpr (Epi::AFTER_DRAIN) { E.fused(acc, cur, wr, wc, fr, fq, lds, wid, lane); S.done(cur); }
#undef PG8_SA
#undef PG8_SB
#undef PG8_STAGE
#undef PG8_LDA
#undef PG8_LDB
#undef PG8_MMA
#undef PG8_WAIT_V
#undef PG8_WAIT_L
#undef PG8_BAR
#undef PG8_SCHED
}
}

constexpr int NWAVES = 8;
#ifndef ATTN_NAIVE
#define ATTN_NAIVE 0
#endif
#ifndef ATTN_V1
#define ATTN_V1 0
#endif
#ifndef R1_V1
#define R1_V1 0
#endif
#ifndef R3_V1
#define R3_V1 0
#endif
#ifndef R1_NAIVE
#define R1_NAIVE 0
#endif
#ifndef R3_NAIVE
#define R3_NAIVE 0
#endif
#ifndef PROBE_REPEAT
#define PROBE_REPEAT 0
#endif
#ifndef PROBE_T
#define PROBE_T 0
#endif
#ifndef PROBE_MULT
#define PROBE_MULT 16
#endif
#ifndef PROBE_USE_B
#define PROBE_USE_B 0
#endif
#ifndef PROBE_BLOCK
#define PROBE_BLOCK 0
#endif
#ifndef MK_N_LAUNCHES
#define MK_N_LAUNCHES 1
#endif
constexpr int PER_PHASE = 9;
constexpr int N_LAUNCHES = MK_N_LAUNCHES;

constexpr int BATCH = 4, SEQ = 4096, D = 2048, M = BATCH * SEQ, HD = 128, NH = 8, DATT = 1024, DRET = 1024, DIN = 7168, DFF = 5632, NGU = 2 * DFF, CH = 128, NCH = SEQ / CH;
constexpr float EPS = 1e-6f;
constexpr int COL_QA = 0, COL_KA = 1024, COL_VA = 2048, COL_QR = 3072, COL_KR = 4096, COL_VR = 5120, COL_GR = 6144;

constexpr size_t MiB = 1u << 20;
constexpr size_t WS_CTL = 0, CTL_ZERO_BYTES = 1 * MiB;
constexpr size_t WS_WIN = 1 * MiB, WS_WOUT = 29 * MiB, WS_WGU = 37 * MiB, WS_WDN = 81 * MiB;
constexpr size_t WS_LSE = 103 * MiB;
constexpr size_t WS_XN = 105 * MiB;
constexpr size_t WS_PROJ = 169 * MiB;
constexpr size_t WS_MIX = 393 * MiB;
constexpr size_t WS_END = 457 * MiB;
static_assert(WS_WIN + (size_t)DIN * D * 2 <= WS_WOUT && WS_WOUT + (size_t)D * D * 2 <= WS_WGU && WS_WGU + (size_t)NGU * D * 2 <= WS_WDN && WS_WDN + (size_t)D * DFF * 2 <= WS_LSE, "weight map");
static_assert(WS_XN + (size_t)M * D * 2 <= WS_PROJ && WS_PROJ + (size_t)M * DIN * 2 <= WS_MIX && WS_MIX + (size_t)M * D * 2 <= WS_END, "activation map");
constexpr int CW_TMO = 0, CW_CODE = 1, CW_BAR = 4096;
constexpr size_t CTL_SS1 = 256 * 1024;
constexpr size_t ST_HALF = (size_t)BATCH * NH * NCH * HD * HD;

constexpr int RING_OFF = 0, RING_BYTES = 143360;
constexpr int LDSCTL_OFF = RING_BYTES, MISC_OFF = LDSCTL_OFF + 320;
constexpr int LDS_BYTES = 147456;
static_assert(MISC_OFF + 128 <= LDS_BYTES, "LDS map");

#define GAS __attribute__((address_space(1)))
#define LAS __attribute__((address_space(3)))
typedef unsigned short bf16;
typedef unsigned v4u __attribute__((ext_vector_type(4)));
typedef float f32x4 __attribute__((ext_vector_type(4)));
typedef GAS unsigned gu32;
#define RLX_AGENT __ATOMIC_RELAXED, __HIP_MEMORY_SCOPE_AGENT
#define LDS_WAIT() asm volatile("s_waitcnt lgkmcnt(0)" ::: "memory")
#define VM_WAIT() asm volatile("s_waitcnt vmcnt(0)" ::: "memory")
__device__ __forceinline__ unsigned f2bf(float f) { unsigned u = __builtin_bit_cast(unsigned, f); return (u + 0x7fffu + ((u >> 16) & 1u)) >> 16; }
__device__ __forceinline__ unsigned pk2(float lo, float hi) { return f2bf(lo) | (f2bf(hi) << 16); }
__device__ __forceinline__ float bflo(unsigned w) { return __builtin_bit_cast(float, w << 16); }
__device__ __forceinline__ float bfhi(unsigned w) { return __builtin_bit_cast(float, w & 0xffff0000u); }

#define XB_TMO      128
#define XB_XCNT(j)  (256  + 64 * (j))
#define XB_XSUB(j)  (1280 + 64 * (j))
#define XB_XGEN(j)  (2304 + 64 * (j))
#define XB_TOP      3328
#define XB_TOPGEN   3392
#define XCD_BAR_WORDS 3456
#define XB_SPIN_CAP (1u << 18)

__device__ __forceinline__ unsigned xb_ld(unsigned* p)              { return __hip_atomic_load(p, __ATOMIC_RELAXED, __HIP_MEMORY_SCOPE_AGENT); }
__device__ __forceinline__ unsigned xb_add(unsigned* p, unsigned v) { return __hip_atomic_fetch_add(p, v, __ATOMIC_RELAXED, __HIP_MEMORY_SCOPE_AGENT); }
__device__ __forceinline__ unsigned xb_xcc_id() { return (unsigned)__builtin_amdgcn_s_getreg((3 << 11) | 20) & 0xFu; }
#define XB_SPIN(cond, bar) do { unsigned _sp = 0; while (cond) { __builtin_amdgcn_s_sleep(1); \
    if ((++_sp & 255u) == 0u) { if (xb_ld(&(bar)[XB_TMO])) break; if (_sp > XB_SPIN_CAP) { atomicAdd(&(bar)[XB_TMO], 1u); break; } } } } while (0)

struct XcdBarrier {
    unsigned* bar; unsigned x;
    volatile LAS unsigned* st;
};

__device__ __forceinline__ XcdBarrier xcd_barrier_post(unsigned* bar, volatile LAS unsigned* st) {
    XcdBarrier b; b.bar = bar; b.x = xb_xcc_id(); b.st = st;
    if (threadIdx.x == 0) st[2] = xb_add(&bar[XB_XCNT(b.x)], 1u);
    return b;
}
__device__ __forceinline__ void xcd_barrier_complete(unsigned* bar, unsigned x, unsigned& nloc, unsigned& nx) {
    const unsigned G = gridDim.x * gridDim.y * gridDim.z;
    unsigned sum, cnt, mine, sp = 0u;
    for (;;) {
        sum = 0u; cnt = 0u; mine = 0u;
#pragma unroll
        for (unsigned j = 0; j < 16; ++j) { const unsigned c = xb_ld(&bar[XB_XCNT(j)]); sum += c; cnt += (c > 0u) ? 1u : 0u; mine = (j == x) ? c : mine; }
        if (sum == G) break;
        __builtin_amdgcn_s_sleep(1);
        if ((++sp & 255u) == 0u) { if (xb_ld(&bar[XB_TMO])) break; if (sp > XB_SPIN_CAP) { atomicAdd(&bar[XB_TMO], 1u); break; } }
    }
    nloc = mine > 0u ? mine : 1u; nx = cnt > 0u ? cnt : 1u;
}

__device__ __forceinline__ void xcd_barrier(const XcdBarrier& b) {
    asm volatile("s_waitcnt vmcnt(0)" ::: "memory");
    __syncthreads();
    if (threadIdx.x == 0) {
        unsigned* bar = b.bar;
        __builtin_amdgcn_s_waitcnt(0);
        unsigned nloc = b.st[0], nx = b.st[1];
        if (nloc == 0u) { xcd_barrier_complete(bar, b.x, nloc, nx); b.st[0] = nloc; b.st[1] = nx; }
        const unsigned old = xb_add(&bar[XB_XSUB(b.x)], 1u);
        const unsigned gen = old / nloc;
        if (old + 1u == (gen + 1u) * nloc) {
            __builtin_amdgcn_fence(__ATOMIC_RELEASE, "agent");
            asm volatile("s_waitcnt vmcnt(0)" ::: "memory");
            const unsigned og = xb_add(&bar[XB_TOP], 1u);
            const unsigned tg = og / nx;
            if (og + 1u == (tg + 1u) * nx) xb_add(&bar[XB_TOPGEN], 1u);
            else XB_SPIN(xb_ld(&bar[XB_TOPGEN]) == tg, bar);
            __builtin_amdgcn_fence(__ATOMIC_ACQUIRE, "agent");
            xb_add(&bar[XB_XGEN(b.x)], 1u);
            asm volatile("s_waitcnt vmcnt(0)" ::: "memory");
        } else {
            XB_SPIN(xb_ld(&bar[XB_XGEN(b.x)]) == gen, bar);
            __builtin_amdgcn_fence(__ATOMIC_ACQUIRE, "agent");
            asm volatile("s_waitcnt vmcnt(0)" ::: "memory");
        }
    }
    __syncthreads();
}

struct Frame {
    LAS unsigned char* lds;
    volatile LAS unsigned* MISC;
    gu32* ctl;
    int tid, lane, wave;
    int vcu, G;
    const float *x, *w_mix, *w_in, *decf, *decb, *w_retn, *w_out, *w_ffn, *w_gate, *w_up, *w_down, *w_fin; float* out;
    bf16 *Win_t, *Wout_t, *Wgu_t, *Wdn_t;
    bf16 *XN, *PROJ, *MIX, *ACT;
    float *STF, *STB, *SS1, *LSE;
    unsigned long long tA, tB;
};
#if PROBE_T
#define RT() __builtin_amdgcn_s_memrealtime()
#define T_ADD(acc, t0) do { __builtin_amdgcn_sched_barrier(0); (acc) += RT() - (t0); __builtin_amdgcn_sched_barrier(0); } while (0)
#define T_START(t0) do { __builtin_amdgcn_sched_barrier(0); (t0) = RT(); __builtin_amdgcn_sched_barrier(0); } while (0)
#else
#define T_ADD(acc, t0) do {} while (0)
#define T_START(t0) do {} while (0)
#endif

__device__ __forceinline__ float wave_sum(float v) {
#pragma unroll
    for (int o = 1; o < 64; o <<= 1) v += __shfl_xor(v, o);
    return v;
}
__device__ __forceinline__ float wave_max(float v) {
#pragma unroll
    for (int o = 1; o < 64; o <<= 1) v = fmaxf(v, __shfl_xor(v, o));
    return v;
}
__device__ __forceinline__ void p0_transpose_item(const float* W, int K, int N, bf16* WT, int row_base, const float* kscale, LAS float* scr, int k0, int n0, int lane) {
#pragma unroll 8
    for (int i = 0; i < 32; ++i) { const int kk = 2 * i + (lane >> 5); float v = W[(size_t)(k0 + kk) * N + n0 + (lane & 31)]; if (kscale) v *= kscale[k0 + kk]; scr[kk * 33 + (lane & 31)] = v; }
    LDS_WAIT(); asm volatile("" ::: "memory");
    const int c = lane & 7;
#pragma unroll
    for (int j = 0; j < 4; ++j) { const int n = (lane >> 3) + 8 * j; const LAS float* s = scr + (8 * c) * 33 + n;
        v4u o; o.x = pk2(s[0 * 33], s[1 * 33]); o.y = pk2(s[2 * 33], s[3 * 33]); o.z = pk2(s[4 * 33], s[5 * 33]); o.w = pk2(s[6 * 33], s[7 * 33]);
        *(GAS v4u*)(WT + (size_t)(row_base + n) * K + k0 + 8 * c) = o; }
    LDS_WAIT(); asm volatile("" ::: "memory");
}
__device__ __forceinline__ void p0_prologue(Frame& F) {
    LAS float* scr = (LAS float*)(F.lds + RING_OFF + F.wave * 16384);
    const int gw = F.vcu * NWAVES + F.wave, NGW = F.G * NWAVES;
    constexpr int I_IN = (D / 64) * (DIN / 32), I_OUT = (D / 64) * (D / 32), I_G = (D / 64) * (DFF / 32), I_DN = (DFF / 64) * (D / 32);
    constexpr int NITEMS = I_IN + I_OUT + 2 * I_G + I_DN;
    for (int it = gw; it < NITEMS; it += NGW) {
        int r = it;
        if (r < I_IN) { const int nblk = DIN / 32, kb = r / nblk, nb = r % nblk; p0_transpose_item(F.w_in, D, DIN, F.Win_t, 32 * nb, nullptr, scr, 64 * kb, 32 * nb, F.lane); continue; } r -= I_IN;
        if (r < I_OUT) { const int nblk = D / 32, kb = r / nblk, nb = r % nblk; p0_transpose_item(F.w_out, D, D, F.Wout_t, 32 * nb, nullptr, scr, 64 * kb, 32 * nb, F.lane); continue; } r -= I_OUT;
        if (r < 2 * I_G) { const int up = r >= I_G; if (up) r -= I_G; const int nblk = DFF / 32, kb = r / nblk, nb = r % nblk, n0 = 32 * nb;
            p0_transpose_item(up ? F.w_up : F.w_gate, D, DFF, F.Wgu_t, 256 * (n0 >> 7) + (n0 & 127) + (up ? 128 : 0), F.w_ffn, scr, 64 * kb, n0, F.lane); continue; } r -= 2 * I_G;
        { const int nblk = D / 32, kb = r / nblk, nb = r % nblk; p0_transpose_item(F.w_down, DFF, D, F.Wdn_t, 32 * nb, nullptr, scr, 64 * kb, 32 * nb, F.lane); }
    }
    for (int m = gw; m < M; m += NGW) {
        const GAS f32x4* xr = (const GAS f32x4*)(F.x + (size_t)m * D) + F.lane; const GAS f32x4* wr = (const GAS f32x4*)F.w_mix + F.lane;
        f32x4 v[8]; float s = 0.f;
#pragma unroll
        for (int j = 0; j < 8; ++j) { v[j] = xr[64 * j]; s += (v[j].x * v[j].x + v[j].y * v[j].y) + (v[j].z * v[j].z + v[j].w * v[j].w); }
        const float rstd = 1.0f / sqrtf(wave_sum(s) * (1.0f / D) + EPS);
        GAS unsigned long long* o8 = (GAS unsigned long long*)(F.XN + (size_t)m * D) + F.lane;
#pragma unroll
        for (int j = 0; j < 8; ++j) { const f32x4 w = wr[64 * j]; o8[64 * j] = (unsigned long long)pk2(v[j].x * rstd * w.x, v[j].y * rstd * w.y) | ((unsigned long long)pk2(v[j].z * rstd * w.z, v[j].w * rstd * w.w) << 32); }
    }
}

#define HP(col, h) (F.PROJ + (size_t)((col) / HD + (h)) * M * HD)
__device__ __forceinline__ void p2_attn_naive(Frame& F) {
    LAS float* qs = (LAS float*)(F.lds + RING_OFF + F.wave * 4096);
    LAS float* ps = qs + 128;
    const int gw = F.vcu * NWAVES + F.wave, NGW = F.G * NWAVES, lane = F.lane;
    for (int item = gw; item < BATCH * NH * SEQ; item += NGW) {
        const int bh = item >> 12, t = item & 4095, b = bh >> 3, h = bh & 7;
        const float slope = exp2f(-(float)(h + 1));
        const bf16* Qrow = HP(COL_QA, h) + (size_t)(b * SEQ + t) * HD;
        const bf16* Kb = HP(COL_KA, h) + (size_t)(b * SEQ) * HD;
        const bf16* Vb = HP(COL_VA, h) + (size_t)(b * SEQ) * HD;
        { const unsigned qq = *(const GAS unsigned*)(Qrow + 2 * lane); qs[2 * lane] = bflo(qq) * 0.08838834764831845f; qs[2 * lane + 1] = bfhi(qq) * 0.08838834764831845f; }
        LDS_WAIT();
        float sc[3][3]; float mx = -INFINITY;
#pragma unroll
        for (int p = 0; p < 3; ++p) { const int dil = 1 << (2 * p);
#pragma unroll
            for (int k = 0; k < 3; ++k) { const int idx = lane + 64 * k, j = idx - 64, s = t + j * dil; float v = -INFINITY;
                if (idx < 129 && s >= 0 && s < SEQ) { const GAS v4u* kr = (const GAS v4u*)(Kb + (size_t)s * HD); float dot = 0.f;
#pragma unroll 4
                    for (int c = 0; c < 16; ++c) { const v4u kk = kr[c]; const LAS float* q8 = qs + 8 * c;
                        dot += q8[0] * bflo(kk.x) + q8[1] * bfhi(kk.x) + q8[2] * bflo(kk.y) + q8[3] * bfhi(kk.y) + q8[4] * bflo(kk.z) + q8[5] * bfhi(kk.z) + q8[6] * bflo(kk.w) + q8[7] * bfhi(kk.w); }
                    v = dot - slope * (float)(dil * (j < 0 ? -j : j)); }
                sc[p][k] = v; mx = fmaxf(mx, v); } }
        mx = wave_max(mx);
        float l = 0.f;
#pragma unroll
        for (int p = 0; p < 3; ++p)
#pragma unroll
            for (int k = 0; k < 3; ++k) { const float e = __expf(sc[p][k] - mx); l += e; ps[p * 192 + lane + 64 * k] = e; }
        l = wave_sum(l);
        LDS_WAIT();
        float o0 = 0.f, o1 = 0.f;
#pragma unroll
        for (int p = 0; p < 3; ++p) { const int dil = 1 << (2 * p);
            for (int idx = 0; idx < 129; ++idx) { const int s = t + (idx - 64) * dil;
                if (s >= 0 && s < SEQ) { const float pv = ps[p * 192 + idx]; const unsigned vv = *(const GAS unsigned*)(Vb + (size_t)s * HD + 2 * lane); o0 += pv * bflo(vv); o1 += pv * bfhi(vv); } } }
        const float il = 1.0f / l;
        *(GAS unsigned*)(F.MIX + (size_t)(b * SEQ + t) * D + h * HD + 2 * lane) = pk2(o0 * il, o1 * il);
        LDS_WAIT();
    }
}
__device__ __forceinline__ void p2_r1_naive(Frame& F) {
    LAS float* Ks = (LAS float*)(F.lds + RING_OFF); LAS float* Vs = Ks + CH * HD;
    const int tid = F.tid;
    for (int item = F.vcu; item < BATCH * NH * NCH; item += F.G) {
        const int bh = item >> 5, c = item & 31, b = bh >> 3, h = bh & 7; const size_t row0 = (size_t)b * SEQ + c * CH;
        const bf16* Kg = HP(COL_KR, h) + row0 * HD; const bf16* Vg = HP(COL_VR, h) + row0 * HD;
        { const int row = tid >> 2, seg = tid & 3;
#pragma unroll
          for (int q = 0; q < 4; ++q) { const v4u kk = *(const GAS v4u*)(Kg + (size_t)row * HD + 32 * seg + 8 * q); const v4u vv = *(const GAS v4u*)(Vg + (size_t)row * HD + 32 * seg + 8 * q);
              LAS float* kd = Ks + row * HD + 32 * seg + 8 * q; LAS float* vd = Vs + row * HD + 32 * seg + 8 * q;
              kd[0] = bflo(kk.x); kd[1] = bfhi(kk.x); kd[2] = bflo(kk.y); kd[3] = bfhi(kk.y); kd[4] = bflo(kk.z); kd[5] = bfhi(kk.z); kd[6] = bflo(kk.w); kd[7] = bfhi(kk.w);
              vd[0] = bflo(vv.x); vd[1] = bfhi(vv.x); vd[2] = bflo(vv.y); vd[3] = bfhi(vv.y); vd[4] = bflo(vv.z); vd[5] = bfhi(vv.z); vd[6] = bflo(vv.w); vd[7] = bfhi(vv.w); } }
        __syncthreads();
        const float lgf = -__expf(F.decf[h]), lgb = -__expf(F.decb[h]);
        const int e = tid >> 2, dq = tid & 3;
        float af[32], ab[32];
#pragma unroll
        for (int i = 0; i < 32; ++i) { af[i] = 0.f; ab[i] = 0.f; }
        for (int j = 0; j < CH; ++j) { const float v = Vs[j * HD + e], vf = v * __expf(lgf * (float)(CH - 1 - j)), vb = v * __expf(lgb * (float)j);
            const LAS f32x4* k4 = (const LAS f32x4*)(Ks + j * HD + 32 * dq);
#pragma unroll
            for (int i = 0; i < 8; ++i) { const f32x4 k = k4[i];
                af[4 * i] += vf * k.x; af[4 * i + 1] += vf * k.y; af[4 * i + 2] += vf * k.z; af[4 * i + 3] += vf * k.w;
                ab[4 * i] += vb * k.x; ab[4 * i + 1] += vb * k.y; ab[4 * i + 2] += vb * k.z; ab[4 * i + 3] += vb * k.w; } }
        GAS f32x4* of = (GAS f32x4*)(F.STF + (size_t)item * HD * HD + e * HD + 32 * dq); GAS f32x4* ob = (GAS f32x4*)(F.STB + (size_t)item * HD * HD + e * HD + 32 * dq);
#pragma unroll
        for (int i = 0; i < 8; ++i) { of[i] = (f32x4){af[4 * i], af[4 * i + 1], af[4 * i + 2], af[4 * i + 3]}; ob[i] = (f32x4){ab[4 * i], ab[4 * i + 1], ab[4 * i + 2], ab[4 * i + 3]}; }
        __syncthreads();
    }
}
__device__ __forceinline__ bf16* sbf_row(bf16* proj, int slot, int e);
__device__ __forceinline__ void p3_scan(Frame& F) {
    const int gt = F.vcu * (NWAVES * 64) + F.tid, NT = F.G * NWAVES * 64;
    for (int idx = gt; idx < 2 * BATCH * NH * 4096; idx += NT) {
        const int dir = idx / (BATCH * NH * 4096), rem = idx % (BATCH * NH * 4096), bh = rem >> 12, q = rem & 4095, h = bh & 7;
        const float g = __expf(-__expf(dir ? F.decb[h] : F.decf[h]) * (float)CH);
        GAS f32x4* base = (GAS f32x4*)(dir ? F.STB : F.STF) + (size_t)bh * NCH * 4096 + q;
        f32x4 s = (f32x4){0.f, 0.f, 0.f, 0.f};
#pragma unroll 8
        for (int cc = 0; cc < NCH; ++cc) { const int c = dir ? NCH - 1 - cc : cc; const f32x4 t = base[(size_t)c * 4096];
#if R3_NAIVE
            base[(size_t)c * 4096] = s;
#else
            { unsigned long long o = (unsigned long long)pk2(s.x, s.y) | ((unsigned long long)pk2(s.z, s.w) << 32); *(GAS unsigned long long*)(sbf_row(F.PROJ, 2 * (bh * NCH + c) + dir, q >> 5) + 4 * (q & 31)) = o; }
#endif
            s = s * g + t; }
    }
}
__device__ __forceinline__ void p4_r3_naive(Frame& F) {
    LAS bf16* Qs = (LAS bf16*)(F.lds + RING_OFF); LAS bf16* KVs = Qs + CH * HD; LAS float* As = (LAS float*)(F.lds + RING_OFF + 65536);
    const int tid = F.tid; const float scale = 0.08838834764831845f;
    for (int item = F.vcu; item < BATCH * NH * NCH; item += F.G) {
        const int bh = item >> 5, c = item & 31, b = bh >> 3, h = bh & 7; const size_t row0 = (size_t)b * SEQ + c * CH;
        const bf16* Qg = HP(COL_QR, h) + row0 * HD; const bf16* Kg = HP(COL_KR, h) + row0 * HD;
        const bf16* Vg = HP(COL_VR, h) + row0 * HD; const bf16* Gg = HP(COL_GR, h) + row0 * HD;
        const float lgf = -__expf(F.decf[h]), lgb = -__expf(F.decb[h]);
        const int i = tid >> 2, part = tid & 3;
#pragma unroll
        for (int q = 0; q < 4; ++q) { *(LAS v4u*)(Qs + i * HD + 32 * part + 8 * q) = *(const GAS v4u*)(Qg + (size_t)i * HD + 32 * part + 8 * q);
                                      *(LAS v4u*)(KVs + i * HD + 32 * part + 8 * q) = *(const GAS v4u*)(Kg + (size_t)i * HD + 32 * part + 8 * q); }
        __syncthreads();
        for (int jj = 0; jj < 32; ++jj) { const int j = 32 * part + jj; float dot = 0.f;
#pragma unroll 4
            for (int c8 = 0; c8 < 16; ++c8) { const v4u qq = *(const LAS v4u*)(Qs + i * HD + 8 * c8), kk = *(const LAS v4u*)(KVs + j * HD + 8 * c8);
                dot += bflo(qq.x) * bflo(kk.x) + bfhi(qq.x) * bfhi(kk.x) + bflo(qq.y) * bflo(kk.y) + bfhi(qq.y) * bfhi(kk.y) + bflo(qq.z) * bflo(kk.z) + bfhi(qq.z) * bfhi(kk.z) + bflo(qq.w) * bflo(kk.w) + bfhi(qq.w) * bfhi(kk.w); }
            const float dec = (j <= i) ? __expf(lgf * (float)(i - j)) : __expf(lgb * (float)(j - i));
            As[i * CH + j] = dot * scale * dec; }
        __syncthreads();
#pragma unroll
        for (int q = 0; q < 4; ++q) *(LAS v4u*)(KVs + i * HD + 32 * part + 8 * q) = *(const GAS v4u*)(Vg + (size_t)i * HD + 32 * part + 8 * q);
        __syncthreads();
        const int e0 = 32 * part;
        float acc[32], accf[32], accb[32];
#pragma unroll
        for (int k = 0; k < 32; ++k) { acc[k] = 0.f; accf[k] = 0.f; accb[k] = 0.f; }
        for (int j = 0; j < CH; ++j) { const float a = As[i * CH + j];
#pragma unroll
            for (int q = 0; q < 4; ++q) { const v4u vv = *(const LAS v4u*)(KVs + j * HD + e0 + 8 * q);
                acc[8 * q] += a * bflo(vv.x); acc[8 * q + 1] += a * bfhi(vv.x); acc[8 * q + 2] += a * bflo(vv.y); acc[8 * q + 3] += a * bfhi(vv.y);
                acc[8 * q + 4] += a * bflo(vv.z); acc[8 * q + 5] += a * bfhi(vv.z); acc[8 * q + 6] += a * bflo(vv.w); acc[8 * q + 7] += a * bfhi(vv.w); } }
        const float* Sf = F.STF + (size_t)item * HD * HD; const float* Sb = F.STB + (size_t)item * HD * HD;
        for (int d4 = 0; d4 < HD; d4 += 4) { const unsigned long long qq = *(const LAS unsigned long long*)(Qs + i * HD + d4);
            const float q0 = bflo((unsigned)qq), q1 = bfhi((unsigned)qq), q2 = bflo((unsigned)(qq >> 32)), q3 = bfhi((unsigned)(qq >> 32));
#pragma unroll
            for (int k = 0; k < 32; ++k) { const f32x4 sf = *(const GAS f32x4*)(Sf + (size_t)(e0 + k) * HD + d4), sb = *(const GAS f32x4*)(Sb + (size_t)(e0 + k) * HD + d4);
                accf[k] += q0 * sf.x + q1 * sf.y + q2 * sf.z + q3 * sf.w; accb[k] += q0 * sb.x + q1 * sb.y + q2 * sb.z + q3 * sb.w; } }
        const float ff = __expf(lgf * (float)(i + 1)) * scale, fb = __expf(lgb * (float)(CH - i)) * scale;
        float ssq = 0.f;
#pragma unroll
        for (int k = 0; k < 32; ++k) { acc[k] += ff * accf[k] + fb * accb[k]; ssq += acc[k] * acc[k]; }
        ssq += __shfl_xor(ssq, 1); ssq += __shfl_xor(ssq, 2);
        const float rms = 1.0f / sqrtf(ssq * (1.0f / HD) + EPS);
        bf16* orow = F.MIX + (row0 + i) * D + DATT + h * HD + e0;
#pragma unroll
        for (int q = 0; q < 4; ++q) { const v4u gg = *(const GAS v4u*)(Gg + (size_t)i * HD + e0 + 8 * q); float r[8]; const float gv[8] = {bflo(gg.x), bfhi(gg.x), bflo(gg.y), bfhi(gg.y), bflo(gg.z), bfhi(gg.z), bflo(gg.w), bfhi(gg.w)};
#pragma unroll
            for (int k = 0; k < 8; ++k) { const float g = gv[k]; r[k] = acc[8 * q + k] * rms * F.w_retn[h * HD + e0 + 8 * q + k] * (g / (1.0f + __expf(-g))); }
            v4u o; o.x = pk2(r[0], r[1]); o.y = pk2(r[2], r[3]); o.z = pk2(r[4], r[5]); o.w = pk2(r[6], r[7]); *(GAS v4u*)(orow + 8 * q) = o; }
        __syncthreads();
    }
}
__device__ __forceinline__ void p8_final(Frame& F, bool dummy) {
    const int gw = F.vcu * NWAVES + F.wave, NGW = F.G * NWAVES;
    for (int m = gw; m < M; m += NGW) {
        GAS f32x4* xr = (GAS f32x4*)(F.out + (size_t)m * D) + F.lane; const GAS f32x4* wr = (const GAS f32x4*)F.w_fin + F.lane;
        f32x4 v[8]; float s = 0.f;
#pragma unroll
        for (int j = 0; j < 8; ++j) { v[j] = xr[64 * j]; s += (v[j].x * v[j].x + v[j].y * v[j].y) + (v[j].z * v[j].z + v[j].w * v[j].w); }
        const float rstd = 1.0f / sqrtf(wave_sum(s) * (1.0f / D) + EPS);
#pragma unroll
        for (int j = 0; j < 8; ++j) xr[64 * j] = dummy ? (v[j] + (rstd > 1e30f ? 1.0f : 0.0f)) : v[j] * rstd * wr[64 * j];
    }
}


typedef short bf16x8 __attribute__((ext_vector_type(8)));
typedef float f32x16 __attribute__((ext_vector_type(16)));
typedef unsigned u32x2 __attribute__((ext_vector_type(2)));
typedef float f32x2_t __attribute__((ext_vector_type(2))); typedef __bf16 bf16x2_t __attribute__((ext_vector_type(2)));
__device__ __forceinline__ unsigned cvtpk(float lo, float hi) { f32x2_t v = {lo, hi}; bf16x2_t b = __builtin_convertvector(v, bf16x2_t); return __builtin_bit_cast(unsigned, b); }
#define MFMA32(a, b, c) __builtin_amdgcn_mfma_f32_32x32x16_bf16((a), (b), (c), 0, 0, 0)
__device__ __forceinline__ f32x16 zero16() { f32x16 z;
#pragma unroll
    for (int i = 0; i < 16; ++i) z[i] = 0.f; return z; }
__device__ __forceinline__ bf16x8 pack8(const f32x16& x, int sp) {
    v4u p; p.x = cvtpk(x[8 * sp + 0], x[8 * sp + 1]); p.y = cvtpk(x[8 * sp + 2], x[8 * sp + 3]); p.z = cvtpk(x[8 * sp + 4], x[8 * sp + 5]); p.w = cvtpk(x[8 * sp + 6], x[8 * sp + 7]);
    return __builtin_bit_cast(bf16x8, p); }
__device__ __forceinline__ bf16x8 cat8(u32x2 lo, u32x2 hi) { v4u p; p.x = lo.x; p.y = lo.y; p.z = hi.x; p.w = hi.y; return __builtin_bit_cast(bf16x8, p); }
__device__ __forceinline__ unsigned elt16(const v4u& v, int i) { const unsigned w = v[i >> 1]; return (i & 1) ? (w >> 16) : (w & 0xffffu); }

__device__ __forceinline__ bf16* sbf_row(bf16* proj, int slot, int e) { return proj + ((size_t)slot * HD + e) * HD; }
__device__ __forceinline__ void p2_r1_mfma(Frame& F) {
    constexpr int P = 272;
    LAS unsigned char* KT = F.lds + RING_OFF; LAS unsigned char* VFT = KT + 128 * P; LAS unsigned char* VBT = VFT + 128 * P;
    const int w = F.wave;
    for (int item = F.vcu; item < BATCH * NH * NCH; item += F.G) {
        int tid = F.tid; asm volatile("" : "+v"(tid)); const int lane = tid & 63, r = lane & 31, hh = lane >> 5;
        const int bh = item >> 5, c = item & 31, b = bh >> 3, h = bh & 7; const size_t row0 = (size_t)b * SEQ + c * CH;
        const bf16* Kg = HP(COL_KR, h) + row0 * HD; const bf16* Vg = HP(COL_VR, h) + row0 * HD;
        const float lgf = -__expf(F.decf[h]), lgb = -__expf(F.decb[h]);
        {
            const int jg = tid & 31, dc = tid >> 5; v4u kr[4], vr[4]; float sf[4], sb[4];
#pragma unroll
            for (int q = 0; q < 4; ++q) { kr[q] = *(const GAS v4u*)(Kg + (size_t)(4 * jg + q) * HD + 8 * dc); vr[q] = *(const GAS v4u*)(Vg + (size_t)(4 * jg + q) * HD + 8 * dc);
                sf[q] = __expf(lgf * (float)(CH - 1 - (4 * jg + q))); sb[q] = __expf(lgb * (float)(4 * jg + q)); }
#pragma unroll
            for (int i = 0; i < 8; ++i) { const int off = (8 * dc + i) * P + 8 * jg;
                u32x2 kk; kk.x = elt16(kr[0], i) | (elt16(kr[1], i) << 16); kk.y = elt16(kr[2], i) | (elt16(kr[3], i) << 16); *(LAS u32x2*)(KT + off) = kk;
                const float v0 = __builtin_bit_cast(float, elt16(vr[0], i) << 16), v1 = __builtin_bit_cast(float, elt16(vr[1], i) << 16), v2 = __builtin_bit_cast(float, elt16(vr[2], i) << 16), v3 = __builtin_bit_cast(float, elt16(vr[3], i) << 16);
                u32x2 vf; vf.x = cvtpk(v0 * sf[0], v1 * sf[1]); vf.y = cvtpk(v2 * sf[2], v3 * sf[3]); *(LAS u32x2*)(VFT + off) = vf;
                u32x2 vb; vb.x = cvtpk(v0 * sb[0], v1 * sb[1]); vb.y = cvtpk(v2 * sb[2], v3 * sb[3]); *(LAS u32x2*)(VBT + off) = vb; }
        }
        __syncthreads();
        const int et = w & 3, dt0 = 2 * (w >> 2);
        f32x16 accf[2], accb[2]; accf[0] = zero16(); accf[1] = zero16(); accb[0] = zero16(); accb[1] = zero16();
#pragma unroll
        for (int s = 0; s < 8; ++s) {
            const bf16x8 af = *(const LAS bf16x8*)(VFT + (32 * et + r) * P + 32 * s + 16 * hh), ab = *(const LAS bf16x8*)(VBT + (32 * et + r) * P + 32 * s + 16 * hh);
#pragma unroll
            for (int t = 0; t < 2; ++t) { const bf16x8 bk = *(const LAS bf16x8*)(KT + (32 * (dt0 + t) + r) * P + 32 * s + 16 * hh);
                accf[t] = MFMA32(af, bk, accf[t]); accb[t] = MFMA32(ab, bk, accb[t]); }
        }
        float* of = F.STF + (size_t)item * HD * HD; float* ob = F.STB + (size_t)item * HD * HD;
#pragma unroll
        for (int t = 0; t < 2; ++t)
#pragma unroll
            for (int reg = 0; reg < 16; ++reg) { const int e = 32 * et + (reg & 3) + 8 * (reg >> 2) + 4 * hh, d = 32 * (dt0 + t) + r; of[e * HD + d] = accf[t][reg]; ob[e * HD + d] = accb[t][reg]; }
        __syncthreads();
    }
}
__device__ __forceinline__ void p4_r3_mfma(Frame& F) {
    constexpr int P = 264;
    LAS unsigned char* VT = F.lds + RING_OFF; LAS float* XS = (LAS float*)(F.lds + RING_OFF + 128 * P);
    const int w = F.wave, qt = w & 3, eh = w >> 2;
    const float scale = 0.08838834764831845f, L2E = 1.4426950408889634f;
    for (int item = F.vcu; item < BATCH * NH * NCH; item += F.G) {
        int tid = F.tid; asm volatile("" : "+v"(tid)); const int lane = tid & 63, r = lane & 31, hh = lane >> 5;
        const int bh = item >> 5, c = item & 31, b = bh >> 3, h = bh & 7; const size_t row0 = (size_t)b * SEQ + c * CH;
        const bf16* Qg = HP(COL_QR, h) + row0 * HD; const bf16* Kg = HP(COL_KR, h) + row0 * HD;
        const bf16* Vg = HP(COL_VR, h) + row0 * HD; const bf16* Gg = HP(COL_GR, h) + row0 * HD;
        const float lgf2 = -__expf(F.decf[h]) * L2E, lgb2 = -__expf(F.decb[h]) * L2E;
        {
            const int jg = tid & 31, dc = tid >> 5; v4u vr[4];
#pragma unroll
            for (int q = 0; q < 4; ++q) vr[q] = *(const GAS v4u*)(Vg + (size_t)(4 * jg + q) * HD + 8 * dc);
#pragma unroll
            for (int i = 0; i < 8; ++i) { u32x2 vv; vv.x = elt16(vr[0], i) | (elt16(vr[1], i) << 16); vv.y = elt16(vr[2], i) | (elt16(vr[3], i) << 16); *(LAS u32x2*)(VT + (8 * dc + i) * P + 8 * jg) = vv; }
        }
        const int iq = 32 * qt + r;
        bf16x8 qf[8];
#pragma unroll
        for (int s = 0; s < 8; ++s) qf[s] = *(const GAS bf16x8*)(Qg + (size_t)iq * HD + 64 * hh + 8 * s);
        f32x16 st[4];
#pragma unroll
        for (int kt = 0; kt < 4; ++kt) { st[kt] = zero16();
#pragma unroll
            for (int s = 0; s < 8; ++s) { const bf16x8 kf = *(const GAS bf16x8*)(Kg + (size_t)(32 * kt + r) * HD + 64 * hh + 8 * s); st[kt] = MFMA32(kf, qf[s], st[kt]); }
            __builtin_amdgcn_sched_barrier(0); }
        bf16x8 pf[4][2];
#pragma unroll
        for (int kt = 0; kt < 4; ++kt) {
#pragma unroll
            for (int reg = 0; reg < 16; ++reg) { const int j = 32 * kt + (reg & 3) + 8 * (reg >> 2) + 4 * hh, dj = iq - j;
                const float dec = __builtin_amdgcn_exp2f(dj >= 0 ? lgf2 * (float)dj : lgb2 * (float)(-dj)); st[kt][reg] *= scale * dec; }
            pf[kt][0] = pack8(st[kt], 0); pf[kt][1] = pack8(st[kt], 1); }
        const float ff = __builtin_amdgcn_exp2f(lgf2 * (float)(iq + 1)) * scale, fb = __builtin_amdgcn_exp2f(lgb2 * (float)(CH - iq)) * scale;
        f32x16 acc[2];
#pragma unroll
        for (int t = 0; t < 2; ++t) { const int e = 32 * (2 * eh + t) + r; f32x16 a1 = zero16(), a2 = zero16();
            const bf16* s1 = sbf_row(F.PROJ, 2 * item, e) + 64 * hh; const bf16* s2 = sbf_row(F.PROJ, 2 * item + 1, e) + 64 * hh;
#pragma unroll
            for (int s = 0; s < 8; ++s) { a1 = MFMA32(*(const GAS bf16x8*)(s1 + 8 * s), qf[s], a1); a2 = MFMA32(*(const GAS bf16x8*)(s2 + 8 * s), qf[s], a2); }
#pragma unroll
            for (int reg = 0; reg < 16; ++reg) acc[t][reg] = ff * a1[reg] + fb * a2[reg];
            __builtin_amdgcn_sched_barrier(0); }
        __syncthreads();
#pragma unroll
        for (int t = 0; t < 2; ++t) { const LAS unsigned char* vrow = VT + (32 * (2 * eh + t) + r) * P + 8 * hh;
#pragma unroll
            for (int kt = 0; kt < 4; ++kt)
#pragma unroll
                for (int sp = 0; sp < 2; ++sp) { const u32x2 lo = *(const LAS u32x2*)(vrow + 2 * (32 * kt + 16 * sp)), hi = *(const LAS u32x2*)(vrow + 2 * (32 * kt + 16 * sp + 8));
                    acc[t] = MFMA32(cat8(lo, hi), pf[kt][sp], acc[t]); } }
        float ssq = 0.f;
#pragma unroll
        for (int t = 0; t < 2; ++t)
#pragma unroll
            for (int reg = 0; reg < 16; ++reg) ssq += acc[t][reg] * acc[t][reg];
        ssq += __shfl_xor(ssq, 32);
        if (hh == 0) XS[w * 32 + r] = ssq;
        __syncthreads();
        const float rms = 1.0f / sqrtf((XS[w * 32 + r] + XS[(w ^ 4) * 32 + r]) * (1.0f / HD) + EPS);
#pragma unroll
        for (int t = 0; t < 2; ++t)
#pragma unroll
            for (int g = 0; g < 4; ++g) { const int e = 32 * (2 * eh + t) + 8 * g + 4 * hh;
                const u32x2 gg = *(const GAS u32x2*)(Gg + (size_t)iq * HD + e); const f32x4 wn = *(const GAS f32x4*)(F.w_retn + h * HD + e);
                const float g0 = bflo(gg.x), g1 = bfhi(gg.x), g2 = bflo(gg.y), g3 = bfhi(gg.y);
                const float o0 = acc[t][4 * g] * rms * wn.x * (g0 / (1.0f + __expf(-g0))), o1 = acc[t][4 * g + 1] * rms * wn.y * (g1 / (1.0f + __expf(-g1)));
                const float o2 = acc[t][4 * g + 2] * rms * wn.z * (g2 / (1.0f + __expf(-g2))), o3 = acc[t][4 * g + 3] * rms * wn.w * (g3 / (1.0f + __expf(-g3)));
                u32x2 o; o.x = cvtpk(o0, o1); o.y = cvtpk(o2, o3); *(GAS u32x2*)(F.MIX + (row0 + iq) * D + DATT + h * HD + e) = o; }
        __syncthreads();
    }
}
__device__ __forceinline__ void p2_attn_mfma(Frame& F) {
    constexpr int PK = 272, PV = 520;
    LAS unsigned char* KI = F.lds + RING_OFF; LAS unsigned char* VT = KI + 256 * PK;
    static_assert(256 * PK + 128 * PV <= RING_BYTES, "attention images fit the ring");
    const int w = F.wave, qt = w & 3, eh = w >> 2;
    const float scale = 0.08838834764831845f, L2E = 1.4426950408889634f;
    const int NU = BATCH * NH * 96;
    for (int n = F.vcu; n < NU; n += F.G) {
        int tid = F.tid; asm volatile("" : "+v"(tid)); const int lane = tid & 63, r = lane & 31, hh = lane >> 5;
        unsigned long long t0 = 0, t1 = 0; T_START(t0);
        int bh, u;
        if (F.G == 256) { const int it = n >> 8; bh = (F.vcu >> 5) + 8 * (it / 3); u = (F.vcu & 31) + 32 * (it % 3); }
        else { bh = n / 96; u = n % 96; }
        const int p = u >> 5, idx = u & 31, sh = 2 * p, dil = 1 << sh, nblk = 32 >> sh, cls = idx / nblk, l0 = 128 * (idx % nblk), L = SEQ >> sh;
        const int b = bh >> 3, h = bh & 7;
        const bf16* Qb = HP(COL_QA, h) + (size_t)(b * SEQ) * HD; const bf16* Kb = HP(COL_KA, h) + (size_t)(b * SEQ) * HD; const bf16* Vb = HP(COL_VA, h) + (size_t)(b * SEQ) * HD;
#pragma unroll
        for (int it = 0; it < 8; ++it) { const int pc = tid + 512 * it, row = pc >> 4, ch = pc & 15, lk = l0 - 64 + row;
            const int lkc = lk < 0 ? 0 : (lk >= L ? L - 1 : lk);
            *(LAS v4u*)(KI + row * PK + 16 * ch) = *(const GAS v4u*)(Kb + (size_t)(lkc * dil + cls) * HD + 8 * ch); }
#pragma unroll
        for (int it = 0; it < 2; ++it) { const int bid = tid + 512 * it, jg = bid & 63, dc = bid >> 6; v4u vr[4];
#pragma unroll
            for (int q = 0; q < 4; ++q) { const int lk = l0 - 64 + 4 * jg + q, lkc = lk < 0 ? 0 : (lk >= L ? L - 1 : lk); vr[q] = *(const GAS v4u*)(Vb + (size_t)(lkc * dil + cls) * HD + 8 * dc); }
#pragma unroll
            for (int i = 0; i < 8; ++i) { u32x2 vv; vv.x = elt16(vr[0], i) | (elt16(vr[1], i) << 16); vv.y = elt16(vr[2], i) | (elt16(vr[3], i) << 16); *(LAS u32x2*)(VT + (8 * dc + i) * PV + 8 * jg) = vv; } }
        const int lq = l0 + 32 * qt + r;
        const size_t qrow = (size_t)(lq * dil + cls);
        bf16x8 qf[8];
#pragma unroll
        for (int s = 0; s < 8; ++s) qf[s] = *(const GAS bf16x8*)(Qb + qrow * HD + 64 * hh + 8 * s);
        __syncthreads();
        if (PROBE_T == 1) T_ADD(F.tA, t0);
        T_START(t1);
        f32x16 st[5];
#pragma unroll
        for (int kt = 0; kt < 5; ++kt) { st[kt] = zero16(); const LAS unsigned char* krow = KI + (32 * qt + 32 * kt + r) * PK + 128 * hh;
#pragma unroll
            for (int s = 0; s < 8; ++s) st[kt] = MFMA32(*(const LAS bf16x8*)(krow + 16 * s), qf[s], st[kt]);
            __builtin_amdgcn_sched_barrier(0); }
        const float slope2 = exp2f(-(float)(h + 1)) * (float)dil * L2E, sc2 = scale * L2E;
        float mx = -INFINITY;
#pragma unroll
        for (int kt = 0; kt < 5; ++kt)
#pragma unroll
            for (int reg = 0; reg < 16; ++reg) { const int jl = 32 * kt + (reg & 3) + 8 * (reg >> 2) + 4 * hh, dist = r + 64 - jl, ad = dist < 0 ? -dist : dist, lk = l0 + 32 * qt - 64 + jl;
                const bool valid = (ad <= 64) && (lk >= 0) && (lk < L);
                const float s2 = valid ? st[kt][reg] * sc2 - slope2 * (float)ad : -INFINITY; st[kt][reg] = s2; mx = fmaxf(mx, s2); }
        mx = fmaxf(mx, __shfl_xor(mx, 32));
        if (PROBE_T == 3) { T_ADD(F.tA, t1); T_START(t1); }
        float l = 0.f;
#pragma unroll
        for (int kt = 0; kt < 5; ++kt)
#pragma unroll
            for (int reg = 0; reg < 16; ++reg) { const float e = __builtin_amdgcn_exp2f(st[kt][reg] - mx); st[kt][reg] = e; l += e; }
        l += __shfl_xor(l, 32);
        f32x16 acc[2]; acc[0] = zero16(); acc[1] = zero16();
#pragma unroll
        for (int kt = 0; kt < 5; ++kt)
#pragma unroll
            for (int sp = 0; sp < 2; ++sp) { const bf16x8 pfr = pack8(st[kt], sp);
#pragma unroll
                for (int t = 0; t < 2; ++t) { const LAS unsigned char* vrow = VT + (32 * (2 * eh + t) + r) * PV + 2 * (32 * qt + 32 * kt + 16 * sp + 4 * hh);
                    const u32x2 lo = *(const LAS u32x2*)(vrow), hi = *(const LAS u32x2*)(vrow + 16);
                    acc[t] = MFMA32(cat8(lo, hi), pfr, acc[t]); }
                __builtin_amdgcn_sched_barrier(0); }
        const float il = 1.0f / l; const size_t orow = (size_t)b * SEQ + qrow;
        bf16* ob = (p == 0) ? (F.MIX + orow * D + h * HD) : (F.XN + (size_t)(p - 1) * M * DATT + orow * DATT + h * HD);
#pragma unroll
        for (int t = 0; t < 2; ++t)
#pragma unroll
            for (int g = 0; g < 4; ++g) { const int e = 32 * (2 * eh + t) + 8 * g + 4 * hh; u32x2 o; o.x = cvtpk(acc[t][4 * g] * il, acc[t][4 * g + 1] * il); o.y = cvtpk(acc[t][4 * g + 2] * il, acc[t][4 * g + 3] * il); *(GAS u32x2*)(ob + e) = o; }
        if (eh == 0 && hh == 0) F.LSE[(size_t)p * M * NH + orow * NH + h] = (mx + __log2f(l)) * 0.6931471805599453f;
        __syncthreads();
        if (PROBE_T == 1) T_ADD(F.tB, t0);
        if (PROBE_T == 3) T_ADD(F.tB, t1);
    }
}
__device__ __forceinline__ void p3_merge(Frame& F) {
    const int gt = F.vcu * (NWAVES * 64) + F.tid, NT = F.G * NWAVES * 64;
    for (int idx = gt; idx < M * (DATT / 8); idx += NT) { const int row = idx >> 7, c8 = idx & 127, h = c8 >> 4;
        const float l1 = F.LSE[(size_t)row * NH + h], l4 = F.LSE[(size_t)M * NH + (size_t)row * NH + h], l16 = F.LSE[(size_t)2 * M * NH + (size_t)row * NH + h];
        const float mx = fmaxf(l1, fmaxf(l4, l16)); float w1 = __expf(l1 - mx), w4 = __expf(l4 - mx), w16 = __expf(l16 - mx); const float inv = 1.0f / (w1 + w4 + w16); w1 *= inv; w4 *= inv; w16 *= inv;
        GAS v4u* pm = (GAS v4u*)(F.MIX + (size_t)row * D + 8 * c8);
        const v4u a = *pm, bq = *(const GAS v4u*)(F.XN + (size_t)row * DATT + 8 * c8), cq = *(const GAS v4u*)(F.XN + (size_t)M * DATT + (size_t)row * DATT + 8 * c8);
        v4u o;
#pragma unroll
        for (int k = 0; k < 4; ++k) o[k] = cvtpk(w1 * bflo(a[k]) + w4 * bflo(bq[k]) + w16 * bflo(cq[k]), w1 * bfhi(a[k]) + w4 * bfhi(bq[k]) + w16 * bfhi(cq[k]));
        *pm = o; }
}
typedef short v4i16_t __attribute__((ext_vector_type(4)));
__device__ __forceinline__ unsigned swz16(unsigned row) { return ((row & 3u) << 2) | ((row >> 2) & 3u); }
struct AttnUnit { int b, h, p, dil, cls, l0, L; const bf16 *Qb, *Kb, *Vb; };
__device__ __forceinline__ AttnUnit attn_unit(const Frame& F, int n) {
    int bh, u;
    if (F.G == 256) { const int it = n >> 8; bh = (F.vcu >> 5) + 8 * (it / 3); u = (F.vcu & 31) + 32 * (it % 3); }
    else { bh = n / 96; u = n % 96; }
    AttnUnit U; U.p = u >> 5; const int idx = u & 31, sh = 2 * U.p, nblk = 32 >> sh; U.dil = 1 << sh; U.cls = idx / nblk; U.l0 = 128 * (idx % nblk); U.L = SEQ >> sh; U.b = bh >> 3; U.h = bh & 7;
    U.Qb = HP(COL_QA, U.h) + (size_t)(U.b * SEQ) * HD; U.Kb = HP(COL_KA, U.h) + (size_t)(U.b * SEQ) * HD; U.Vb = HP(COL_VA, U.h) + (size_t)(U.b * SEQ) * HD;
    return U;
}
__device__ __forceinline__ void attn_dma(LAS unsigned char* img, const bf16* Xb, const AttnUnit& U, int w, int lane) {
#pragma unroll
    for (int i = 0; i < 8; ++i) { const int pc = 8 * w + i, row = 4 * pc + (lane >> 4), ch = (lane & 15) ^ (int)swz16((unsigned)row);
        int lk = U.l0 - 64 + row; lk = lk < 0 ? 0 : (lk >= U.L ? U.L - 1 : lk);
        __builtin_amdgcn_global_load_lds((const unsigned*)(Xb + (size_t)(lk * U.dil + U.cls) * HD + 8 * ch), (LAS unsigned*)(img + pc * 1024), 16, 0, 0); }
}
__device__ __forceinline__ void p2_attn_dma(Frame& F) {
    LAS unsigned char* KI = F.lds + RING_OFF; LAS unsigned char* VI = KI + 65536;
    const int w = F.wave, qt = w & 3, eh = w >> 2;
    const float scale = 0.08838834764831845f, L2E = 1.4426950408889634f;
    const int NU = BATCH * NH * 96;
    int n = F.vcu; if (n >= NU) return;
    AttnUnit U = attn_unit(F, n);
    bf16x8 qf[8];
    { int tid = F.tid; asm volatile("" : "+v"(tid)); const int lane = tid & 63, r = lane & 31, hh = lane >> 5;
      attn_dma(KI, U.Kb, U, w, lane);
      const size_t qrow = (size_t)((U.l0 + 32 * qt + r) * U.dil + U.cls);
#pragma unroll
      for (int s = 0; s < 8; ++s) qf[s] = *(const GAS bf16x8*)(U.Qb + qrow * HD + 16 * s + 8 * hh); }
    for (;;) {
        int tid = F.tid; asm volatile("" : "+v"(tid)); const int lane = tid & 63, r = lane & 31, hh = lane >> 5;
        unsigned long long t0 = 0, t1 = 0; T_START(t0);
        __syncthreads();
        if (PROBE_T == 1) T_ADD(F.tA, t0);
        T_START(t1);
        attn_dma(VI, U.Vb, U, w, lane);
        const int lq0 = U.l0 + 32 * qt;
        f32x16 st[5];
        const unsigned swr = swz16((unsigned)r);
#pragma unroll
        for (int kt = 0; kt < 5; ++kt) { st[kt] = zero16(); const int lk0 = lq0 - 64 + 32 * kt;
            if (lk0 >= 0 && lk0 < U.L) { const LAS unsigned char* krow = KI + (32 * (qt + kt) + r) * 256;
#pragma unroll
                for (int s = 0; s < 8; ++s) st[kt] = MFMA32(*(const LAS bf16x8*)(krow + 16 * ((unsigned)(2 * s + hh) ^ swr)), qf[s], st[kt]); }
            __builtin_amdgcn_sched_barrier(0); }
        const float slope2 = exp2f(-(float)(U.h + 1)) * (float)U.dil * L2E, sc2 = scale * L2E, frr = (float)(r - 4 * hh);
        float mx = -INFINITY;
#pragma unroll
        for (int kt = 0; kt < 5; ++kt) { const int lk0 = lq0 - 64 + 32 * kt; const bool tin = (lk0 >= 0 && lk0 < U.L);
#pragma unroll
            for (int reg = 0; reg < 16; ++reg) { const float ad = fabsf(frr + (float)(64 - 32 * kt - ((reg & 3) + 8 * (reg >> 2))));
                float s2 = st[kt][reg] * sc2 - slope2 * ad;
                if (kt == 0 || kt == 4) s2 = (ad <= 64.0f) ? s2 : -INFINITY;
                s2 = tin ? s2 : -INFINITY;
                st[kt][reg] = s2; mx = fmaxf(mx, s2); } }
        mx = fmaxf(mx, __shfl_xor(mx, 32));
        if (PROBE_T == 3) { T_ADD(F.tA, t1); T_START(t1); }
        __syncthreads();
        const int nn = n + F.G; const bool has_next = nn < NU;
        AttnUnit Un = U; if (has_next) { Un = attn_unit(F, nn); attn_dma(KI, Un.Kb, Un, w, lane); }
        float l = 0.f;
#pragma unroll
        for (int kt = 0; kt < 5; ++kt)
#pragma unroll
            for (int reg = 0; reg < 16; ++reg) { const float e = __builtin_amdgcn_exp2f(st[kt][reg] - mx); st[kt][reg] = e; l += e; }
        l += __shfl_xor(l, 32);
        f32x16 acc[2]; acc[0] = zero16(); acc[1] = zero16();
        const int q4 = (lane & 15) >> 2, pp = lane & 3, blk = (lane >> 4) & 1;
        unsigned voff[2][2][2];
#pragma unroll
        for (int t2 = 0; t2 < 2; ++t2) { const unsigned rl = (unsigned)(4 * hh + 8 * t2 + q4), sw = swz16(rl);
#pragma unroll
            for (int t = 0; t < 2; ++t) { const unsigned chunk = (unsigned)(4 * (2 * eh + t) + 2 * blk + (pp >> 1)); voff[t2][t][0] = 256u * rl + 16u * (chunk ^ sw) + 8u * (unsigned)(pp & 1); voff[t2][t][1] = 0; } }
#pragma unroll
        for (int kt = 0; kt < 5; ++kt) { const int lk0 = lq0 - 64 + 32 * kt;
            if (lk0 >= 0 && lk0 < U.L) {
#pragma unroll
                for (int sp = 0; sp < 2; ++sp) { const bf16x8 pfr = pack8(st[kt], sp); const LAS unsigned char* vb = VI + (32 * (qt + kt) + 16 * sp) * 256;
#pragma unroll
                    for (int t = 0; t < 2; ++t) {
                        const v4i16_t lo = __builtin_amdgcn_ds_read_tr16_b64_v4i16((LAS v4i16_t*)(vb + voff[0][t][0])), hi = __builtin_amdgcn_ds_read_tr16_b64_v4i16((LAS v4i16_t*)(vb + voff[1][t][0]));
                        const bf16x8 vf = __builtin_shufflevector(lo, hi, 0, 1, 2, 3, 4, 5, 6, 7);
                        acc[t] = MFMA32(vf, pfr, acc[t]); } } }
            __builtin_amdgcn_sched_barrier(0); }
        const float il = 1.0f / l; const size_t qrow = (size_t)((lq0 + r) * U.dil + U.cls), orow = (size_t)U.b * SEQ + qrow;
        bf16* ob = (U.p == 0) ? (F.MIX + orow * D + U.h * HD) : (F.XN + (size_t)(U.p - 1) * M * DATT + orow * DATT + U.h * HD);
#pragma unroll
        for (int t = 0; t < 2; ++t)
#pragma unroll
            for (int g = 0; g < 4; ++g) { const int e = 32 * (2 * eh + t) + 8 * g + 4 * hh; u32x2 o; o.x = cvtpk(acc[t][4 * g] * il, acc[t][4 * g + 1] * il); o.y = cvtpk(acc[t][4 * g + 2] * il, acc[t][4 * g + 3] * il); *(GAS u32x2*)(ob + e) = o; }
        if (eh == 0 && hh == 0) F.LSE[(size_t)U.p * M * NH + orow * NH + U.h] = (mx + __log2f(l)) * 0.6931471805599453f;
        if (PROBE_T == 1) T_ADD(F.tB, t0);
        if (PROBE_T == 3) T_ADD(F.tB, t1);
        if (!has_next) break;
        U = Un; n = nn;
        { const size_t qr2 = (size_t)((U.l0 + 32 * qt + r) * U.dil + U.cls);
#pragma unroll
          for (int s = 0; s < 8; ++s) qf[s] = *(const GAS bf16x8*)(U.Qb + qr2 * HD + 16 * s + 8 * hh); }
    }
    __syncthreads();
}
__device__ __forceinline__ void dma_rows128(LAS unsigned char* img, const bf16* src, int w, int lane) {
#pragma unroll
    for (int i = 0; i < 4; ++i) { const int pc = 4 * w + i, row = 4 * pc + (lane >> 4), ch = (lane & 15) ^ (int)swz16((unsigned)row);
        __builtin_amdgcn_global_load_lds((const unsigned*)(src + (size_t)row * HD + 8 * ch), (LAS unsigned*)(img + pc * 1024), 16, 0, 0); }
}
__device__ __forceinline__ unsigned tr_nat(int lane, int c, int ks, int t2) { const unsigned h = lane >> 5, blk = (lane >> 4) & 1, q = (lane & 15) >> 2, p = lane & 3, row = 16 * ks + 8 * h + 4 * t2 + q;
    return 256u * row + 16u * ((unsigned)(4 * c + 2 * blk + (p >> 1)) ^ swz16(row)) + 8u * (p & 1); }
__device__ __forceinline__ v4i16_t trd(const LAS unsigned char* p) { return __builtin_amdgcn_ds_read_tr16_b64_v4i16((LAS v4i16_t*)p); }
__device__ __forceinline__ void p2_r1_dma(Frame& F) {
    const int w = F.wave, dt = w & 3, et0 = 2 * (w >> 2);
    const float L2E = 1.4426950408889634f;
    const int NI = BATCH * NH * NCH;
    int item = F.vcu; if (item >= NI) return;
    bf16* STFh = (bf16*)F.STF; bf16* STBh = STFh + (size_t)NI * HD * HD;
    { int tid = F.tid; asm volatile("" : "+v"(tid)); const int lane = tid & 63;
      const int bh = item >> 5, c = item & 31, b = bh >> 3, h = bh & 7; const size_t row0 = (size_t)b * SEQ + c * CH;
      dma_rows128(F.lds + RING_OFF, HP(COL_KR, h) + row0 * HD, w, lane); dma_rows128(F.lds + RING_OFF + 32768, HP(COL_VR, h) + row0 * HD, w, lane); }
    for (int k = 0;; ++k) {
        int tid = F.tid; asm volatile("" : "+v"(tid)); const int lane = tid & 63, r = lane & 31, hh = lane >> 5;
        const int bh = item >> 5, h = bh & 7;
        __syncthreads();
        const int nitem = item + F.G; const bool has_next = nitem < NI;
        LAS unsigned char* KI = F.lds + RING_OFF + (k & 1) * 65536; LAS unsigned char* VI = KI + 32768;
        if (has_next) { const int bh2 = nitem >> 5, c2 = nitem & 31, b2 = bh2 >> 3, h2 = bh2 & 7; const size_t row2 = (size_t)b2 * SEQ + c2 * CH; LAS unsigned char* NB = F.lds + RING_OFF + ((k + 1) & 1) * 65536;
            dma_rows128(NB, HP(COL_KR, h2) + row2 * HD, w, lane); dma_rows128(NB + 32768, HP(COL_VR, h2) + row2 * HD, w, lane); }
        const float lgf2 = -__expf(F.decf[h]) * L2E, lgb2 = -__expf(F.decb[h]) * L2E;
        float gfi[8], gbi[8];
#pragma unroll
        for (int q = 0; q < 8; ++q) { gfi[q] = __builtin_amdgcn_exp2f(-lgf2 * (float)q); gbi[q] = __builtin_amdgcn_exp2f(lgb2 * (float)q); }
        f32x16 accf[2], accb[2]; accf[0] = zero16(); accf[1] = zero16(); accb[0] = zero16(); accb[1] = zero16();
#pragma unroll
        for (int s = 0; s < 8; ++s) {
            const v4i16_t klo = trd(KI + tr_nat(lane, dt, s, 0)), khi = trd(KI + tr_nat(lane, dt, s, 1));
            const bf16x8 kf = __builtin_shufflevector(klo, khi, 0, 1, 2, 3, 4, 5, 6, 7);
            const float bfw = __builtin_amdgcn_exp2f(lgf2 * (float)(CH - 1 - 16 * s - 8 * hh)), bbw = __builtin_amdgcn_exp2f(lgb2 * (float)(16 * s + 8 * hh));
#pragma unroll
            for (int t = 0; t < 2; ++t) { const v4i16_t vlo = trd(VI + tr_nat(lane, et0 + t, s, 0)), vhi = trd(VI + tr_nat(lane, et0 + t, s, 1));
                float v[8];
#pragma unroll
                for (int q = 0; q < 4; ++q) { v[q] = __builtin_bit_cast(float, (unsigned)(unsigned short)vlo[q] << 16); v[4 + q] = __builtin_bit_cast(float, (unsigned)(unsigned short)vhi[q] << 16); }
                v4u pf_, pb_;
#pragma unroll
                for (int q = 0; q < 4; ++q) { pf_[q] = cvtpk(v[2 * q] * (bfw * gfi[2 * q]), v[2 * q + 1] * (bfw * gfi[2 * q + 1])); pb_[q] = cvtpk(v[2 * q] * (bbw * gbi[2 * q]), v[2 * q + 1] * (bbw * gbi[2 * q + 1])); }
                accf[t] = MFMA32(kf, __builtin_bit_cast(bf16x8, pf_), accf[t]); accb[t] = MFMA32(kf, __builtin_bit_cast(bf16x8, pb_), accb[t]); }
        }
        bf16* of = STFh + (size_t)item * HD * HD; bf16* ob = STBh + (size_t)item * HD * HD;
#pragma unroll
        for (int t = 0; t < 2; ++t) { const int e = 32 * (et0 + t) + r;
#pragma unroll
            for (int g = 0; g < 4; ++g) { const int d0 = 32 * dt + 8 * g + 4 * hh;
                u32x2 o1; o1.x = cvtpk(accf[t][4 * g], accf[t][4 * g + 1]); o1.y = cvtpk(accf[t][4 * g + 2], accf[t][4 * g + 3]); *(GAS u32x2*)(of + e * HD + d0) = o1;
                u32x2 o2; o2.x = cvtpk(accb[t][4 * g], accb[t][4 * g + 1]); o2.y = cvtpk(accb[t][4 * g + 2], accb[t][4 * g + 3]); *(GAS u32x2*)(ob + e * HD + d0) = o2; } }
        if (!has_next) break;
        item = nitem;
    }
    __syncthreads();
}
__device__ __forceinline__ void p3_scan_bf16(Frame& F) {
    const int gt = F.vcu * (NWAVES * 64) + F.tid, NT = F.G * NWAVES * 64;
    const bf16* STFh = (const bf16*)F.STF; const bf16* STBh = STFh + (size_t)BATCH * NH * NCH * HD * HD;
    for (int idx = gt; idx < 2 * BATCH * NH * 2048; idx += NT) {
        const int dir = idx / (BATCH * NH * 2048), rem = idx % (BATCH * NH * 2048), bh = rem >> 11, q = rem & 2047, h = bh & 7;
        const float g = __expf(-__expf(dir ? F.decb[h] : F.decf[h]) * (float)CH);
        const GAS v4u* base = (const GAS v4u*)(dir ? STBh : STFh) + (size_t)bh * NCH * 2048 + q;
        float s[8];
#pragma unroll
        for (int i = 0; i < 8; ++i) s[i] = 0.f;
#pragma unroll 8
        for (int cc = 0; cc < NCH; ++cc) { const int c = dir ? NCH - 1 - cc : cc; const v4u t = base[(size_t)c * 2048];
            v4u o; o.x = cvtpk(s[0], s[1]); o.y = cvtpk(s[2], s[3]); o.z = cvtpk(s[4], s[5]); o.w = cvtpk(s[6], s[7]);
            *(GAS v4u*)(sbf_row(F.PROJ, 2 * (bh * NCH + c) + dir, q >> 4) + 8 * (q & 15)) = o;
#pragma unroll
            for (int i = 0; i < 4; ++i) { s[2 * i] = s[2 * i] * g + bflo(t[i]); s[2 * i + 1] = s[2 * i + 1] * g + bfhi(t[i]); } }
    }
}
__device__ __forceinline__ void p4_r3_dma(Frame& F) {
    LAS unsigned char* KI = F.lds + RING_OFF; LAS unsigned char* VI = KI + 32768; LAS unsigned char* SFI = KI + 65536; LAS unsigned char* SBI = KI + 98304; LAS float* XS = (LAS float*)(KI + 131072);
    const int w = F.wave, qt = w & 3, eh = w >> 2;
    const float scale = 0.08838834764831845f, L2E = 1.4426950408889634f;
    const int NI = BATCH * NH * NCH;
    int item = F.vcu; if (item >= NI) return;
    bf16x8 qf[8];
    { int tid = F.tid; asm volatile("" : "+v"(tid)); const int lane = tid & 63, r = lane & 31, hh = lane >> 5;
      const int bh = item >> 5, c = item & 31, b = bh >> 3, h = bh & 7; const size_t row0 = (size_t)b * SEQ + c * CH;
      dma_rows128(KI, HP(COL_KR, h) + row0 * HD, w, lane); dma_rows128(SFI, sbf_row(F.PROJ, 2 * item, 0), w, lane); dma_rows128(SBI, sbf_row(F.PROJ, 2 * item + 1, 0), w, lane);
      const bf16* Qg = HP(COL_QR, h) + row0 * HD;
#pragma unroll
      for (int s = 0; s < 8; ++s) qf[s] = *(const GAS bf16x8*)(Qg + (size_t)(32 * qt + r) * HD + 16 * s + 8 * hh); }
    for (;;) {
        int tid = F.tid; asm volatile("" : "+v"(tid)); const int lane = tid & 63, r = lane & 31, hh = lane >> 5;
        const int bh = item >> 5, c = item & 31, b = bh >> 3, h = bh & 7; const size_t row0 = (size_t)b * SEQ + c * CH;
        const bf16* Gg = HP(COL_GR, h) + row0 * HD;
        const float lgf2 = -__expf(F.decf[h]) * L2E, lgb2 = -__expf(F.decb[h]) * L2E;
        const int iq = 32 * qt + r;
        __syncthreads();
        dma_rows128(VI, HP(COL_VR, h) + row0 * HD, w, lane);
        u32x2 gg[2][4];
#pragma unroll
        for (int t = 0; t < 2; ++t)
#pragma unroll
            for (int g = 0; g < 4; ++g) gg[t][g] = *(const GAS u32x2*)(Gg + (size_t)iq * HD + 32 * (2 * eh + t) + 8 * g + 4 * hh);
        const unsigned swr = swz16((unsigned)r);
        f32x16 st[4];
#pragma unroll
        for (int kt = 0; kt < 4; ++kt) { st[kt] = zero16(); const LAS unsigned char* krow = KI + (32 * kt + r) * 256;
#pragma unroll
            for (int s = 0; s < 8; ++s) st[kt] = MFMA32(*(const LAS bf16x8*)(krow + 16 * ((unsigned)(2 * s + hh) ^ swr)), qf[s], st[kt]);
            __builtin_amdgcn_sched_barrier(0); }
        bf16x8 pf[4][2];
#pragma unroll
        for (int kt = 0; kt < 4; ++kt) {
#pragma unroll
            for (int reg = 0; reg < 16; ++reg) { const int j = 32 * kt + (reg & 3) + 8 * (reg >> 2) + 4 * hh, dj = iq - j;
                const float dec = __builtin_amdgcn_exp2f(dj >= 0 ? lgf2 * (float)dj : lgb2 * (float)(-dj)); st[kt][reg] *= scale * dec; }
            pf[kt][0] = pack8(st[kt], 0); pf[kt][1] = pack8(st[kt], 1); }
        const float ff = __builtin_amdgcn_exp2f(lgf2 * (float)(iq + 1)) * scale, fb = __builtin_amdgcn_exp2f(lgb2 * (float)(CH - iq)) * scale;
        f32x16 acc[2];
#pragma unroll
        for (int t = 0; t < 2; ++t) { f32x16 a1 = zero16(), a2 = zero16(); const int erow = (32 * (2 * eh + t) + r) * 256;
#pragma unroll
            for (int s = 0; s < 8; ++s) { const unsigned co = 16 * ((unsigned)(2 * s + hh) ^ swr);
                a1 = MFMA32(*(const LAS bf16x8*)(SFI + erow + co), qf[s], a1); a2 = MFMA32(*(const LAS bf16x8*)(SBI + erow + co), qf[s], a2); }
#pragma unroll
            for (int reg = 0; reg < 16; ++reg) acc[t][reg] = ff * a1[reg] + fb * a2[reg];
            __builtin_amdgcn_sched_barrier(0); }
        __syncthreads();
        const int nitem = item + F.G; const bool has_next = nitem < NI;
        if (has_next) { const int bh2 = nitem >> 5, c2 = nitem & 31, b2 = bh2 >> 3, h2 = bh2 & 7; const size_t row2 = (size_t)b2 * SEQ + c2 * CH;
            dma_rows128(KI, HP(COL_KR, h2) + row2 * HD, w, lane); dma_rows128(SFI, sbf_row(F.PROJ, 2 * nitem, 0), w, lane); dma_rows128(SBI, sbf_row(F.PROJ, 2 * nitem + 1, 0), w, lane); }
        { const int q4 = (lane & 15) >> 2, pp = lane & 3, blk = (lane >> 4) & 1; unsigned voff[2][2];
#pragma unroll
          for (int t2 = 0; t2 < 2; ++t2) { const unsigned rl = (unsigned)(4 * hh + 8 * t2 + q4), sw = swz16(rl);
#pragma unroll
              for (int t = 0; t < 2; ++t) voff[t2][t] = 256u * rl + 16u * ((unsigned)(4 * (2 * eh + t) + 2 * blk + (pp >> 1)) ^ sw) + 8u * (unsigned)(pp & 1); }
#pragma unroll
          for (int kt = 0; kt < 4; ++kt) {
#pragma unroll
              for (int sp = 0; sp < 2; ++sp) { const LAS unsigned char* vb = VI + (32 * kt + 16 * sp) * 256;
#pragma unroll
                  for (int t = 0; t < 2; ++t) { const v4i16_t lo = trd(vb + voff[0][t]), hi = trd(vb + voff[1][t]);
                      acc[t] = MFMA32(__builtin_shufflevector(lo, hi, 0, 1, 2, 3, 4, 5, 6, 7), pf[kt][sp], acc[t]); } }
              __builtin_amdgcn_sched_barrier(0); } }
        float ssq = 0.f;
#pragma unroll
        for (int t = 0; t < 2; ++t)
#pragma unroll
            for (int reg = 0; reg < 16; ++reg) ssq += acc[t][reg] * acc[t][reg];
        ssq += __shfl_xor(ssq, 32);
        if (hh == 0) XS[w * 32 + r] = ssq;
        asm volatile("s_waitcnt lgkmcnt(0)" ::: "memory"); __builtin_amdgcn_s_barrier(); asm volatile("" ::: "memory");
        const float rms = 1.0f / sqrtf((XS[w * 32 + r] + XS[(w ^ 4) * 32 + r]) * (1.0f / HD) + EPS);
#pragma unroll
        for (int t = 0; t < 2; ++t)
#pragma unroll
            for (int g = 0; g < 4; ++g) { const int e = 32 * (2 * eh + t) + 8 * g + 4 * hh; const f32x4 wn = *(const GAS f32x4*)(F.w_retn + h * HD + e);
                const float g0 = bflo(gg[t][g].x), g1 = bfhi(gg[t][g].x), g2 = bflo(gg[t][g].y), g3 = bfhi(gg[t][g].y);
                const float o0 = acc[t][4 * g] * rms * wn.x * (g0 / (1.0f + __expf(-g0))), o1 = acc[t][4 * g + 1] * rms * wn.y * (g1 / (1.0f + __expf(-g1)));
                const float o2 = acc[t][4 * g + 2] * rms * wn.z * (g2 / (1.0f + __expf(-g2))), o3 = acc[t][4 * g + 3] * rms * wn.w * (g3 / (1.0f + __expf(-g3)));
                u32x2 o; o.x = cvtpk(o0, o1); o.y = cvtpk(o2, o3); *(GAS u32x2*)(F.MIX + (row0 + iq) * D + DATT + h * HD + e) = o; }
        if (!has_next) break;
        item = nitem;
        { const int bh2 = item >> 5, c2 = item & 31, b2 = bh2 >> 3, h2 = bh2 & 7; const bf16* Qg = HP(COL_QR, h2) + ((size_t)b2 * SEQ + c2 * CH) * HD;
#pragma unroll
          for (int s = 0; s < 8; ++s) qf[s] = *(const GAS bf16x8*)(Qg + (size_t)(32 * qt + r) * HD + 16 * s + 8 * hh); }
    }
    __syncthreads();
}
struct Args { const float* in[12]; float* out; unsigned char* ws; int ph_lo, ph_hi, li, pad; };
__global__ void __launch_bounds__(NWAVES * 64, 2) mk_fwd(Args args) {
    extern __shared__ __attribute__((aligned(16))) unsigned char lds[];
    Frame F;
    F.lds = (LAS unsigned char*)lds;
    F.MISC = (volatile LAS unsigned*)(F.lds + MISC_OFF);
    F.tid = threadIdx.x; F.lane = F.tid & 63; F.wave = __builtin_amdgcn_readfirstlane(F.tid >> 6);
    F.G = gridDim.x; { const int bx = blockIdx.x; F.vcu = (F.G % 8 == 0) ? (bx % 8) * (F.G / 8) + bx / 8 : bx; }
    unsigned char* ws = args.ws;
    F.ctl = (gu32*)(ws + WS_CTL);
    F.x = args.in[0]; F.w_mix = args.in[1]; F.w_in = args.in[2]; F.decf = args.in[3]; F.decb = args.in[4]; F.w_retn = args.in[5]; F.w_out = args.in[6];
    F.w_ffn = args.in[7]; F.w_gate = args.in[8]; F.w_up = args.in[9]; F.w_down = args.in[10]; F.w_fin = args.in[11]; F.out = args.out;
    F.Win_t = (bf16*)(ws + WS_WIN); F.Wout_t = (bf16*)(ws + WS_WOUT); F.Wgu_t = (bf16*)(ws + WS_WGU); F.Wdn_t = (bf16*)(ws + WS_WDN);
    F.XN = (bf16*)(ws + WS_XN); F.PROJ = (bf16*)(ws + WS_PROJ); F.MIX = (bf16*)(ws + WS_MIX); F.ACT = (bf16*)(ws + WS_PROJ);
    F.STF = args.out; F.STB = args.out + ST_HALF; F.SS1 = (float*)(ws + WS_CTL + CTL_SS1); F.LSE = (float*)(ws + WS_LSE);
    F.tA = 0; F.tB = 0;
    for (int u = F.tid; u < (LDS_BYTES - LDSCTL_OFF) / 4; u += NWAVES * 64) ((LAS unsigned*)(F.lds + LDSCTL_OFF))[u] = 0u;
    __syncthreads();
    XcdBarrier bar; bar.bar = (unsigned*)(F.ctl + CW_BAR); bar.x = 0; bar.st = nullptr;
    if (N_LAUNCHES != PER_PHASE) bar = xcd_barrier_post((unsigned*)(F.ctl + CW_BAR), F.MISC + 8);
#define GRID_BAR(seam) do { if (N_LAUNCHES == PER_PHASE) { if (F.tid == 0) __hip_atomic_store(F.ctl + CW_TMO, 0xBADBA0u | (unsigned)(seam), RLX_AGENT); } else { xcd_barrier(bar); } } while (0)
    const int lo = args.ph_lo, hi = args.ph_hi;
#define IN(k) (lo <= (k) && (k) < hi)
#define BOTH(k) (IN(k) && IN((k) + 1))

#define REP(k) (((PROBE_REPEAT) >> (k)) & 1)
    if (IN(0)) { p0_prologue(F); if (REP(0)) p0_prologue(F); if (BOTH(0)) GRID_BAR(0); }
    if (N_LAUNCHES != PER_PHASE && lo == 0 && hi > 1) {
        unsigned pre = 0;
        for (unsigned j = 0; j < bar.x; ++j) pre += xb_ld(&bar.bar[XB_XCNT(j)]);
        F.vcu = (int)(pre + F.MISC[10]);
    }
    if (IN(1)) {
        pg8::Gemm g{F.XN, F.Win_t, M, DIN, D}; pg8::StaticOrder S; S.init(M, DIN, F.G, (int)blockIdx.x);
        pg8::EpiHeads E{F.PROJ, M};
        for (int rep = 0; rep <= REP(1); ++rep) pg8::gemm_phase<pg8::EpiHeads, pg8::StaticOrder, true, true>(F.lds + RING_OFF, g, S, E);
        if (BOTH(1)) GRID_BAR(1);
    }
    if (IN(2)) {
        for (int rep = 0; rep <= REP(2); ++rep) {
#if ATTN_NAIVE
        p2_attn_naive(F); __syncthreads();
#elif ATTN_V1
        p2_attn_mfma(F);
#else
        p2_attn_dma(F);
#endif
#if R1_NAIVE
        p2_r1_naive(F);
#elif R1_V1
        p2_r1_mfma(F);
#else
        { unsigned long long tR1 = 0; T_START(tR1); p2_r1_dma(F); if (PROBE_T == 2) T_ADD(F.tA, tR1); }
#endif
        }
        if (BOTH(2)) GRID_BAR(2); }
#if R1_NAIVE || R1_V1
#define P3_SCAN p3_scan
#else
#define P3_SCAN p3_scan_bf16
#endif
    if (IN(3)) { P3_SCAN(F); if (REP(3)) P3_SCAN(F);
#if !ATTN_NAIVE
        p3_merge(F);
#endif
        if (BOTH(3)) GRID_BAR(3); }
    if (IN(4)) {
        for (int rep = 0; rep <= REP(4); ++rep) {
#if R3_NAIVE
        p4_r3_naive(F);
#elif R3_V1
        p4_r3_mfma(F);
#else
        { unsigned long long tR3 = 0; T_START(tR3); p4_r3_dma(F); if (PROBE_T == 2) T_ADD(F.tB, tR3); }
#endif
        }
        if (BOTH(4)) GRID_BAR(4); }
    if (IN(5)) {
        pg8::Gemm g{F.MIX, F.Wout_t, M, D, D}; pg8::StaticOrder S; S.init(M, D, F.G, (int)blockIdx.x);
        pg8::EpiResid E{F.x, F.out, F.XN, F.SS1, D};
        pg8::gemm_phase<pg8::EpiResid, pg8::StaticOrder, true, true>(F.lds + RING_OFF, g, S, E);
        if (REP(5)) { pg8::EpiResid E2{F.x, F.out, F.XN, nullptr, D}; pg8::gemm_phase<pg8::EpiResid, pg8::StaticOrder, true, true>(F.lds + RING_OFF, g, S, E2); }
        if (BOTH(5)) GRID_BAR(5);
    }
    if (IN(6)) {
        pg8::Gemm g{F.XN, F.Wgu_t, M, NGU, D}; pg8::StaticOrder S; S.init(M, NGU, F.G, (int)blockIdx.x);
        pg8::EpiSwiGLU E{F.ACT, DFF, F.SS1, 1.0f / D, EPS};
        for (int rep = 0; rep <= REP(6); ++rep) pg8::gemm_phase<pg8::EpiSwiGLU, pg8::StaticOrder, true, true>(F.lds + RING_OFF, g, S, E);
        if (BOTH(6)) GRID_BAR(6);
    }
    if (IN(7)) {
        pg8::Gemm g{F.ACT, F.Wdn_t, M, D, DFF}; pg8::StaticOrder S; S.init(M, D, F.G, (int)blockIdx.x);
        if (REP(7)) { pg8::EpiNull E0{}; pg8::gemm_phase<pg8::EpiNull, pg8::StaticOrder, true, true>(F.lds + RING_OFF, g, S, E0); }
        pg8::EpiResid E{F.out, F.out, nullptr, nullptr, D};
        pg8::gemm_phase<pg8::EpiResid, pg8::StaticOrder, true, true>(F.lds + RING_OFF, g, S, E);
        if (BOTH(7)) GRID_BAR(7);
    }
    if (IN(8)) { if (REP(8)) p8_final(F, true); p8_final(F, false); }
#if PROBE_T
    if (blockIdx.x == PROBE_BLOCK && F.tid == 0) {
        const unsigned long long t0 = RT(), span = (unsigned long long)PROBE_MULT * (PROBE_USE_B ? F.tB : F.tA);
        while (RT() - t0 < span) __builtin_amdgcn_s_sleep(8);
    }
#endif
#undef REP
#undef IN
#undef BOTH
}

extern "C" void kernel_launch(void* const* d_in, const int* in_sizes, int n_in, void* d_out, int out_size, void* d_ws, size_t ws_size, hipStream_t stream) {
    static int grid = 0;
    if (grid == 0) {
        if (n_in != 12 || in_sizes[0] != M * D || out_size != M * D || ws_size < WS_END) { fprintf(stderr, "kernel_launch: shape/workspace mismatch (n_in %d, in0 %d, out %d, ws %zu, need %zu)\n", n_in, n_in > 0 ? in_sizes[0] : -1, out_size, ws_size, (size_t)WS_END); grid = -1; return; }
        int dev = 0, cus = 0, per_cu = 0;
        if (hipGetDevice(&dev) != hipSuccess || hipDeviceGetAttribute(&cus, hipDeviceAttributeMultiprocessorCount, dev) != hipSuccess) { grid = -1; return; }
        if (hipFuncSetAttribute((const void*)mk_fwd, hipFuncAttributeMaxDynamicSharedMemorySize, LDS_BYTES) != hipSuccess) { fprintf(stderr, "kernel_launch: hipFuncSetAttribute failed\n"); grid = -1; return; }
        if (hipOccupancyMaxActiveBlocksPerMultiprocessor(&per_cu, (const void*)mk_fwd, NWAVES * 64, LDS_BYTES) != hipSuccess || per_cu < 1) fprintf(stderr, "kernel_launch: occupancy query reports %d\n", per_cu);
        (void)hipGetLastError();
        grid = cus;
    }
    if (grid < 0) return;
    (void)hipMemsetAsync((char*)d_ws + WS_CTL, 0, CTL_ZERO_BYTES, stream);
    Args a{};
    for (int i = 0; i < 12; ++i) a.in[i] = (const float*)d_in[i];
    a.out = (float*)d_out; a.ws = (unsigned char*)d_ws;
    if (N_LAUNCHES == 1) { a.ph_lo = 0; a.ph_hi = PER_PHASE; a.li = 0; hipLaunchKernelGGL(mk_fwd, dim3(grid), dim3(NWAVES * 64), LDS_BYTES, stream, a); }
    else for (int li = 0; li < PER_PHASE; ++li) { a.ph_lo = li; a.ph_hi = li + 1; a.li = li; hipLaunchKernelGGL(mk_fwd, dim3(grid), dim3(NWAVES * 64), LDS_BYTES, stream, a); }
}
```

```cpp
#include <hip/hip_runtime.h>
#include <cstdio>
#include <cstdint>
namespace pg8 {
#define PG8_LAS __attribute__((address_space(3)))
typedef unsigned short bf16_t;
typedef short bf16x8 __attribute__((ext_vector_type(8)));
typedef float f32x4 __attribute__((ext_vector_type(4)));
typedef unsigned u32x4 __attribute__((ext_vector_type(4)));
constexpr int BM = 256, BK = 64, HALF = 128, HTB = HALF * BK * 2  , STAGE_BYTES = 8 * HTB, NXCD = 8, WGM = 8;

__host__ __device__ __forceinline__ int lds_byte(int r, int c) { const int st = (r >> 4) * 2 + (c >> 5), rr = r & 15, cc = c & 31, ob = rr * 64 + cc * 2; return st * 1024 + (ob ^ (((ob >> 9) & 1) << 5)); }
__host__ __device__ __forceinline__ void stage_rc(int b, int& R, int& C) { const int st = b / 1024, sb = b % 1024, swz = sb ^ (((sb >> 9) & 1) << 5); R = (st >> 1) * 16 + swz / 64; C = (st & 1) * 32 + (swz % 64) / 2; }
__host__ __device__ __forceinline__ int perm32(int rho) { const int n = rho >> 4, i = rho & 15; return 8 * (i >> 2) + 4 * n + (i & 3); }

struct Unit { int pm, pn; };
struct Gemm { const bf16_t* A; const bf16_t* Bt; int M, N, K; };

struct StaticOrder {
    int nM, nN, nwg, G, c;
    __host__ __device__ void init(int M, int N, int G_, int c_) { nM = M / BM; nN = N / BM; nwg = nM * nN; G = G_; c = c_; }
    __host__ __device__ bool next(int i, Unit& u) const {
        const long L = (long)i * G + c; if (L >= nwg) return false;
        int wgid = (int)L; { const int q = nwg / NXCD, r = nwg % NXCD, xcd = wgid % NXCD, off = wgid / NXCD; wgid = (xcd < r ? xcd * (q + 1) : r * (q + 1) + (xcd - r) * q) + off; }
        const int nig = WGM * nN, gid = wgid / nig, fm = gid * WGM, gsz = (nM - fm) < WGM ? (nM - fm) : WGM;
        u.pm = fm + ((wgid % nig) % gsz); u.pn = (wgid % nig) / gsz; return true;
    }
    __device__ __forceinline__ void a_ready(const Unit&) const {}
    __device__ __forceinline__ void done(const Unit&) const {}
};

__device__ __forceinline__ unsigned cvt_pk_bf16(float lo, float hi) { unsigned r; asm volatile("v_cvt_pk_bf16_f32 %0, %1, %2" : "=v"(r) : "v"(lo), "v"(hi)); return r; }
typedef float f32x2 __attribute__((ext_vector_type(2)));
__device__ __forceinline__ f32x2 gelu_pk(f32x2 v) {
    const f32x2 av = __builtin_elementwise_abs(v), d = av * 0.2316418882f + 1.0f;
    f32x2 t; t.x = __builtin_amdgcn_rcpf(d.x); t.y = __builtin_amdgcn_rcpf(d.y);
    f32x2 q = t * 0.5307027145f + (-0.7265760135f); q = q * t + 0.7107068705f; q = q * t + (-0.142248368f); q = q * t + 0.127414796f; q = q * t;
    const f32x2 s = (v * v) * (-0.72134752044f);
    f32x2 e; e.x = __builtin_amdgcn_exp2f(s.x); e.y = __builtin_amdgcn_exp2f(s.y);
    const f32x2 m = v * (q * e), r = v - m;
    f32x2 o; o.x = v.x < 0.f ? m.x : r.x; o.y = v.y < 0.f ? m.y : r.y; return o;
}

template <int ACT  > struct EpiBf16 {
    static constexpr bool PERM = true, AFTER_DRAIN = false; static_assert(ACT == 0 || ACT == 1, "EpiBf16: ACT is 0 (none) or 1 (gelu_pk)");
    bf16_t* O; int ldc; const float* bias; int split_cols; size_t split_stride; float scale0;
    __device__ __forceinline__ void operator()(const f32x4 (&acc)[2][2][4][2], const Unit& u, int wr, int wc, int fr, int fq) const {
        const int row0 = u.pm * BM + wr * 64 + fr; int colt = u.pn * BM; bf16_t* base = O;
        float sc = 1.f; if (split_cols) { const int t = colt / split_cols; base += (size_t)t * split_stride; colt -= t * split_cols; if (t == 0) sc = scale0; }
        const int col0 = colt + wc * 32 + 8 * fq, bcol0 = u.pn * BM + wc * 32 + 8 * fq;
        f32x4 bv[2][2];
#pragma unroll
        for (int bj = 0; bj < 2; ++bj)
#pragma unroll
            for (int n = 0; n < 2; ++n) bv[bj][n] = bias ? *(const f32x4*)(bias + bcol0 + bj * HALF + 4 * n) : (f32x4){0.f, 0.f, 0.f, 0.f};
#pragma unroll
        for (int ai = 0; ai < 2; ++ai)
#pragma unroll
            for (int m = 0; m < 4; ++m) { bf16_t* rowp = base + (size_t)(row0 + ai * HALF + m * 16) * ldc + col0;
#pragma unroll
                for (int bj = 0; bj < 2; ++bj) { f32x4 v0 = acc[ai][bj][m][0] + bv[bj][0], v1 = acc[ai][bj][m][1] + bv[bj][1];
                    if (ACT == 1) { f32x2 a = gelu_pk((f32x2){v0[0], v0[1]}), b = gelu_pk((f32x2){v0[2], v0[3]}), c = gelu_pk((f32x2){v1[0], v1[1]}), d = gelu_pk((f32x2){v1[2], v1[3]});
                        v0 = (f32x4){a.x, a.y, b.x, b.y}; v1 = (f32x4){c.x, c.y, d.x, d.y}; }
                    v0 = v0 * sc; v1 = v1 * sc; u32x4 w; w.x = cvt_pk_bf16(v0[0], v0[1]); w.y = cvt_pk_bf16(v0[2], v0[3]); w.z = cvt_pk_bf16(v1[0], v1[1]); w.w = cvt_pk_bf16(v1[2], v1[3]);
                    *(u32x4*)(rowp + bj * HALF) = w; } }
    }
};
struct EpiResid {
    static constexpr bool PERM = true, AFTER_DRAIN = false;
    const float* base; float* out; bf16_t* hb; float* ss; int ldc;
    __device__ __forceinline__ void operator()(const f32x4 (&acc)[2][2][4][2], const Unit& u, int wr, int wc, int fr, int fq) const {
        const int row0 = u.pm * BM + wr * 64 + fr, col0 = u.pn * BM + wc * 32 + 8 * fq;
#pragma unroll
        for (int ai = 0; ai < 2; ++ai)
#pragma unroll
            for (int m = 0; m < 4; ++m) { const int row = row0 + ai * HALF + m * 16; const size_t off = (size_t)row * ldc + col0; float s = 0.f;
#pragma unroll
                for (int bj = 0; bj < 2; ++bj) {
                    const f32x4 b0 = *(const f32x4*)(base + off + bj * HALF), b1 = *(const f32x4*)(base + off + bj * HALF + 4);
                    const f32x4 v0 = acc[ai][bj][m][0] + b0, v1 = acc[ai][bj][m][1] + b1;
                    *(f32x4*)(out + off + bj * HALF) = v0; *(f32x4*)(out + off + bj * HALF + 4) = v1;
                    if (hb) { u32x4 w; w.x = cvt_pk_bf16(v0[0], v0[1]); w.y = cvt_pk_bf16(v0[2], v0[3]); w.z = cvt_pk_bf16(v1[0], v1[1]); w.w = cvt_pk_bf16(v1[2], v1[3]); *(u32x4*)(hb + off + bj * HALF) = w; }
                    s += (v0[0] * v0[0] + v0[1] * v0[1]) + (v0[2] * v0[2] + v0[3] * v0[3]) + (v1[0] * v1[0] + v1[1] * v1[1]) + (v1[2] * v1[2] + v1[3] * v1[3]);
                }
                if (ss) { s += __shfl_xor(s, 16); s += __shfl_xor(s, 32); if (fq == 0) (void)__hip_atomic_fetch_add(ss + row, s, __ATOMIC_RELAXED, __HIP_MEMORY_SCOPE_AGENT); }
                asm volatile("" ::: "memory"); }
    }
};
struct EpiSwiGLU {
    static constexpr bool PERM = true, AFTER_DRAIN = false;
    bf16_t* O; int ldc; const float* ss; float inv_d, eps;
    __device__ __forceinline__ void operator()(const f32x4 (&acc)[2][2][4][2], const Unit& u, int wr, int wc, int fr, int fq) const {
        const int row0 = u.pm * BM + wr * 64 + fr, col0 = u.pn * HALF + wc * 32 + 8 * fq;
#pragma unroll
        for (int ai = 0; ai < 2; ++ai)
#pragma unroll
            for (int m = 0; m < 4; ++m) { const int row = row0 + ai * HALF + m * 16; const float rstd = __builtin_amdgcn_rsqf(ss[row] * inv_d + eps);
                float a[8];
#pragma unroll
                for (int n = 0; n < 2; ++n)
#pragma unroll
                    for (int i = 0; i < 4; ++i) { const float g = acc[ai][0][m][n][i] * rstd, up = acc[ai][1][m][n][i] * rstd;
                        a[4 * n + i] = g * __builtin_amdgcn_rcpf(1.0f + __builtin_amdgcn_exp2f(-1.4426950408889634f * g)) * up; }
                u32x4 w; w.x = cvt_pk_bf16(a[0], a[1]); w.y = cvt_pk_bf16(a[2], a[3]); w.z = cvt_pk_bf16(a[4], a[5]); w.w = cvt_pk_bf16(a[6], a[7]);
                *(u32x4*)(O + (size_t)row * ldc + col0) = w; }
    }
};

struct EpiHeads {
    static constexpr bool PERM = true, AFTER_DRAIN = false;
    bf16_t* O; int Mrows;
    __device__ __forceinline__ void operator()(const f32x4 (&acc)[2][2][4][2], const Unit& u, int wr, int wc, int fr, int fq) const {
        const int row0 = u.pm * BM + wr * 64 + fr, col = wc * 32 + 8 * fq;
#pragma unroll
        for (int bj = 0; bj < 2; ++bj) { bf16_t* base = O + (size_t)(u.pn * 2 + bj) * Mrows * HALF + col;
#pragma unroll
            for (int ai = 0; ai < 2; ++ai)
#pragma unroll
                for (int m = 0; m < 4; ++m) { const f32x4 v0 = acc[ai][bj][m][0], v1 = acc[ai][bj][m][1];
                    u32x4 w; w.x = cvt_pk_bf16(v0[0], v0[1]); w.y = cvt_pk_bf16(v0[2], v0[3]); w.z = cvt_pk_bf16(v1[0], v1[1]); w.w = cvt_pk_bf16(v1[2], v1[3]);
                    *(u32x4*)(base + (size_t)(row0 + ai * HALF + m * 16) * HALF) = w; } }
    }
};
struct EpiNull {
    static constexpr bool PERM = true, AFTER_DRAIN = false;
    __device__ __forceinline__ void operator()(const f32x4 (&acc)[2][2][4][2], const Unit&, int, int, int, int) const {
#pragma unroll
        for (int ai = 0; ai < 2; ++ai)
#pragma unroll
            for (int bj = 0; bj < 2; ++bj)
#pragma unroll
                for (int m = 0; m < 4; ++m)
#pragma unroll
                    for (int n = 0; n < 2; ++n) asm volatile("" :: "v"(acc[ai][bj][m][n]));
    }
};

template <class Epi, class Sched, bool ALIGN_EPI = false, bool SP2 = false>
__device__ __forceinline__ void gemm_phase(PG8_LAS unsigned char* lds, const Gemm g, const Sched& S, const Epi& E) {
    int tid_ = threadIdx.x; asm volatile("" : "+v"(tid_));
    const int tid = tid_, wid = __builtin_amdgcn_readfirstlane(tid >> 6), lane = tid & 63, wr = wid >> 2, wc = wid & 3, fr = lane & 15, fq = lane >> 4;
    const int K = g.K, nt = K / BK;
    unsigned voffA[2], voffB[2];
#pragma unroll
    for (int i = 0; i < 2; ++i) { int R, C; stage_rc(tid * 16 + i * 8192, R, C); const int Rb = Epi::PERM ? ((R & ~31) + perm32(R & 31)) : R;
        voffA[i] = (unsigned)(R * K + C) * 2u; voffB[i] = (unsigned)(Rb * K + C) * 2u; }
    const size_t kstep = (size_t)(BK * 2);
    const size_t hstep = (size_t)HALF * K * 2;
    const size_t tstep = 2 * hstep;
    const unsigned ldsw = (unsigned)wid * 1024u;
    const int aoff = lds_byte(wr * 64 + fr, fq * 8), boff = lds_byte(wc * 32 + fr, fq * 8);
#define PG8_SA(b, h) (((b) * 2 + (h)) * HTB)
#define PG8_SB(b, h) ((4 + (b) * 2 + (h)) * HTB)
#define PG8_STAGE(bufoff, gbase, voff) do { _Pragma("unroll") for (int _i = 0; _i < 2; ++_i) \
        __builtin_amdgcn_global_load_lds((const unsigned*)((const char*)(gbase) + (voff)[_i]), (PG8_LAS unsigned*)(lds + (bufoff) + ldsw + _i * 8192), 16, 0, 0); } while (0)
#define PG8_LDA(dst, b, h) do { _Pragma("unroll") for (int m = 0; m < 4; ++m) _Pragma("unroll") for (int k = 0; k < 2; ++k) dst[m][k] = *(const PG8_LAS bf16x8*)(lds + PG8_SA(b, h) + aoff + m * 2048 + k * 1024); } while (0)
#define PG8_LDB(dst, b, h) do { _Pragma("unroll") for (int n = 0; n < 2; ++n) _Pragma("unroll") for (int k = 0; k < 2; ++k) dst[n][k] = *(const PG8_LAS bf16x8*)(lds + PG8_SB(b, h) + boff + n * 2048 + k * 1024); } while (0)
#define PG8_MMA(ai, bj, At, Bt) do { __builtin_amdgcn_s_setprio(1); _Pragma("unroll") for (int m = 0; m < 4; ++m) _Pragma("unroll") for (int n = 0; n < 2; ++n) _Pragma("unroll") for (int k = 0; k < 2; ++k) \
        acc[ai][bj][m][n] = __builtin_amdgcn_mfma_f32_16x16x32_bf16(Bt[n][k], At[m][k], acc[ai][bj][m][n], 0, 0, 0); __builtin_amdgcn_s_setprio(0); } while (0)
#define PG8_WAIT_V(n) asm volatile("s_waitcnt vmcnt(" #n ")" ::: "memory")
#define PG8_WAIT_L(n) asm volatile("s_waitcnt lgkmcnt(" #n ")" ::: "memory")
#define PG8_BAR __builtin_amdgcn_s_barrier()
#define PG8_SCHED __builtin_amdgcn_sched_barrier(0)
    Unit cur, nxt; int ui = 0;
    if (!S.next(0, cur)) return;
    f32x4 acc[2][2][4][2];
#pragma unroll
    for (int a = 0; a < 2; ++a)
#pragma unroll
        for (int b = 0; b < 2; ++b)
#pragma unroll
            for (int m = 0; m < 4; ++m)
#pragma unroll
                for (int n = 0; n < 2; ++n) acc[a][b][m][n] = (f32x4){0.f, 0.f, 0.f, 0.f};
    bf16x8 At[4][2], B0[2][2], B1[2][2];
    const char* cA = (const char*)g.A + (size_t)cur.pm * tstep; const char* cB = (const char*)g.Bt + (size_t)cur.pn * tstep;
    S.a_ready(cur);
    if constexpr (SP2) {
        PG8_STAGE(PG8_SB(0, 0), cB, voffB); PG8_STAGE(PG8_SB(0, 1), cB + hstep, voffB); PG8_STAGE(PG8_SA(0, 0), cA, voffA); PG8_STAGE(PG8_SA(0, 1), cA + hstep, voffA);
        if (wr == 1) PG8_BAR;
        PG8_WAIT_V(2); PG8_BAR;
        PG8_STAGE(PG8_SB(1, 0), cB + kstep, voffB); PG8_STAGE(PG8_SA(1, 0), cA + kstep, voffA); PG8_STAGE(PG8_SB(1, 1), cB + hstep + kstep, voffB);
        PG8_WAIT_V(6); PG8_BAR;
    } else {
        PG8_STAGE(PG8_SB(0, 0), cB, voffB); PG8_STAGE(PG8_SA(0, 0), cA, voffA); PG8_STAGE(PG8_SB(0, 1), cB + hstep, voffB); PG8_STAGE(PG8_SA(0, 1), cA + hstep, voffA);
        if (wr == 1) PG8_BAR;
        PG8_WAIT_V(4); PG8_BAR;
        PG8_STAGE(PG8_SB(1, 0), cB + kstep, voffB); PG8_STAGE(PG8_SA(1, 0), cA + kstep, voffA); PG8_STAGE(PG8_SB(1, 1), cB + hstep + kstep, voffB);
        PG8_WAIT_V(6); PG8_BAR;
    }
    for (;;) {
        const bool has_next = S.next(ui + 1, nxt);
        const char* nA = has_next ? (const char*)g.A + (size_t)nxt.pm * tstep : cA; const char* nB = has_next ? (const char*)g.Bt + (size_t)nxt.pn * tstep : cB;
        for (int t = 0; t < nt; t += 2) {
            const bool last = (t == nt - 2);
            const char* a1 = cA + (size_t)(t + 1) * kstep;
            const char* a2 = last ? nA : cA + (size_t)(t + 2) * kstep; const char* b2 = last ? nB : cB + (size_t)(t + 2) * kstep;
            const char* a3 = a2 + kstep; const char* b3 = b2 + kstep;
            if (last && has_next) S.a_ready(nxt);
            if constexpr (SP2) {
            PG8_LDB(B0, 0, 0); PG8_LDB(B1, 0, 1); PG8_SCHED; PG8_LDA(At, 0, 0); PG8_STAGE(PG8_SA(1, 1), a1 + hstep, voffA);
            PG8_WAIT_V(8); PG8_WAIT_L(0); PG8_BAR; PG8_MMA(0, 0, At, B0); PG8_MMA(0, 1, At, B1); PG8_BAR; PG8_SCHED;
            PG8_LDA(At, 0, 1); PG8_STAGE(PG8_SB(0, 0), b2, voffB); PG8_STAGE(PG8_SB(0, 1), b2 + hstep, voffB); PG8_STAGE(PG8_SA(0, 0), a2, voffA);
            PG8_WAIT_V(8); PG8_WAIT_L(0); PG8_BAR; PG8_MMA(1, 0, At, B0); PG8_MMA(1, 1, At, B1); PG8_BAR; PG8_SCHED;
            PG8_LDB(B0, 1, 0); PG8_LDB(B1, 1, 1); PG8_SCHED; PG8_LDA(At, 1, 0); PG8_STAGE(PG8_SA(0, 1), a2 + hstep, voffA);
            PG8_WAIT_V(8); PG8_WAIT_L(0); PG8_BAR; PG8_MMA(0, 0, At, B0); PG8_MMA(0, 1, At, B1); PG8_BAR; PG8_SCHED;
            PG8_LDA(At, 1, 1); PG8_STAGE(PG8_SB(1, 0), b3, voffB); PG8_STAGE(PG8_SB(1, 1), b3 + hstep, voffB); PG8_STAGE(PG8_SA(1, 0), a3, voffA);
            PG8_WAIT_V(8); PG8_WAIT_L(0); PG8_BAR; PG8_MMA(1, 0, At, B0); PG8_MMA(1, 1, At, B1); PG8_BAR; PG8_SCHED;
            } else {
            PG8_LDB(B0, 0, 0); PG8_SCHED; PG8_LDA(At, 0, 0); PG8_STAGE(PG8_SA(1, 1), a1 + hstep, voffA);
            PG8_WAIT_L(8); PG8_BAR; PG8_WAIT_L(0); PG8_MMA(0, 0, At, B0); PG8_BAR; PG8_SCHED;
            PG8_LDB(B1, 0, 1); PG8_STAGE(PG8_SB(0, 0), b2, voffB);
            PG8_BAR; PG8_WAIT_L(0); PG8_MMA(0, 1, At, B1); PG8_BAR;
            PG8_LDA(At, 0, 1); PG8_STAGE(PG8_SA(0, 0), a2, voffA);
            PG8_BAR; PG8_WAIT_L(0); PG8_MMA(1, 0, At, B0); PG8_BAR; PG8_SCHED;
            PG8_STAGE(PG8_SB(0, 1), b2 + hstep, voffB);
            PG8_WAIT_V(6); PG8_BAR; PG8_MMA(1, 1, At, B1); PG8_BAR;
            PG8_LDB(B0, 1, 0); PG8_SCHED; PG8_LDA(At, 1, 0); PG8_STAGE(PG8_SA(0, 1), a2 + hstep, voffA);
            PG8_WAIT_L(8); PG8_BAR; PG8_WAIT_L(0); PG8_MMA(0, 0, At, B0); PG8_BAR; PG8_SCHED;
            PG8_LDB(B1, 1, 1); PG8_STAGE(PG8_SB(1, 0), b3, voffB);
            PG8_BAR; PG8_WAIT_L(0); PG8_MMA(0, 1, At, B1); PG8_BAR;
            PG8_LDA(At, 1, 1); PG8_STAGE(PG8_SA(1, 0), a3, voffA);
            PG8_BAR; PG8_WAIT_L(0); PG8_MMA(1, 0, At, B0); PG8_BAR; PG8_SCHED;
            PG8_STAGE(PG8_SB(1, 1), b3 + hstep, voffB);
            PG8_WAIT_V(6); PG8_BAR; PG8_MMA(1, 1, At, B1); PG8_BAR;
            }
        }
        if constexpr (ALIGN_EPI) { if (wr == 0) PG8_BAR; }
        if constexpr (!Epi::AFTER_DRAIN) { E(acc, cur, wr, wc, fr, fq); S.done(cur); }
        if (!has_next) break;
#pragma unroll
        for (int a = 0; a < 2; ++a)
#pragma unroll
            for (int b = 0; b < 2; ++b)
#pragma unroll
                for (int m = 0; m < 4; ++m)
#pragma unroll
                    for (int n = 0; n < 2; ++n) acc[a][b][m][n] = (f32x4){0.f, 0.f, 0.f, 0.f};
        cur = nxt; cA = nA; cB = nB; ++ui;
        if constexpr (ALIGN_EPI) { if (wr == 1) PG8_BAR; }
    }
    PG8_WAIT_V(0);
    if constexpr (!ALIGN_EPI) { if (wr == 0) PG8_BAR; }
    PG8_BAR;
    if constexpr (Epi::AFTER_DRAIN) { E.fused(acc, cur, wr, wc, fr, fq, lds, wid, lane); S.done(cur); }
#undef PG8_SA
#undef PG8_SB
#undef PG8_STAGE
#undef PG8_LDA
#undef PG8_LDB
#undef PG8_MMA
#undef PG8_WAIT_V
#undef PG8_WAIT_L
#undef PG8_BAR
#undef PG8_SCHED
}
}

constexpr int NWAVES = 8;
#ifndef ATTN_NAIVE
#define ATTN_NAIVE 0
#endif
#ifndef ATTN_V1
#define ATTN_V1 0
#endif
#ifndef R1_V1
#define R1_V1 0
#endif
#ifndef R3_V1
#define R3_V1 0
#endif
#ifndef R1_NAIVE
#define R1_NAIVE 0
#endif
#ifndef R3_NAIVE
#define R3_NAIVE 0
#endif
#ifndef PROBE_REPEAT
#define PROBE_REPEAT 0
#endif
#ifndef PROBE_T
#define PROBE_T 0
#endif
#ifndef PROBE_MULT
#define PROBE_MULT 16
#endif
#ifndef PROBE_USE_B
#define PROBE_USE_B 0
#endif
#ifndef PROBE_BLOCK
#define PROBE_BLOCK 0
#endif
#ifndef MK_N_LAUNCHES
#define MK_N_LAUNCHES 1
#endif
constexpr int PER_PHASE = 9;
constexpr int N_LAUNCHES = MK_N_LAUNCHES;

constexpr int BATCH = 4, SEQ = 4096, D = 2048, M = BATCH * SEQ, HD = 128, NH = 8, DATT = 1024, DRET = 1024, DIN = 7168, DFF = 5632, NGU = 2 * DFF, CH = 128, NCH = SEQ / CH;
constexpr float EPS = 1e-6f;
constexpr int COL_QA = 0, COL_KA = 1024, COL_VA = 2048, COL_QR = 3072, COL_KR = 4096, COL_VR = 5120, COL_GR = 6144;

constexpr size_t MiB = 1u << 20;
constexpr size_t WS_CTL = 0, CTL_ZERO_BYTES = 1 * MiB;
constexpr size_t WS_WIN = 1 * MiB, WS_WOUT = 29 * MiB, WS_WGU = 37 * MiB, WS_WDN = 81 * MiB;
constexpr size_t WS_LSE = 103 * MiB;
constexpr size_t WS_XN = 105 * MiB;
constexpr size_t WS_PROJ = 169 * MiB;
constexpr size_t WS_MIX = 393 * MiB;
constexpr size_t WS_END = 457 * MiB;
static_assert(WS_WIN + (size_t)DIN * D * 2 <= WS_WOUT && WS_WOUT + (size_t)D * D * 2 <= WS_WGU && WS_WGU + (size_t)NGU * D * 2 <= WS_WDN && WS_WDN + (size_t)D * DFF * 2 <= WS_LSE, "weight map");
static_assert(WS_XN + (size_t)M * D * 2 <= WS_PROJ && WS_PROJ + (size_t)M * DIN * 2 <= WS_MIX && WS_MIX + (size_t)M * D * 2 <= WS_END, "activation map");
constexpr int CW_TMO = 0, CW_CODE = 1, CW_BAR = 4096;
constexpr size_t CTL_SS1 = 256 * 1024;
constexpr size_t ST_HALF = (size_t)BATCH * NH * NCH * HD * HD;

constexpr int RING_OFF = 0, RING_BYTES = 143360;
constexpr int LDSCTL_OFF = RING_BYTES, MISC_OFF = LDSCTL_OFF + 320;
constexpr int LDS_BYTES = 147456;
static_assert(MISC_OFF + 128 <= LDS_BYTES, "LDS map");

#define GAS __attribute__((address_space(1)))
#define LAS __attribute__((address_space(3)))
typedef unsigned short bf16;
typedef unsigned v4u __attribute__((ext_vector_type(4)));
typedef float f32x4 __attribute__((ext_vector_type(4)));
typedef GAS unsigned gu32;
#define RLX_AGENT __ATOMIC_RELAXED, __HIP_MEMORY_SCOPE_AGENT
#define LDS_WAIT() asm volatile("s_waitcnt lgkmcnt(0)" ::: "memory")
#define VM_WAIT() asm volatile("s_waitcnt vmcnt(0)" ::: "memory")
__device__ __forceinline__ unsigned f2bf(float f) { unsigned u = __builtin_bit_cast(unsigned, f); return (u + 0x7fffu + ((u >> 16) & 1u)) >> 16; }
__device__ __forceinline__ unsigned pk2(float lo, float hi) { return f2bf(lo) | (f2bf(hi) << 16); }
__device__ __forceinline__ float bflo(unsigned w) { return __builtin_bit_cast(float, w << 16); }
__device__ __forceinline__ float bfhi(unsigned w) { return __builtin_bit_cast(float, w & 0xffff0000u); }

#define XB_TMO      128
#define XB_XCNT(j)  (256  + 64 * (j))
#define XB_XSUB(j)  (1280 + 64 * (j))
#define XB_XGEN(j)  (2304 + 64 * (j))
#define XB_TOP      3328
#define XB_TOPGEN   3392
#define XCD_BAR_WORDS 3456
#define XB_SPIN_CAP (1u << 18)

__device__ __forceinline__ unsigned xb_ld(unsigned* p)              { return __hip_atomic_load(p, __ATOMIC_RELAXED, __HIP_MEMORY_SCOPE_AGENT); }
__device__ __forceinline__ unsigned xb_add(unsigned* p, unsigned v) { return __hip_atomic_fetch_add(p, v, __ATOMIC_RELAXED, __HIP_MEMORY_SCOPE_AGENT); }
__device__ __forceinline__ unsigned xb_xcc_id() { return (unsigned)__builtin_amdgcn_s_getreg((3 << 11) | 20) & 0xFu; }
#define XB_SPIN(cond, bar) do { unsigned _sp = 0; while (cond) { __builtin_amdgcn_s_sleep(1); \
    if ((++_sp & 255u) == 0u) { if (xb_ld(&(bar)[XB_TMO])) break; if (_sp > XB_SPIN_CAP) { atomicAdd(&(bar)[XB_TMO], 1u); break; } } } } while (0)

struct XcdBarrier {
    unsigned* bar; unsigned x;
    volatile LAS unsigned* st;
};

__device__ __forceinline__ XcdBarrier xcd_barrier_post(unsigned* bar, volatile LAS unsigned* st) {
    XcdBarrier b; b.bar = bar; b.x = xb_xcc_id(); b.st = st;
    if (threadIdx.x == 0) st[2] = xb_add(&bar[XB_XCNT(b.x)], 1u);
    return b;
}
__device__ __forceinline__ void xcd_barrier_complete(unsigned* bar, unsigned x, unsigned& nloc, unsigned& nx) {
    const unsigned G = gridDim.x * gridDim.y * gridDim.z;
    unsigned sum, cnt, mine, sp = 0u;
    for (;;) {
        sum = 0u; cnt = 0u; mine = 0u;
#pragma unroll
        for (unsigned j = 0; j < 16; ++j) { const unsigned c = xb_ld(&bar[XB_XCNT(j)]); sum += c; cnt += (c > 0u) ? 1u : 0u; mine = (j == x) ? c : mine; }
        if (sum == G) break;
        __builtin_amdgcn_s_sleep(1);
        if ((++sp & 255u) == 0u) { if (xb_ld(&bar[XB_TMO])) break; if (sp > XB_SPIN_CAP) { atomicAdd(&bar[XB_TMO], 1u); break; } }
    }
    nloc = mine > 0u ? mine : 1u; nx = cnt > 0u ? cnt : 1u;
}

__device__ __forceinline__ void xcd_barrier(const XcdBarrier& b) {
    asm volatile("s_waitcnt vmcnt(0)" ::: "memory");
    __syncthreads();
    if (threadIdx.x == 0) {
        unsigned* bar = b.bar;
        __builtin_amdgcn_s_waitcnt(0);
        unsigned nloc = b.st[0], nx = b.st[1];
        if (nloc == 0u) { xcd_barrier_complete(bar, b.x, nloc, nx); b.st[0] = nloc; b.st[1] = nx; }
        const unsigned old = xb_add(&bar[XB_XSUB(b.x)], 1u);
        const unsigned gen = old / nloc;
        if (old + 1u == (gen + 1u) * nloc) {
            __builtin_amdgcn_fence(__ATOMIC_RELEASE, "agent");
            asm volatile("s_waitcnt vmcnt(0)" ::: "memory");
            const unsigned og = xb_add(&bar[XB_TOP], 1u);
            const unsigned tg = og / nx;
            if (og + 1u == (tg + 1u) * nx) xb_add(&bar[XB_TOPGEN], 1u);
            else XB_SPIN(xb_ld(&bar[XB_TOPGEN]) == tg, bar);
            __builtin_amdgcn_fence(__ATOMIC_ACQUIRE, "agent");
            xb_add(&bar[XB_XGEN(b.x)], 1u);
            asm volatile("s_waitcnt vmcnt(0)" ::: "memory");
        } else {
            XB_SPIN(xb_ld(&bar[XB_XGEN(b.x)]) == gen, bar);
            __builtin_amdgcn_fence(__ATOMIC_ACQUIRE, "agent");
            asm volatile("s_waitcnt vmcnt(0)" ::: "memory");
        }
    }
    __syncthreads();
}

struct Frame {
    LAS unsigned char* lds;
    volatile LAS unsigned* MISC;
    gu32* ctl;
    int tid, lane, wave;
    int vcu, G;
    const float *x, *w_mix, *w_in, *decf, *decb, *w_retn, *w_out, *w_ffn, *w_gate, *w_up, *w_down, *w_fin; float* out;
    bf16 *Win_t, *Wout_t, *Wgu_t, *Wdn_t;
    bf16 *XN, *PROJ, *MIX, *ACT;
    float *STF, *STB, *SS1, *LSE;
    unsigned long long tA, tB;
};
#if PROBE_T
#define RT() __builtin_amdgcn_s_memrealtime()
#define T_ADD(acc, t0) do { __builtin_amdgcn_sched_barrier(0); (acc) += RT() - (t0); __builtin_amdgcn_sched_barrier(0); } while (0)
#define T_START(t0) do { __builtin_amdgcn_sched_barrier(0); (t0) = RT(); __builtin_amdgcn_sched_barrier(0); } while (0)
#else
#define T_ADD(acc, t0) do {} while (0)
#define T_START(t0) do {} while (0)
#endif

__device__ __forceinline__ float wave_sum(float v) {
#pragma unroll
    for (int o = 1; o < 64; o <<= 1) v += __shfl_xor(v, o);
    return v;
}
__device__ __forceinline__ float wave_max(float v) {
#pragma unroll
    for (int o = 1; o < 64; o <<= 1) v = fmaxf(v, __shfl_xor(v, o));
    return v;
}
__device__ __forceinline__ void p0_transpose_item(const float* W, int K, int N, bf16* WT, int row_base, const float* kscale, LAS float* scr, int k0, int n0, int lane) {
#pragma unroll 8
    for (int i = 0; i < 32; ++i) { const int kk = 2 * i + (lane >> 5); float v = W[(size_t)(k0 + kk) * N + n0 + (lane & 31)]; if (kscale) v *= kscale[k0 + kk]; scr[kk * 33 + (lane & 31)] = v; }
    LDS_WAIT(); asm volatile("" ::: "memory");
    const int c = lane & 7;
#pragma unroll
    for (int j = 0; j < 4; ++j) { const int n = (lane >> 3) + 8 * j; const LAS float* s = scr + (8 * c) * 33 + n;
        v4u o; o.x = pk2(s[0 * 33], s[1 * 33]); o.y = pk2(s[2 * 33], s[3 * 33]); o.z = pk2(s[4 * 33], s[5 * 33]); o.w = pk2(s[6 * 33], s[7 * 33]);
        *(GAS v4u*)(WT + (size_t)(row_base + n) * K + k0 + 8 * c) = o; }
    LDS_WAIT(); asm volatile("" ::: "memory");
}
__device__ __forceinline__ void p0_prologue(Frame& F) {
    LAS float* scr = (LAS float*)(F.lds + RING_OFF + F.wave * 16384);
    const int gw = F.vcu * NWAVES + F.wave, NGW = F.G * NWAVES;
    constexpr int I_IN = (D / 64) * (DIN / 32), I_OUT = (D / 64) * (D / 32), I_G = (D / 64) * (DFF / 32), I_DN = (DFF / 64) * (D / 32);
    constexpr int NITEMS = I_IN + I_OUT + 2 * I_G + I_DN;
    for (int it = gw; it < NITEMS; it += NGW) {
        int r = it;
        if (r < I_IN) { const int nblk = DIN / 32, kb = r / nblk, nb = r % nblk; p0_transpose_item(F.w_in, D, DIN, F.Win_t, 32 * nb, nullptr, scr, 64 * kb, 32 * nb, F.lane); continue; } r -= I_IN;
        if (r < I_OUT) { const int nblk = D / 32, kb = r / nblk, nb = r % nblk; p0_transpose_item(F.w_out, D, D, F.Wout_t, 32 * nb, nullptr, scr, 64 * kb, 32 * nb, F.lane); continue; } r -= I_OUT;
        if (r < 2 * I_G) { const int up = r >= I_G; if (up) r -= I_G; const int nblk = DFF / 32, kb = r / nblk, nb = r % nblk, n0 = 32 * nb;
            p0_transpose_item(up ? F.w_up : F.w_gate, D, DFF, F.Wgu_t, 256 * (n0 >> 7) + (n0 & 127) + (up ? 128 : 0), F.w_ffn, scr, 64 * kb, n0, F.lane); continue; } r -= 2 * I_G;
        { const int nblk = D / 32, kb = r / nblk, nb = r % nblk; p0_transpose_item(F.w_down, DFF, D, F.Wdn_t, 32 * nb, nullptr, scr, 64 * kb, 32 * nb, F.lane); }
    }
    for (int m = gw; m < M; m += NGW) {
        const GAS f32x4* xr = (const GAS f32x4*)(F.x + (size_t)m * D) + F.lane; const GAS f32x4* wr = (const GAS f32x4*)F.w_mix + F.lane;
        f32x4 v[8]; float s = 0.f;
#pragma unroll
        for (int j = 0; j < 8; ++j) { v[j] = xr[64 * j]; s += (v[j].x * v[j].x + v[j].y * v[j].y) + (v[j].z * v[j].z + v[j].w * v[j].w); }
        const float rstd = 1.0f / sqrtf(wave_sum(s) * (1.0f / D) + EPS);
        GAS unsigned long long* o8 = (GAS unsigned long long*)(F.XN + (size_t)m * D) + F.lane;
#pragma unroll
        for (int j = 0; j < 8; ++j) { const f32x4 w = wr[64 * j]; o8[64 * j] = (unsigned long long)pk2(v[j].x * rstd * w.x, v[j].y * rstd * w.y) | ((unsigned long long)pk2(v[j].z * rstd * w.z, v[j].w * rstd * w.w) << 32); }
    }
}

#define HP(col, h) (F.PROJ + (size_t)((col) / HD + (h)) * M * HD)
__device__ __forceinline__ void p2_attn_naive(Frame& F) {
    LAS float* qs = (LAS float*)(F.lds + RING_OFF + F.wave * 4096);
    LAS float* ps = qs + 128;
    const int gw = F.vcu * NWAVES + F.wave, NGW = F.G * NWAVES, lane = F.lane;
    for (int item = gw; item < BATCH * NH * SEQ; item += NGW) {
        const int bh = item >> 12, t = item & 4095, b = bh >> 3, h = bh & 7;
        const float slope = exp2f(-(float)(h + 1));
        const bf16* Qrow = HP(COL_QA, h) + (size_t)(b * SEQ + t) * HD;
        const bf16* Kb = HP(COL_KA, h) + (size_t)(b * SEQ) * HD;
        const bf16* Vb = HP(COL_VA, h) + (size_t)(b * SEQ) * HD;
        { const unsigned qq = *(const GAS unsigned*)(Qrow + 2 * lane); qs[2 * lane] = bflo(qq) * 0.08838834764831845f; qs[2 * lane + 1] = bfhi(qq) * 0.08838834764831845f; }
        LDS_WAIT();
        float sc[3][3]; float mx = -INFINITY;
#pragma unroll
        for (int p = 0; p < 3; ++p) { const int dil = 1 << (2 * p);
#pragma unroll
            for (int k = 0; k < 3; ++k) { const int idx = lane + 64 * k, j = idx - 64, s = t + j * dil; float v = -INFINITY;
                if (idx < 129 && s >= 0 && s < SEQ) { const GAS v4u* kr = (const GAS v4u*)(Kb + (size_t)s * HD); float dot = 0.f;
#pragma unroll 4
                    for (int c = 0; c < 16; ++c) { const v4u kk = kr[c]; const LAS float* q8 = qs + 8 * c;
                        dot += q8[0] * bflo(kk.x) + q8[1] * bfhi(kk.x) + q8[2] * bflo(kk.y) + q8[3] * bfhi(kk.y) + q8[4] * bflo(kk.z) + q8[5] * bfhi(kk.z) + q8[6] * bflo(kk.w) + q8[7] * bfhi(kk.w); }
                    v = dot - slope * (float)(dil * (j < 0 ? -j : j)); }
                sc[p][k] = v; mx = fmaxf(mx, v); } }
        mx = wave_max(mx);
        float l = 0.f;
#pragma unroll
        for (int p = 0; p < 3; ++p)
#pragma unroll
            for (int k = 0; k < 3; ++k) { const float e = __expf(sc[p][k] - mx); l += e; ps[p * 192 + lane + 64 * k] = e; }
        l = wave_sum(l);
        LDS_WAIT();
        float o0 = 0.f, o1 = 0.f;
#pragma unroll
        for (int p = 0; p < 3; ++p) { const int dil = 1 << (2 * p);
            for (int idx = 0; idx < 129; ++idx) { const int s = t + (idx - 64) * dil;
                if (s >= 0 && s < SEQ) { const float pv = ps[p * 192 + idx]; const unsigned vv = *(const GAS unsigned*)(Vb + (size_t)s * HD + 2 * lane); o0 += pv * bflo(vv); o1 += pv * bfhi(vv); } } }
        const float il = 1.0f / l;
        *(GAS unsigned*)(F.MIX + (size_t)(b * SEQ + t) * D + h * HD + 2 * lane) = pk2(o0 * il, o1 * il);
        LDS_WAIT();
    }
}
__device__ __forceinline__ void p2_r1_naive(Frame& F) {
    LAS float* Ks = (LAS float*)(F.lds + RING_OFF); LAS float* Vs = Ks + CH * HD;
    const int tid = F.tid;
    for (int item = F.vcu; item < BATCH * NH * NCH; item += F.G) {
        const int bh = item >> 5, c = item & 31, b = bh >> 3, h = bh & 7; const size_t row0 = (size_t)b * SEQ + c * CH;
        const bf16* Kg = HP(COL_KR, h) + row0 * HD; const bf16* Vg = HP(COL_VR, h) + row0 * HD;
        { const int row = tid >> 2, seg = tid & 3;
#pragma unroll
          for (int q = 0; q < 4; ++q) { const v4u kk = *(const GAS v4u*)(Kg + (size_t)row * HD + 32 * seg + 8 * q); const v4u vv = *(const GAS v4u*)(Vg + (size_t)row * HD + 32 * seg + 8 * q);
              LAS float* kd = Ks + row * HD + 32 * seg + 8 * q; LAS float* vd = Vs + row * HD + 32 * seg + 8 * q;
              kd[0] = bflo(kk.x); kd[1] = bfhi(kk.x); kd[2] = bflo(kk.y); kd[3] = bfhi(kk.y); kd[4] = bflo(kk.z); kd[5] = bfhi(kk.z); kd[6] = bflo(kk.w); kd[7] = bfhi(kk.w);
              vd[0] = bflo(vv.x); vd[1] = bfhi(vv.x); vd[2] = bflo(vv.y); vd[3] = bfhi(vv.y); vd[4] = bflo(vv.z); vd[5] = bfhi(vv.z); vd[6] = bflo(vv.w); vd[7] = bfhi(vv.w); } }
        __syncthreads();
        const float lgf = -__expf(F.decf[h]), lgb = -__expf(F.decb[h]);
        const int e = tid >> 2, dq = tid & 3;
        float af[32], ab[32];
#pragma unroll
        for (int i = 0; i < 32; ++i) { af[i] = 0.f; ab[i] = 0.f; }
        for (int j = 0; j < CH; ++j) { const float v = Vs[j * HD + e], vf = v * __expf(lgf * (float)(CH - 1 - j)), vb = v * __expf(lgb * (float)j);
            const LAS f32x4* k4 = (const LAS f32x4*)(Ks + j * HD + 32 * dq);
#pragma unroll
            for (int i = 0; i < 8; ++i) { const f32x4 k = k4[i];
                af[4 * i] += vf * k.x; af[4 * i + 1] += vf * k.y; af[4 * i + 2] += vf * k.z; af[4 * i + 3] += vf * k.w;
                ab[4 * i] += vb * k.x; ab[4 * i + 1] += vb * k.y; ab[4 * i + 2] += vb * k.z; ab[4 * i + 3] += vb * k.w; } }
        GAS f32x4* of = (GAS f32x4*)(F.STF + (size_t)item * HD * HD + e * HD + 32 * dq); GAS f32x4* ob = (GAS f32x4*)(F.STB + (size_t)item * HD * HD + e * HD + 32 * dq);
#pragma unroll
        for (int i = 0; i < 8; ++i) { of[i] = (f32x4){af[4 * i], af[4 * i + 1], af[4 * i + 2], af[4 * i + 3]}; ob[i] = (f32x4){ab[4 * i], ab[4 * i + 1], ab[4 * i + 2], ab[4 * i + 3]}; }
        __syncthreads();
    }
}
__device__ __forceinline__ bf16* sbf_row(bf16* proj, int slot, int e);
__device__ __forceinline__ void p3_scan(Frame& F) {
    const int gt = F.vcu * (NWAVES * 64) + F.tid, NT = F.G * NWAVES * 64;
    for (int idx = gt; idx < 2 * BATCH * NH * 4096; idx += NT) {
        const int dir = idx / (BATCH * NH * 4096), rem = idx % (BATCH * NH * 4096), bh = rem >> 12, q = rem & 4095, h = bh & 7;
        const float g = __expf(-__expf(dir ? F.decb[h] : F.decf[h]) * (float)CH);
        GAS f32x4* base = (GAS f32x4*)(dir ? F.STB : F.STF) + (size_t)bh * NCH * 4096 + q;
        f32x4 s = (f32x4){0.f, 0.f, 0.f, 0.f};
#pragma unroll 8
        for (int cc = 0; cc < NCH; ++cc) { const int c = dir ? NCH - 1 - cc : cc; const f32x4 t = base[(size_t)c * 4096];
#if R3_NAIVE
            base[(size_t)c * 4096] = s;
#else
            { unsigned long long o = (unsigned long long)pk2(s.x, s.y) | ((unsigned long long)pk2(s.z, s.w) << 32); *(GAS unsigned long long*)(sbf_row(F.PROJ, 2 * (bh * NCH + c) + dir, q >> 5) + 4 * (q & 31)) = o; }
#endif
            s = s * g + t; }
    }
}
__device__ __forceinline__ void p4_r3_naive(Frame& F) {
    LAS bf16* Qs = (LAS bf16*)(F.lds + RING_OFF); LAS bf16* KVs = Qs + CH * HD; LAS float* As = (LAS float*)(F.lds + RING_OFF + 65536);
    const int tid = F.tid; const float scale = 0.08838834764831845f;
    for (int item = F.vcu; item < BATCH * NH * NCH; item += F.G) {
        const int bh = item >> 5, c = item & 31, b = bh >> 3, h = bh & 7; const size_t row0 = (size_t)b * SEQ + c * CH;
        const bf16* Qg = HP(COL_QR, h) + row0 * HD; const bf16* Kg = HP(COL_KR, h) + row0 * HD;
        const bf16* Vg = HP(COL_VR, h) + row0 * HD; const bf16* Gg = HP(COL_GR, h) + row0 * HD;
        const float lgf = -__expf(F.decf[h]), lgb = -__expf(F.decb[h]);
        const int i = tid >> 2, part = tid & 3;
#pragma unroll
        for (int q = 0; q < 4; ++q) { *(LAS v4u*)(Qs + i * HD + 32 * part + 8 * q) = *(const GAS v4u*)(Qg + (size_t)i * HD + 32 * part + 8 * q);
                                      *(LAS v4u*)(KVs + i * HD + 32 * part + 8 * q) = *(const GAS v4u*)(Kg + (size_t)i * HD + 32 * part + 8 * q); }
        __syncthreads();
        for (int jj = 0; jj < 32; ++jj) { const int j = 32 * part + jj; float dot = 0.f;
#pragma unroll 4
            for (int c8 = 0; c8 < 16; ++c8) { const v4u qq = *(const LAS v4u*)(Qs + i * HD + 8 * c8), kk = *(const LAS v4u*)(KVs + j * HD + 8 * c8);
                dot += bflo(qq.x) * bflo(kk.x) + bfhi(qq.x) * bfhi(kk.x) + bflo(qq.y) * bflo(kk.y) + bfhi(qq.y) * bfhi(kk.y) + bflo(qq.z) * bflo(kk.z) + bfhi(qq.z) * bfhi(kk.z) + bflo(qq.w) * bflo(kk.w) + bfhi(qq.w) * bfhi(kk.w); }
            const float dec = (j <= i) ? __expf(lgf * (float)(i - j)) : __expf(lgb * (float)(j - i));
            As[i * CH + j] = dot * scale * dec; }
        __syncthreads();
#pragma unroll
        for (int q = 0; q < 4; ++q) *(LAS v4u*)(KVs + i * HD + 32 * part + 8 * q) = *(const GAS v4u*)(Vg + (size_t)i * HD + 32 * part + 8 * q);
        __syncthreads();
        const int e0 = 32 * part;
        float acc[32], accf[32], accb[32];
#pragma unroll
        for (int k = 0; k < 32; ++k) { acc[k] = 0.f; accf[k] = 0.f; accb[k] = 0.f; }
        for (int j = 0; j < CH; ++j) { const float a = As[i * CH + j];
#pragma unroll
            for (int q = 0; q < 4; ++q) { const v4u vv = *(const LAS v4u*)(KVs + j * HD + e0 + 8 * q);
                acc[8 * q] += a * bflo(vv.x); acc[8 * q + 1] += a * bfhi(vv.x); acc[8 * q + 2] += a * bflo(vv.y); acc[8 * q + 3] += a * bfhi(vv.y);
                acc[8 * q + 4] += a * bflo(vv.z); acc[8 * q + 5] += a * bfhi(vv.z); acc[8 * q + 6] += a * bflo(vv.w); acc[8 * q + 7] += a * bfhi(vv.w); } }
        const float* Sf = F.STF + (size_t)item * HD * HD; const float* Sb = F.STB + (size_t)item * HD * HD;
        for (int d4 = 0; d4 < HD; d4 += 4) { const unsigned long long qq = *(const LAS unsigned long long*)(Qs + i * HD + d4);
            const float q0 = bflo((unsigned)qq), q1 = bfhi((unsigned)qq), q2 = bflo((unsigned)(qq >> 32)), q3 = bfhi((unsigned)(qq >> 32));
#pragma unroll
            for (int k = 0; k < 32; ++k) { const f32x4 sf = *(const GAS f32x4*)(Sf + (size_t)(e0 + k) * HD + d4), sb = *(const GAS f32x4*)(Sb + (size_t)(e0 + k) * HD + d4);
                accf[k] += q0 * sf.x + q1 * sf.y + q2 * sf.z + q3 * sf.w; accb[k] += q0 * sb.x + q1 * sb.y + q2 * sb.z + q3 * sb.w; } }
        const float ff = __expf(lgf * (float)(i + 1)) * scale, fb = __expf(lgb * (float)(CH - i)) * scale;
        float ssq = 0.f;
#pragma unroll
        for (int k = 0; k < 32; ++k) { acc[k] += ff * accf[k] + fb * accb[k]; ssq += acc[k] * acc[k]; }
        ssq += __shfl_xor(ssq, 1); ssq += __shfl_xor(ssq, 2);
        const float rms = 1.0f / sqrtf(ssq * (1.0f / HD) + EPS);
        bf16* orow = F.MIX + (row0 + i) * D + DATT + h * HD + e0;
#pragma unroll
        for (int q = 0; q < 4; ++q) { const v4u gg = *(const GAS v4u*)(Gg + (size_t)i * HD + e0 + 8 * q); float r[8]; const float gv[8] = {bflo(gg.x), bfhi(gg.x), bflo(gg.y), bfhi(gg.y), bflo(gg.z), bfhi(gg.z), bflo(gg.w), bfhi(gg.w)};
#pragma unroll
            for (int k = 0; k < 8; ++k) { const float g = gv[k]; r[k] = acc[8 * q + k] * rms * F.w_retn[h * HD + e0 + 8 * q + k] * (g / (1.0f + __expf(-g))); }
            v4u o; o.x = pk2(r[0], r[1]); o.y = pk2(r[2], r[3]); o.z = pk2(r[4], r[5]); o.w = pk2(r[6], r[7]); *(GAS v4u*)(orow + 8 * q) = o; }
        __syncthreads();
    }
}
__device__ __forceinline__ void p8_final(Frame& F, bool dummy) {
    const int gw = F.vcu * NWAVES + F.wave, NGW = F.G * NWAVES;
    for (int m = gw; m < M; m += NGW) {
        GAS f32x4* xr = (GAS f32x4*)(F.out + (size_t)m * D) + F.lane; const GAS f32x4* wr = (const GAS f32x4*)F.w_fin + F.lane;
        f32x4 v[8]; float s = 0.f;
#pragma unroll
        for (int j = 0; j < 8; ++j) { v[j] = xr[64 * j]; s += (v[j].x * v[j].x + v[j].y * v[j].y) + (v[j].z * v[j].z + v[j].w * v[j].w); }
        const float rstd = 1.0f / sqrtf(wave_sum(s) * (1.0f / D) + EPS);
#pragma unroll
        for (int j = 0; j < 8; ++j) xr[64 * j] = dummy ? (v[j] + (rstd > 1e30f ? 1.0f : 0.0f)) : v[j] * rstd * wr[64 * j];
    }
}


typedef short bf16x8 __attribute__((ext_vector_type(8)));
typedef float f32x16 __attribute__((ext_vector_type(16)));
typedef unsigned u32x2 __attribute__((ext_vector_type(2)));
typedef float f32x2_t __attribute__((ext_vector_type(2))); typedef __bf16 bf16x2_t __attribute__((ext_vector_type(2)));
__device__ __forceinline__ unsigned cvtpk(float lo, float hi) { f32x2_t v = {lo, hi}; bf16x2_t b = __builtin_convertvector(v, bf16x2_t); return __builtin_bit_cast(unsigned, b); }
#define MFMA32(a, b, c) __builtin_amdgcn_mfma_f32_32x32x16_bf16((a), (b), (c), 0, 0, 0)
__device__ __forceinline__ f32x16 zero16() { f32x16 z;
#pragma unroll
    for (int i = 0; i < 16; ++i) z[i] = 0.f; return z; }
__device__ __forceinline__ bf16x8 pack8(const f32x16& x, int sp) {
    v4u p; p.x = cvtpk(x[8 * sp + 0], x[8 * sp + 1]); p.y = cvtpk(x[8 * sp + 2], x[8 * sp + 3]); p.z = cvtpk(x[8 * sp + 4], x[8 * sp + 5]); p.w = cvtpk(x[8 * sp + 6], x[8 * sp + 7]);
    return __builtin_bit_cast(bf16x8, p); }
__device__ __forceinline__ bf16x8 cat8(u32x2 lo, u32x2 hi) { v4u p; p.x = lo.x; p.y = lo.y; p.z = hi.x; p.w = hi.y; return __builtin_bit_cast(bf16x8, p); }
__device__ __forceinline__ unsigned elt16(const v4u& v, int i) { const unsigned w = v[i >> 1]; return (i & 1) ? (w >> 16) : (w & 0xffffu); }

__device__ __forceinline__ bf16* sbf_row(bf16* proj, int slot, int e) { return proj + ((size_t)slot * HD + e) * HD; }
__device__ __forceinline__ void p2_r1_mfma(Frame& F) {
    constexpr int P = 272;
    LAS unsigned char* KT = F.lds + RING_OFF; LAS unsigned char* VFT = KT + 128 * P; LAS unsigned char* VBT = VFT + 128 * P;
    const int w = F.wave;
    for (int item = F.vcu; item < BATCH * NH * NCH; item += F.G) {
        int tid = F.tid; asm volatile("" : "+v"(tid)); const int lane = tid & 63, r = lane & 31, hh = lane >> 5;
        const int bh = item >> 5, c = item & 31, b = bh >> 3, h = bh & 7; const size_t row0 = (size_t)b * SEQ + c * CH;
        const bf16* Kg = HP(COL_KR, h) + row0 * HD; const bf16* Vg = HP(COL_VR, h) + row0 * HD;
        const float lgf = -__expf(F.decf[h]), lgb = -__expf(F.decb[h]);
        {
            const int jg = tid & 31, dc = tid >> 5; v4u kr[4], vr[4]; float sf[4], sb[4];
#pragma unroll
            for (int q = 0; q < 4; ++q) { kr[q] = *(const GAS v4u*)(Kg + (size_t)(4 * jg + q) * HD + 8 * dc); vr[q] = *(const GAS v4u*)(Vg + (size_t)(4 * jg + q) * HD + 8 * dc);
                sf[q] = __expf(lgf * (float)(CH - 1 - (4 * jg + q))); sb[q] = __expf(lgb * (float)(4 * jg + q)); }
#pragma unroll
            for (int i = 0; i < 8; ++i) { const int off = (8 * dc + i) * P + 8 * jg;
                u32x2 kk; kk.x = elt16(kr[0], i) | (elt16(kr[1], i) << 16); kk.y = elt16(kr[2], i) | (elt16(kr[3], i) << 16); *(LAS u32x2*)(KT + off) = kk;
                const float v0 = __builtin_bit_cast(float, elt16(vr[0], i) << 16), v1 = __builtin_bit_cast(float, elt16(vr[1], i) << 16), v2 = __builtin_bit_cast(float, elt16(vr[2], i) << 16), v3 = __builtin_bit_cast(float, elt16(vr[3], i) << 16);
                u32x2 vf; vf.x = cvtpk(v0 * sf[0], v1 * sf[1]); vf.y = cvtpk(v2 * sf[2], v3 * sf[3]); *(LAS u32x2*)(VFT + off) = vf;
                u32x2 vb; vb.x = cvtpk(v0 * sb[0], v1 * sb[1]); vb.y = cvtpk(v2 * sb[2], v3 * sb[3]); *(LAS u32x2*)(VBT + off) = vb; }
        }
        __syncthreads();
        const int et = w & 3, dt0 = 2 * (w >> 2);
        f32x16 accf[2], accb[2]; accf[0] = zero16(); accf[1] = zero16(); accb[0] = zero16(); accb[1] = zero16();
#pragma unroll
        for (int s = 0; s < 8; ++s) {
            const bf16x8 af = *(const LAS bf16x8*)(VFT + (32 * et + r) * P + 32 * s + 16 * hh), ab = *(const LAS bf16x8*)(VBT + (32 * et + r) * P + 32 * s + 16 * hh);
#pragma unroll
            for (int t = 0; t < 2; ++t) { const bf16x8 bk = *(const LAS bf16x8*)(KT + (32 * (dt0 + t) + r) * P + 32 * s + 16 * hh);
                accf[t] = MFMA32(af, bk, accf[t]); accb[t] = MFMA32(ab, bk, accb[t]); }
        }
        float* of = F.STF + (size_t)item * HD * HD; float* ob = F.STB + (size_t)item * HD * HD;
#pragma unroll
        for (int t = 0; t < 2; ++t)
#pragma unroll
            for (int reg = 0; reg < 16; ++reg) { const int e = 32 * et + (reg & 3) + 8 * (reg >> 2) + 4 * hh, d = 32 * (dt0 + t) + r; of[e * HD + d] = accf[t][reg]; ob[e * HD + d] = accb[t][reg]; }
        __syncthreads();
    }
}
__device__ __forceinline__ void p4_r3_mfma(Frame& F) {
    constexpr int P = 264;
    LAS unsigned char* VT = F.lds + RING_OFF; LAS float* XS = (LAS float*)(F.lds + RING_OFF + 128 * P);
    const int w = F.wave, qt = w & 3, eh = w >> 2;
    const float scale = 0.08838834764831845f, L2E = 1.4426950408889634f;
    for (int item = F.vcu; item < BATCH * NH * NCH; item += F.G) {
        int tid = F.tid; asm volatile("" : "+v"(tid)); const int lane = tid & 63, r = lane & 31, hh = lane >> 5;
        const int bh = item >> 5, c = item & 31, b = bh >> 3, h = bh & 7; const size_t row0 = (size_t)b * SEQ + c * CH;
        const bf16* Qg = HP(COL_QR, h) + row0 * HD; const bf16* Kg = HP(COL_KR, h) + row0 * HD;
        const bf16* Vg = HP(COL_VR, h) + row0 * HD; const bf16* Gg = HP(COL_GR, h) + row0 * HD;
        const float lgf2 = -__expf(F.decf[h]) * L2E, lgb2 = -__expf(F.decb[h]) * L2E;
        {
            const int jg = tid & 31, dc = tid >> 5; v4u vr[4];
#pragma unroll
            for (int q = 0; q < 4; ++q) vr[q] = *(const GAS v4u*)(Vg + (size_t)(4 * jg + q) * HD + 8 * dc);
#pragma unroll
            for (int i = 0; i < 8; ++i) { u32x2 vv; vv.x = elt16(vr[0], i) | (elt16(vr[1], i) << 16); vv.y = elt16(vr[2], i) | (elt16(vr[3], i) << 16); *(LAS u32x2*)(VT + (8 * dc + i) * P + 8 * jg) = vv; }
        }
        const int iq = 32 * qt + r;
        bf16x8 qf[8];
#pragma unroll
        for (int s = 0; s < 8; ++s) qf[s] = *(const GAS bf16x8*)(Qg + (size_t)iq * HD + 64 * hh + 8 * s);
        f32x16 st[4];
#pragma unroll
        for (int kt = 0; kt < 4; ++kt) { st[kt] = zero16();
#pragma unroll
            for (int s = 0; s < 8; ++s) { const bf16x8 kf = *(const GAS bf16x8*)(Kg + (size_t)(32 * kt + r) * HD + 64 * hh + 8 * s); st[kt] = MFMA32(kf, qf[s], st[kt]); }
            __builtin_amdgcn_sched_barrier(0); }
        bf16x8 pf[4][2];
#pragma unroll
        for (int kt = 0; kt < 4; ++kt) {
#pragma unroll
            for (int reg = 0; reg < 16; ++reg) { const int j = 32 * kt + (reg & 3) + 8 * (reg >> 2) + 4 * hh, dj = iq - j;
                const float dec = __builtin_amdgcn_exp2f(dj >= 0 ? lgf2 * (float)dj : lgb2 * (float)(-dj)); st[kt][reg] *= scale * dec; }
            pf[kt][0] = pack8(st[kt], 0); pf[kt][1] = pack8(st[kt], 1); }
        const float ff = __builtin_amdgcn_exp2f(lgf2 * (float)(iq + 1)) * scale, fb = __builtin_amdgcn_exp2f(lgb2 * (float)(CH - iq)) * scale;
        f32x16 acc[2];
#pragma unroll
        for (int t = 0; t < 2; ++t) { const int e = 32 * (2 * eh + t) + r; f32x16 a1 = zero16(), a2 = zero16();
            const bf16* s1 = sbf_row(F.PROJ, 2 * item, e) + 64 * hh; const bf16* s2 = sbf_row(F.PROJ, 2 * item + 1, e) + 64 * hh;
#pragma unroll
            for (int s = 0; s < 8; ++s) { a1 = MFMA32(*(const GAS bf16x8*)(s1 + 8 * s), qf[s], a1); a2 = MFMA32(*(const GAS bf16x8*)(s2 + 8 * s), qf[s], a2); }
#pragma unroll
            for (int reg = 0; reg < 16; ++reg) acc[t][reg] = ff * a1[reg] + fb * a2[reg];
            __builtin_amdgcn_sched_barrier(0); }
        __syncthreads();
#pragma unroll
        for (int t = 0; t < 2; ++t) { const LAS unsigned char* vrow = VT + (32 * (2 * eh + t) + r) * P + 8 * hh;
#pragma unroll
            for (int kt = 0; kt < 4; ++kt)
#pragma unroll
                for (int sp = 0; sp < 2; ++sp) { const u32x2 lo = *(const LAS u32x2*)(vrow + 2 * (32 * kt + 16 * sp)), hi = *(const LAS u32x2*)(vrow + 2 * (32 * kt + 16 * sp + 8));
                    acc[t] = MFMA32(cat8(lo, hi), pf[kt][sp], acc[t]); } }
        float ssq = 0.f;
#pragma unroll
        for (int t = 0; t < 2; ++t)
#pragma unroll
            for (int reg = 0; reg < 16; ++reg) ssq += acc[t][reg] * acc[t][reg];
        ssq += __shfl_xor(ssq, 32);
        if (hh == 0) XS[w * 32 + r] = ssq;
        __syncthreads();
        const float rms = 1.0f / sqrtf((XS[w * 32 + r] + XS[(w ^ 4) * 32 + r]) * (1.0f / HD) + EPS);
#pragma unroll
        for (int t = 0; t < 2; ++t)
#pragma unroll
            for (int g = 0; g < 4; ++g) { const int e = 32 * (2 * eh + t) + 8 * g + 4 * hh;
                const u32x2 gg = *(const GAS u32x2*)(Gg + (size_t)iq * HD + e); const f32x4 wn = *(const GAS f32x4*)(F.w_retn + h * HD + e);
                const float g0 = bflo(gg.x), g1 = bfhi(gg.x), g2 = bflo(gg.y), g3 = bfhi(gg.y);
                const float o0 = acc[t][4 * g] * rms * wn.x * (g0 / (1.0f + __expf(-g0))), o1 = acc[t][4 * g + 1] * rms * wn.y * (g1 / (1.0f + __expf(-g1)));
                const float o2 = acc[t][4 * g + 2] * rms * wn.z * (g2 / (1.0f + __expf(-g2))), o3 = acc[t][4 * g + 3] * rms * wn.w * (g3 / (1.0f + __expf(-g3)));
                u32x2 o; o.x = cvtpk(o0, o1); o.y = cvtpk(o2, o3); *(GAS u32x2*)(F.MIX + (row0 + iq) * D + DATT + h * HD + e) = o; }
        __syncthreads();
    }
}
__device__ __forceinline__ void p2_attn_mfma(Frame& F) {
    constexpr int PK = 272, PV = 520;
    LAS unsigned char* KI = F.lds + RING_OFF; LAS unsigned char* VT = KI + 256 * PK;
    static_assert(256 * PK + 128 * PV <= RING_BYTES, "attention images fit the ring");
    const int w = F.wave, qt = w & 3, eh = w >> 2;
    const float scale = 0.08838834764831845f, L2E = 1.4426950408889634f;
    const int NU = BATCH * NH * 96;
    for (int n = F.vcu; n < NU; n += F.G) {
        int tid = F.tid; asm volatile("" : "+v"(tid)); const int lane = tid & 63, r = lane & 31, hh = lane >> 5;
        unsigned long long t0 = 0, t1 = 0; T_START(t0);
        int bh, u;
        if (F.G == 256) { const int it = n >> 8; bh = (F.vcu >> 5) + 8 * (it / 3); u = (F.vcu & 31) + 32 * (it % 3); }
        else { bh = n / 96; u = n % 96; }
        const int p = u >> 5, idx = u & 31, sh = 2 * p, dil = 1 << sh, nblk = 32 >> sh, cls = idx / nblk, l0 = 128 * (idx % nblk), L = SEQ >> sh;
        const int b = bh >> 3, h = bh & 7;
        const bf16* Qb = HP(COL_QA, h) + (size_t)(b * SEQ) * HD; const bf16* Kb = HP(COL_KA, h) + (size_t)(b * SEQ) * HD; const bf16* Vb = HP(COL_VA, h) + (size_t)(b * SEQ) * HD;
#pragma unroll
        for (int it = 0; it < 8; ++it) { const int pc = tid + 512 * it, row = pc >> 4, ch = pc & 15, lk = l0 - 64 + row;
            const int lkc = lk < 0 ? 0 : (lk >= L ? L - 1 : lk);
            *(LAS v4u*)(KI + row * PK + 16 * ch) = *(const GAS v4u*)(Kb + (size_t)(lkc * dil + cls) * HD + 8 * ch); }
#pragma unroll
        for (int it = 0; it < 2; ++it) { const int bid = tid + 512 * it, jg = bid & 63, dc = bid >> 6; v4u vr[4];
#pragma unroll
            for (int q = 0; q < 4; ++q) { const int lk = l0 - 64 + 4 * jg + q, lkc = lk < 0 ? 0 : (lk >= L ? L - 1 : lk); vr[q] = *(const GAS v4u*)(Vb + (size_t)(lkc * dil + cls) * HD + 8 * dc); }
#pragma unroll
            for (int i = 0; i < 8; ++i) { u32x2 vv; vv.x = elt16(vr[0], i) | (elt16(vr[1], i) << 16); vv.y = elt16(vr[2], i) | (elt16(vr[3], i) << 16); *(LAS u32x2*)(VT + (8 * dc + i) * PV + 8 * jg) = vv; } }
        const int lq = l0 + 32 * qt + r;
        const size_t qrow = (size_t)(lq * dil + cls);
        bf16x8 qf[8];
#pragma unroll
        for (int s = 0; s < 8; ++s) qf[s] = *(const GAS bf16x8*)(Qb + qrow * HD + 64 * hh + 8 * s);
        __syncthreads();
        if (PROBE_T == 1) T_ADD(F.tA, t0);
        T_START(t1);
        f32x16 st[5];
#pragma unroll
        for (int kt = 0; kt < 5; ++kt) { st[kt] = zero16(); const LAS unsigned char* krow = KI + (32 * qt + 32 * kt + r) * PK + 128 * hh;
#pragma unroll
            for (int s = 0; s < 8; ++s) st[kt] = MFMA32(*(const LAS bf16x8*)(krow + 16 * s), qf[s], st[kt]);
            __builtin_amdgcn_sched_barrier(0); }
        const float slope2 = exp2f(-(float)(h + 1)) * (float)dil * L2E, sc2 = scale * L2E;
        float mx = -INFINITY;
#pragma unroll
        for (int kt = 0; kt < 5; ++kt)
#pragma unroll
            for (int reg = 0; reg < 16; ++reg) { const int jl = 32 * kt + (reg & 3) + 8 * (reg >> 2) + 4 * hh, dist = r + 64 - jl, ad = dist < 0 ? -dist : dist, lk = l0 + 32 * qt - 64 + jl;
                const bool valid = (ad <= 64) && (lk >= 0) && (lk < L);
                const float s2 = valid ? st[kt][reg] * sc2 - slope2 * (float)ad : -INFINITY; st[kt][reg] = s2; mx = fmaxf(mx, s2); }
        mx = fmaxf(mx, __shfl_xor(mx, 32));
        if (PROBE_T == 3) { T_ADD(F.tA, t1); T_START(t1); }
        float l = 0.f;
#pragma unroll
        for (int kt = 0; kt < 5; ++kt)
#pragma unroll
            for (int reg = 0; reg < 16; ++reg) { const float e = __builtin_amdgcn_exp2f(st[kt][reg] - mx); st[kt][reg] = e; l += e; }
        l += __shfl_xor(l, 32);
        f32x16 acc[2]; acc[0] = zero16(); acc[1] = zero16();
#pragma unroll
        for (int kt = 0; kt < 5; ++kt)
#pragma unroll
            for (int sp = 0; sp < 2; ++sp) { const bf16x8 pfr = pack8(st[kt], sp);
#pragma unroll
                for (int t = 0; t < 2; ++t) { const LAS unsigned char* vrow = VT + (32 * (2 * eh + t) + r) * PV + 2 * (32 * qt + 32 * kt + 16 * sp + 4 * hh);
                    const u32x2 lo = *(const LAS u32x2*)(vrow), hi = *(const LAS u32x2*)(vrow + 16);
                    acc[t] = MFMA32(cat8(lo, hi), pfr, acc[t]); }
                __builtin_amdgcn_sched_barrier(0); }
        const float il = 1.0f / l; const size_t orow = (size_t)b * SEQ + qrow;
        bf16* ob = (p == 0) ? (F.MIX + orow * D + h * HD) : (F.XN + (size_t)(p - 1) * M * DATT + orow * DATT + h * HD);
#pragma unroll
        for (int t = 0; t < 2; ++t)
#pragma unroll
            for (int g = 0; g < 4; ++g) { const int e = 32 * (2 * eh + t) + 8 * g + 4 * hh; u32x2 o; o.x = cvtpk(acc[t][4 * g] * il, acc[t][4 * g + 1] * il); o.y = cvtpk(acc[t][4 * g + 2] * il, acc[t][4 * g + 3] * il); *(GAS u32x2*)(ob + e) = o; }
        if (eh == 0 && hh == 0) F.LSE[(size_t)p * M * NH + orow * NH + h] = (mx + __log2f(l)) * 0.6931471805599453f;
        __syncthreads();
        if (PROBE_T == 1) T_ADD(F.tB, t0);
        if (PROBE_T == 3) T_ADD(F.tB, t1);
    }
}
__device__ __forceinline__ void p3_merge(Frame& F) {
    const int gt = F.vcu * (NWAVES * 64) + F.tid, NT = F.G * NWAVES * 64;
    for (int idx = gt; idx < M * (DATT / 8); idx += NT) { const int row = idx >> 7, c8 = idx & 127, h = c8 >> 4;
        const float l1 = F.LSE[(size_t)row * NH + h], l4 = F.LSE[(size_t)M * NH + (size_t)row * NH + h], l16 = F.LSE[(size_t)2 * M * NH + (size_t)row * NH + h];
        const float mx = fmaxf(l1, fmaxf(l4, l16)); float w1 = __expf(l1 - mx), w4 = __expf(l4 - mx), w16 = __expf(l16 - mx); const float inv = 1.0f / (w1 + w4 + w16); w1 *= inv; w4 *= inv; w16 *= inv;
        GAS v4u* pm = (GAS v4u*)(F.MIX + (size_t)row * D + 8 * c8);
        const v4u a = *pm, bq = *(const GAS v4u*)(F.XN + (size_t)row * DATT + 8 * c8), cq = *(const GAS v4u*)(F.XN + (size_t)M * DATT + (size_t)row * DATT + 8 * c8);
        v4u o;
#pragma unroll
        for (int k = 0; k < 4; ++k) o[k] = cvtpk(w1 * bflo(a[k]) + w4 * bflo(bq[k]) + w16 * bflo(cq[k]), w1 * bfhi(a[k]) + w4 * bfhi(bq[k]) + w16 * bfhi(cq[k]));
        *pm = o; }
}
typedef short v4i16_t __attribute__((ext_vector_type(4)));
__device__ __forceinline__ unsigned swz16(unsigned row) { return ((row & 3u) << 2) | ((row >> 2) & 3u); }
struct AttnUnit { int b, h, p, dil, cls, l0, L; const bf16 *Qb, *Kb, *Vb; };
__device__ __forceinline__ AttnUnit attn_unit(const Frame& F, int n) {
    int bh, u;
    if (F.G == 256) { const int it = n >> 8; bh = (F.vcu >> 5) + 8 * (it / 3); u = (F.vcu & 31) + 32 * (it % 3); }
    else { bh = n / 96; u = n % 96; }
    AttnUnit U; U.p = u >> 5; const int idx = u & 31, sh = 2 * U.p, nblk = 32 >> sh; U.dil = 1 << sh; U.cls = idx / nblk; U.l0 = 128 * (idx % nblk); U.L = SEQ >> sh; U.b = bh >> 3; U.h = bh & 7;
    U.Qb = HP(COL_QA, U.h) + (size_t)(U.b * SEQ) * HD; U.Kb = HP(COL_KA, U.h) + (size_t)(U.b * SEQ) * HD; U.Vb = HP(COL_VA, U.h) + (size_t)(U.b * SEQ) * HD;
    return U;
}
__device__ __forceinline__ void attn_dma(LAS unsigned char* img, const bf16* Xb, const AttnUnit& U, int w, int lane) {
#pragma unroll
    for (int i = 0; i < 8; ++i) { const int pc = 8 * w + i, row = 4 * pc + (lane >> 4), ch = (lane & 15) ^ (int)swz16((unsigned)row);
        int lk = U.l0 - 64 + row; lk = lk < 0 ? 0 : (lk >= U.L ? U.L - 1 : lk);
        __builtin_amdgcn_global_load_lds((const unsigned*)(Xb + (size_t)(lk * U.dil + U.cls) * HD + 8 * ch), (LAS unsigned*)(img + pc * 1024), 16, 0, 0); }
}
__device__ __forceinline__ void p2_attn_dma(Frame& F) {
    LAS unsigned char* KI = F.lds + RING_OFF; LAS unsigned char* VI = KI + 65536;
    const int w = F.wave, qt = w & 3, eh = w >> 2;
    const float scale = 0.08838834764831845f, L2E = 1.4426950408889634f;
    const int NU = BATCH * NH * 96;
    int n = F.vcu; if (n >= NU) return;
    AttnUnit U = attn_unit(F, n);
    bf16x8 qf[8];
    { int tid = F.tid; asm volatile("" : "+v"(tid)); const int lane = tid & 63, r = lane & 31, hh = lane >> 5;
      attn_dma(KI, U.Kb, U, w, lane);
      const size_t qrow = (size_t)((U.l0 + 32 * qt + r) * U.dil + U.cls);
#pragma unroll
      for (int s = 0; s < 8; ++s) qf[s] = *(const GAS bf16x8*)(U.Qb + qrow * HD + 16 * s + 8 * hh); }
    for (;;) {
        int tid = F.tid; asm volatile("" : "+v"(tid)); const int lane = tid & 63, r = lane & 31, hh = lane >> 5;
        unsigned long long t0 = 0, t1 = 0; T_START(t0);
        __syncthreads();
        if (PROBE_T == 1) T_ADD(F.tA, t0);
        T_START(t1);
        attn_dma(VI, U.Vb, U, w, lane);
        const int lq0 = U.l0 + 32 * qt;
        f32x16 st[5];
        const unsigned swr = swz16((unsigned)r);
#pragma unroll
        for (int kt = 0; kt < 5; ++kt) { st[kt] = zero16(); const int lk0 = lq0 - 64 + 32 * kt;
            if (lk0 >= 0 && lk0 < U.L) { const LAS unsigned char* krow = KI + (32 * (qt + kt) + r) * 256;
#pragma unroll
                for (int s = 0; s < 8; ++s) st[kt] = MFMA32(*(const LAS bf16x8*)(krow + 16 * ((unsigned)(2 * s + hh) ^ swr)), qf[s], st[kt]); }
            __builtin_amdgcn_sched_barrier(0); }
        const float slope2 = exp2f(-(float)(U.h + 1)) * (float)U.dil * L2E, sc2 = scale * L2E, frr = (float)(r - 4 * hh);
        float mx = -INFINITY;
#pragma unroll
        for (int kt = 0; kt < 5; ++kt) { const int lk0 = lq0 - 64 + 32 * kt; const bool tin = (lk0 >= 0 && lk0 < U.L);
#pragma unroll
            for (int reg = 0; reg < 16; ++reg) { const float ad = fabsf(frr + (float)(64 - 32 * kt - ((reg & 3) + 8 * (reg >> 2))));
                float s2 = st[kt][reg] * sc2 - slope2 * ad;
                if (kt == 0 || kt == 4) s2 = (ad <= 64.0f) ? s2 : -INFINITY;
                s2 = tin ? s2 : -INFINITY;
                st[kt][reg] = s2; mx = fmaxf(mx, s2); } }
        mx = fmaxf(mx, __shfl_xor(mx, 32));
        if (PROBE_T == 3) { T_ADD(F.tA, t1); T_START(t1); }
        __syncthreads();
        const int nn = n + F.G; const bool has_next = nn < NU;
        AttnUnit Un = U; if (has_next) { Un = attn_unit(F, nn); attn_dma(KI, Un.Kb, Un, w, lane); }
        float l = 0.f;
#pragma unroll
        for (int kt = 0; kt < 5; ++kt)
#pragma unroll
            for (int reg = 0; reg < 16; ++reg) { const float e = __builtin_amdgcn_exp2f(st[kt][reg] - mx); st[kt][reg] = e; l += e; }
        l += __shfl_xor(l, 32);
        f32x16 acc[2]; acc[0] = zero16(); acc[1] = zero16();
        const int q4 = (lane & 15) >> 2, pp = lane & 3, blk = (lane >> 4) & 1;
        unsigned voff[2][2][2];
#pragma unroll
        for (int t2 = 0; t2 < 2; ++t2) { const unsigned rl = (unsigned)(4 * hh + 8 * t2 + q4), sw = swz16(rl);
#pragma unroll
            for (int t = 0; t < 2; ++t) { const unsigned chunk = (unsigned)(4 * (2 * eh + t) + 2 * blk + (pp >> 1)); voff[t2][t][0] = 256u * rl + 16u * (chunk ^ sw) + 8u * (unsigned)(pp & 1); voff[t2][t][1] = 0; } }
#pragma unroll
        for (int kt = 0; kt < 5; ++kt) { const int lk0 = lq0 - 64 + 32 * kt;
            if (lk0 >= 0 && lk0 < U.L) {
#pragma unroll
                for (int sp = 0; sp < 2; ++sp) { const bf16x8 pfr = pack8(st[kt], sp); const LAS unsigned char* vb = VI + (32 * (qt + kt) + 16 * sp) * 256;
#pragma unroll
                    for (int t = 0; t < 2; ++t) {
                        const v4i16_t lo = __builtin_amdgcn_ds_read_tr16_b64_v4i16((LAS v4i16_t*)(vb + voff[0][t][0])), hi = __builtin_amdgcn_ds_read_tr16_b64_v4i16((LAS v4i16_t*)(vb + voff[1][t][0]));
                        const bf16x8 vf = __builtin_shufflevector(lo, hi, 0, 1, 2, 3, 4, 5, 6, 7);
                        acc[t] = MFMA32(vf, pfr, acc[t]); } } }
            __builtin_amdgcn_sched_barrier(0); }
        const float il = 1.0f / l; const size_t qrow = (size_t)((lq0 + r) * U.dil + U.cls), orow = (size_t)U.b * SEQ + qrow;
        bf16* ob = (U.p == 0) ? (F.MIX + orow * D + U.h * HD) : (F.XN + (size_t)(U.p - 1) * M * DATT + orow * DATT + U.h * HD);
#pragma unroll
        for (int t = 0; t < 2; ++t)
#pragma unroll
            for (int g = 0; g < 4; ++g) { const int e = 32 * (2 * eh + t) + 8 * g + 4 * hh; u32x2 o; o.x = cvtpk(acc[t][4 * g] * il, acc[t][4 * g + 1] * il); o.y = cvtpk(acc[t][4 * g + 2] * il, acc[t][4 * g + 3] * il); *(GAS u32x2*)(ob + e) = o; }
        if (eh == 0 && hh == 0) F.LSE[(size_t)U.p * M * NH + orow * NH + U.h] = (mx + __log2f(l)) * 0.6931471805599453f;
        if (PROBE_T == 1) T_ADD(F.tB, t0);
        if (PROBE_T == 3) T_ADD(F.tB, t1);
        if (!has_next) break;
        U = Un; n = nn;
        { const size_t qr2 = (size_t)((U.l0 + 32 * qt + r) * U.dil + U.cls);
#pragma unroll
          for (int s = 0; s < 8; ++s) qf[s] = *(const GAS bf16x8*)(U.Qb + qr2 * HD + 16 * s + 8 * hh); }
    }
    __syncthreads();
}
__device__ __forceinline__ void dma_rows128(LAS unsigned char* img, const bf16* src, int w, int lane) {
#pragma unroll
    for (int i = 0; i < 4; ++i) { const int pc = 4 * w + i, row = 4 * pc + (lane >> 4), ch = (lane & 15) ^ (int)swz16((unsigned)row);
        __builtin_amdgcn_global_load_lds((const unsigned*)(src + (size_t)row * HD + 8 * ch), (LAS unsigned*)(img + pc * 1024), 16, 0, 0); }
}
__device__ __forceinline__ unsigned tr_nat(int lane, int c, int ks, int t2) { const unsigned h = lane >> 5, blk = (lane >> 4) & 1, q = (lane & 15) >> 2, p = lane & 3, row = 16 * ks + 8 * h + 4 * t2 + q;
    return 256u * row + 16u * ((unsigned)(4 * c + 2 * blk + (p >> 1)) ^ swz16(row)) + 8u * (p & 1); }
__device__ __forceinline__ v4i16_t trd(const LAS unsigned char* p) { return __builtin_amdgcn_ds_read_tr16_b64_v4i16((LAS v4i16_t*)p); }
__device__ __forceinline__ void p2_r1_dma(Frame& F) {
    const int w = F.wave, dt = w & 3, et0 = 2 * (w >> 2);
    const float L2E = 1.4426950408889634f;
    const int NI = BATCH * NH * NCH;
    int item = F.vcu; if (item >= NI) return;
    bf16* STFh = (bf16*)F.STF; bf16* STBh = STFh + (size_t)NI * HD * HD;
    { int tid = F.tid; asm volatile("" : "+v"(tid)); const int lane = tid & 63;
      const int bh = item >> 5, c = item & 31, b = bh >> 3, h = bh & 7; const size_t row0 = (size_t)b * SEQ + c * CH;
      dma_rows128(F.lds + RING_OFF, HP(COL_KR, h) + row0 * HD, w, lane); dma_rows128(F.lds + RING_OFF + 32768, HP(COL_VR, h) + row0 * HD, w, lane); }
    for (int k = 0;; ++k) {
        int tid = F.tid; asm volatile("" : "+v"(tid)); const int lane = tid & 63, r = lane & 31, hh = lane >> 5;
        const int bh = item >> 5, h = bh & 7;
        __syncthreads();
        const int nitem = item + F.G; const bool has_next = nitem < NI;
        LAS unsigned char* KI = F.lds + RING_OFF + (k & 1) * 65536; LAS unsigned char* VI = KI + 32768;
        if (has_next) { const int bh2 = nitem >> 5, c2 = nitem & 31, b2 = bh2 >> 3, h2 = bh2 & 7; const size_t row2 = (size_t)b2 * SEQ + c2 * CH; LAS unsigned char* NB = F.lds + RING_OFF + ((k + 1) & 1) * 65536;
            dma_rows128(NB, HP(COL_KR, h2) + row2 * HD, w, lane); dma_rows128(NB + 32768, HP(COL_VR, h2) + row2 * HD, w, lane); }
        const float lgf2 = -__expf(F.decf[h]) * L2E, lgb2 = -__expf(F.decb[h]) * L2E;
        float gfi[8], gbi[8];
#pragma unroll
        for (int q = 0; q < 8; ++q) { gfi[q] = __builtin_amdgcn_exp2f(-lgf2 * (float)q); gbi[q] = __builtin_amdgcn_exp2f(lgb2 * (float)q); }
        f32x16 accf[2], accb[2]; accf[0] = zero16(); accf[1] = zero16(); accb[0] = zero16(); accb[1] = zero16();
#pragma unroll
        for (int s = 0; s < 8; ++s) {
            const v4i16_t klo = trd(KI + tr_nat(lane, dt, s, 0)), khi = trd(KI + tr_nat(lane, dt, s, 1));
            const bf16x8 kf = __builtin_shufflevector(klo, khi, 0, 1, 2, 3, 4, 5, 6, 7);
            const float bfw = __builtin_amdgcn_exp2f(lgf2 * (float)(CH - 1 - 16 * s - 8 * hh)), bbw = __builtin_amdgcn_exp2f(lgb2 * (float)(16 * s + 8 * hh));
#pragma unroll
            for (int t = 0; t < 2; ++t) { const v4i16_t vlo = trd(VI + tr_nat(lane, et0 + t, s, 0)), vhi = trd(VI + tr_nat(lane, et0 + t, s, 1));
                float v[8];
#pragma unroll
                for (int q = 0; q < 4; ++q) { v[q] = __builtin_bit_cast(float, (unsigned)(unsigned short)vlo[q] << 16); v[4 + q] = __builtin_bit_cast(float, (unsigned)(unsigned short)vhi[q] << 16); }
                v4u pf_, pb_;
#pragma unroll
                for (int q = 0; q < 4; ++q) { pf_[q] = cvtpk(v[2 * q] * (bfw * gfi[2 * q]), v[2 * q + 1] * (bfw * gfi[2 * q + 1])); pb_[q] = cvtpk(v[2 * q] * (bbw * gbi[2 * q]), v[2 * q + 1] * (bbw * gbi[2 * q + 1])); }
                accf[t] = MFMA32(kf, __builtin_bit_cast(bf16x8, pf_), accf[t]); accb[t] = MFMA32(kf, __builtin_bit_cast(bf16x8, pb_), accb[t]); }
        }
        bf16* of = STFh + (size_t)item * HD * HD; bf16* ob = STBh + (size_t)item * HD * HD;
#pragma unroll
        for (int t = 0; t < 2; ++t) { const int e = 32 * (et0 + t) + r;
#pragma unroll
            for (int g = 0; g < 4; ++g) { const int d0 = 32 * dt + 8 * g + 4 * hh;
                u32x2 o1; o1.x = cvtpk(accf[t][4 * g], accf[t][4 * g + 1]); o1.y = cvtpk(accf[t][4 * g + 2], accf[t][4 * g + 3]); *(GAS u32x2*)(of + e * HD + d0) = o1;
                u32x2 o2; o2.x = cvtpk(accb[t][4 * g], accb[t][4 * g + 1]); o2.y = cvtpk(accb[t][4 * g + 2], accb[t][4 * g + 3]); *(GAS u32x2*)(ob + e * HD + d0) = o2; } }
        if (!has_next) break;
        item = nitem;
    }
    __syncthreads();
}
__device__ __forceinline__ void p3_scan_bf16(Frame& F) {
    const int gt = F.vcu * (NWAVES * 64) + F.tid, NT = F.G * NWAVES * 64;
    const bf16* STFh = (const bf16*)F.STF; const bf16* STBh = STFh + (size_t)BATCH * NH * NCH * HD * HD;
    for (int idx = gt; idx < 2 * BATCH * NH * 2048; idx += NT) {
        const int dir = idx / (BATCH * NH * 2048), rem = idx % (BATCH * NH * 2048), bh = rem >> 11, q = rem & 2047, h = bh & 7;
        const float g = __expf(-__expf(dir ? F.decb[h] : F.decf[h]) * (float)CH);
        const GAS v4u* base = (const GAS v4u*)(dir ? STBh : STFh) + (size_t)bh * NCH * 2048 + q;
        float s[8];
#pragma unroll
        for (int i = 0; i < 8; ++i) s[i] = 0.f;
#pragma unroll 8
        for (int cc = 0; cc < NCH; ++cc) { const int c = dir ? NCH - 1 - cc : cc; const v4u t = base[(size_t)c * 2048];
            v4u o; o.x = cvtpk(s[0], s[1]); o.y = cvtpk(s[2], s[3]); o.z = cvtpk(s[4], s[5]); o.w = cvtpk(s[6], s[7]);
            *(GAS v4u*)(sbf_row(F.PROJ, 2 * (bh * NCH + c) + dir, q >> 4) + 8 * (q & 15)) = o;
#pragma unroll
            for (int i = 0; i < 4; ++i) { s[2 * i] = s[2 * i] * g + bflo(t[i]); s[2 * i + 1] = s[2 * i + 1] * g + bfhi(t[i]); } }
    }
}
__device__ __forceinline__ void p4_r3_dma(Frame& F) {
    LAS unsigned char* KI = F.lds + RING_OFF; LAS unsigned char* VI = KI + 32768; LAS unsigned char* SFI = KI + 65536; LAS unsigned char* SBI = KI + 98304; LAS float* XS = (LAS float*)(KI + 131072);
    const int w = F.wave, qt = w & 3, eh = w >> 2;
    const float scale = 0.08838834764831845f, L2E = 1.4426950408889634f;
    const int NI = BATCH * NH * NCH;
    int item = F.vcu; if (item >= NI) return;
    bf16x8 qf[8];
    { int tid = F.tid; asm volatile("" : "+v"(tid)); const int lane = tid & 63, r = lane & 31, hh = lane >> 5;
      const int bh = item >> 5, c = item & 31, b = bh >> 3, h = bh & 7; const size_t row0 = (size_t)b * SEQ + c * CH;
      dma_rows128(KI, HP(COL_KR, h) + row0 * HD, w, lane); dma_rows128(SFI, sbf_row(F.PROJ, 2 * item, 0), w, lane); dma_rows128(SBI, sbf_row(F.PROJ, 2 * item + 1, 0), w, lane);
      const bf16* Qg = HP(COL_QR, h) + row0 * HD;
#pragma unroll
      for (int s = 0; s < 8; ++s) qf[s] = *(const GAS bf16x8*)(Qg + (size_t)(32 * qt + r) * HD + 16 * s + 8 * hh); }
    for (;;) {
        int tid = F.tid; asm volatile("" : "+v"(tid)); const int lane = tid & 63, r = lane & 31, hh = lane >> 5;
        const int bh = item >> 5, c = item & 31, b = bh >> 3, h = bh & 7; const size_t row0 = (size_t)b * SEQ + c * CH;
        const bf16* Gg = HP(COL_GR, h) + row0 * HD;
        const float lgf2 = -__expf(F.decf[h]) * L2E, lgb2 = -__expf(F.decb[h]) * L2E;
        const int iq = 32 * qt + r;
        __syncthreads();
        dma_rows128(VI, HP(COL_VR, h) + row0 * HD, w, lane);
        u32x2 gg[2][4];
        if (tid < 32) ((LAS f32x4*)(XS + 256))[tid] = *(const GAS f32x4*)(F.w_retn + h * HD + 4 * tid);
#pragma unroll
        for (int t = 0; t < 2; ++t)
#pragma unroll
            for (int g = 0; g < 4; ++g) gg[t][g] = *(const GAS u32x2*)(Gg + (size_t)iq * HD + 32 * (2 * eh + t) + 8 * g + 4 * hh);
        const unsigned swr = swz16((unsigned)r);
        f32x16 st[4];
#pragma unroll
        for (int kt = 0; kt < 4; ++kt) { st[kt] = zero16(); const LAS unsigned char* krow = KI + (32 * kt + r) * 256;
#pragma unroll
            for (int s = 0; s < 8; ++s) st[kt] = MFMA32(*(const LAS bf16x8*)(krow + 16 * ((unsigned)(2 * s + hh) ^ swr)), qf[s], st[kt]);
            __builtin_amdgcn_sched_barrier(0); }
        bf16x8 pf[4][2];
#pragma unroll
        for (int kt = 0; kt < 4; ++kt) {
#pragma unroll
            for (int reg = 0; reg < 16; ++reg) { const int j = 32 * kt + (reg & 3) + 8 * (reg >> 2) + 4 * hh, dj = iq - j;
                const float dec = __builtin_amdgcn_exp2f(dj >= 0 ? lgf2 * (float)dj : lgb2 * (float)(-dj)); st[kt][reg] *= scale * dec; }
            pf[kt][0] = pack8(st[kt], 0); pf[kt][1] = pack8(st[kt], 1); }
        const float ff = __builtin_amdgcn_exp2f(lgf2 * (float)(iq + 1)) * scale, fb = __builtin_amdgcn_exp2f(lgb2 * (float)(CH - iq)) * scale;
        f32x16 acc[2];
#pragma unroll
        for (int t = 0; t < 2; ++t) { f32x16 a1 = zero16(), a2 = zero16(); const int erow = (32 * (2 * eh + t) + r) * 256;
#pragma unroll
            for (int s = 0; s < 8; ++s) { const unsigned co = 16 * ((unsigned)(2 * s + hh) ^ swr);
                a1 = MFMA32(*(const LAS bf16x8*)(SFI + erow + co), qf[s], a1); a2 = MFMA32(*(const LAS bf16x8*)(SBI + erow + co), qf[s], a2); }
#pragma unroll
            for (int reg = 0; reg < 16; ++reg) acc[t][reg] = ff * a1[reg] + fb * a2[reg];
            __builtin_amdgcn_sched_barrier(0); }
        __syncthreads();
        const int nitem = item + F.G; const bool has_next = nitem < NI;
        if (has_next) { const int bh2 = nitem >> 5, c2 = nitem & 31, b2 = bh2 >> 3, h2 = bh2 & 7; const size_t row2 = (size_t)b2 * SEQ + c2 * CH;
            dma_rows128(KI, HP(COL_KR, h2) + row2 * HD, w, lane); dma_rows128(SFI, sbf_row(F.PROJ, 2 * nitem, 0), w, lane); dma_rows128(SBI, sbf_row(F.PROJ, 2 * nitem + 1, 0), w, lane); }
        { const int q4 = (lane & 15) >> 2, pp = lane & 3, blk = (lane >> 4) & 1; unsigned voff[2][2];
#pragma unroll
          for (int t2 = 0; t2 < 2; ++t2) { const unsigned rl = (unsigned)(4 * hh + 8 * t2 + q4), sw = swz16(rl);
#pragma unroll
              for (int t = 0; t < 2; ++t) voff[t2][t] = 256u * rl + 16u * ((unsigned)(4 * (2 * eh + t) + 2 * blk + (pp >> 1)) ^ sw) + 8u * (unsigned)(pp & 1); }
#pragma unroll
          for (int kt = 0; kt < 4; ++kt) {
#pragma unroll
              for (int sp = 0; sp < 2; ++sp) { const LAS unsigned char* vb = VI + (32 * kt + 16 * sp) * 256;
#pragma unroll
                  for (int t = 0; t < 2; ++t) { const v4i16_t lo = trd(vb + voff[0][t]), hi = trd(vb + voff[1][t]);
                      acc[t] = MFMA32(__builtin_shufflevector(lo, hi, 0, 1, 2, 3, 4, 5, 6, 7), pf[kt][sp], acc[t]); } }
              __builtin_amdgcn_sched_barrier(0); } }
        float ssq = 0.f;
#pragma unroll
        for (int t = 0; t < 2; ++t)
#pragma unroll
            for (int reg = 0; reg < 16; ++reg) ssq += acc[t][reg] * acc[t][reg];
        ssq += __shfl_xor(ssq, 32);
        if (hh == 0) XS[w * 32 + r] = ssq;
        asm volatile("s_waitcnt lgkmcnt(0)" ::: "memory"); __builtin_amdgcn_s_barrier(); asm volatile("" ::: "memory");
        const float rms = 1.0f / sqrtf((XS[w * 32 + r] + XS[(w ^ 4) * 32 + r]) * (1.0f / HD) + EPS);
#pragma unroll
        for (int t = 0; t < 2; ++t)
#pragma unroll
            for (int g = 0; g < 4; ++g) { const int e = 32 * (2 * eh + t) + 8 * g + 4 * hh; const f32x4 wn = *(const LAS f32x4*)(XS + 256 + e);
                const float g0 = bflo(gg[t][g].x), g1 = bfhi(gg[t][g].x), g2 = bflo(gg[t][g].y), g3 = bfhi(gg[t][g].y);
                const float o0 = acc[t][4 * g] * rms * wn.x * (g0 / (1.0f + __expf(-g0))), o1 = acc[t][4 * g + 1] * rms * wn.y * (g1 / (1.0f + __expf(-g1)));
                const float o2 = acc[t][4 * g + 2] * rms * wn.z * (g2 / (1.0f + __expf(-g2))), o3 = acc[t][4 * g + 3] * rms * wn.w * (g3 / (1.0f + __expf(-g3)));
                u32x2 o; o.x = cvtpk(o0, o1); o.y = cvtpk(o2, o3); *(GAS u32x2*)(F.MIX + (row0 + iq) * D + DATT + h * HD + e) = o; }
        if (!has_next) break;
        item = nitem;
        { const int bh2 = item >> 5, c2 = item & 31, b2 = bh2 >> 3, h2 = bh2 & 7; const bf16* Qg = HP(COL_QR, h2) + ((size_t)b2 * SEQ + c2 * CH) * HD;
#pragma unroll
          for (int s = 0; s < 8; ++s) qf[s] = *(const GAS bf16x8*)(Qg + (size_t)(32 * qt + r) * HD + 16 * s + 8 * hh); }
    }
    __syncthreads();
}
struct Args { const float* in[12]; float* out; unsigned char* ws; int ph_lo, ph_hi, li, pad; };
__global__ void __launch_bounds__(NWAVES * 64, 2) mk_fwd(Args args) {
    extern __shared__ __attribute__((aligned(16))) unsigned char lds[];
    Frame F;
    F.lds = (LAS unsigned char*)lds;
    F.MISC = (volatile LAS unsigned*)(F.lds + MISC_OFF);
    F.tid = threadIdx.x; F.lane = F.tid & 63; F.wave = __builtin_amdgcn_readfirstlane(F.tid >> 6);
    F.G = gridDim.x; { const int bx = blockIdx.x; F.vcu = (F.G % 8 == 0) ? (bx % 8) * (F.G / 8) + bx / 8 : bx; }
    unsigned char* ws = args.ws;
    F.ctl = (gu32*)(ws + WS_CTL);
    F.x = args.in[0]; F.w_mix = args.in[1]; F.w_in = args.in[2]; F.decf = args.in[3]; F.decb = args.in[4]; F.w_retn = args.in[5]; F.w_out = args.in[6];
    F.w_ffn = args.in[7]; F.w_gate = args.in[8]; F.w_up = args.in[9]; F.w_down = args.in[10]; F.w_fin = args.in[11]; F.out = args.out;
    F.Win_t = (bf16*)(ws + WS_WIN); F.Wout_t = (bf16*)(ws + WS_WOUT); F.Wgu_t = (bf16*)(ws + WS_WGU); F.Wdn_t = (bf16*)(ws + WS_WDN);
    F.XN = (bf16*)(ws + WS_XN); F.PROJ = (bf16*)(ws + WS_PROJ); F.MIX = (bf16*)(ws + WS_MIX); F.ACT = (bf16*)(ws + WS_PROJ);
    F.STF = args.out; F.STB = args.out + ST_HALF; F.SS1 = (float*)(ws + WS_CTL + CTL_SS1); F.LSE = (float*)(ws + WS_LSE);
    F.tA = 0; F.tB = 0;
    for (int u = F.tid; u < (LDS_BYTES - LDSCTL_OFF) / 4; u += NWAVES * 64) ((LAS unsigned*)(F.lds + LDSCTL_OFF))[u] = 0u;
    __syncthreads();
    XcdBarrier bar; bar.bar = (unsigned*)(F.ctl + CW_BAR); bar.x = 0; bar.st = nullptr;
    if (N_LAUNCHES != PER_PHASE) bar = xcd_barrier_post((unsigned*)(F.ctl + CW_BAR), F.MISC + 8);
#define GRID_BAR(seam) do { if (N_LAUNCHES == PER_PHASE) { if (F.tid == 0) __hip_atomic_store(F.ctl + CW_TMO, 0xBADBA0u | (unsigned)(seam), RLX_AGENT); } else { xcd_barrier(bar); } } while (0)
    const int lo = args.ph_lo, hi = args.ph_hi;
#define IN(k) (lo <= (k) && (k) < hi)
#define BOTH(k) (IN(k) && IN((k) + 1))

#define REP(k) (((PROBE_REPEAT) >> (k)) & 1)
    if (IN(0)) { p0_prologue(F); if (REP(0)) p0_prologue(F); if (BOTH(0)) GRID_BAR(0); }
    if (N_LAUNCHES != PER_PHASE && lo == 0 && hi > 1) {
        unsigned pre = 0;
        for (unsigned j = 0; j < bar.x; ++j) pre += xb_ld(&bar.bar[XB_XCNT(j)]);
        F.vcu = (int)(pre + F.MISC[10]);
    }
    if (IN(1)) {
        pg8::Gemm g{F.XN, F.Win_t, M, DIN, D}; pg8::StaticOrder S; S.init(M, DIN, F.G, (int)blockIdx.x);
        pg8::EpiHeads E{F.PROJ, M};
        for (int rep = 0; rep <= REP(1); ++rep) pg8::gemm_phase<pg8::EpiHeads, pg8::StaticOrder, true, true>(F.lds + RING_OFF, g, S, E);
        if (BOTH(1)) GRID_BAR(1);
    }
    if (IN(2)) {
        for (int rep = 0; rep <= REP(2); ++rep) {
#if ATTN_NAIVE
        p2_attn_naive(F); __syncthreads();
#elif ATTN_V1
        p2_attn_mfma(F);
#else
        p2_attn_dma(F);
#endif
#if R1_NAIVE
        p2_r1_naive(F);
#elif R1_V1
        p2_r1_mfma(F);
#else
        { unsigned long long tR1 = 0; T_START(tR1); p2_r1_dma(F); if (PROBE_T == 2) T_ADD(F.tA, tR1); }
#endif
        }
        if (BOTH(2)) GRID_BAR(2); }
#if R1_NAIVE || R1_V1
#define P3_SCAN p3_scan
#else
#define P3_SCAN p3_scan_bf16
#endif
    if (IN(3)) { P3_SCAN(F); if (REP(3)) P3_SCAN(F);
#if !ATTN_NAIVE
        p3_merge(F);
#endif
        if (BOTH(3)) GRID_BAR(3); }
    if (IN(4)) {
        for (int rep = 0; rep <= REP(4); ++rep) {
#if R3_NAIVE
        p4_r3_naive(F);
#elif R3_V1
        p4_r3_mfma(F);
#else
        { unsigned long long tR3 = 0; T_START(tR3); p4_r3_dma(F); if (PROBE_T == 2) T_ADD(F.tB, tR3); }
#endif
        }
        if (BOTH(4)) GRID_BAR(4); }
    if (IN(5)) {
        pg8::Gemm g{F.MIX, F.Wout_t, M, D, D}; pg8::StaticOrder S; S.init(M, D, F.G, (int)blockIdx.x);
        pg8::EpiResid E{F.x, F.out, F.XN, F.SS1, D};
        pg8::gemm_phase<pg8::EpiResid, pg8::StaticOrder, true, true>(F.lds + RING_OFF, g, S, E);
        if (REP(5)) { pg8::EpiResid E2{F.x, F.out, F.XN, nullptr, D}; pg8::gemm_phase<pg8::EpiResid, pg8::StaticOrder, true, true>(F.lds + RING_OFF, g, S, E2); }
        if (BOTH(5)) GRID_BAR(5);
    }
    if (IN(6)) {
        pg8::Gemm g{F.XN, F.Wgu_t, M, NGU, D}; pg8::StaticOrder S; S.init(M, NGU, F.G, (int)blockIdx.x);
        pg8::EpiSwiGLU E{F.ACT, DFF, F.SS1, 1.0f / D, EPS};
        for (int rep = 0; rep <= REP(6); ++rep) pg8::gemm_phase<pg8::EpiSwiGLU, pg8::StaticOrder, true, true>(F.lds + RING_OFF, g, S, E);
        if (BOTH(6)) GRID_BAR(6);
    }
    if (IN(7)) {
        pg8::Gemm g{F.ACT, F.Wdn_t, M, D, DFF}; pg8::StaticOrder S; S.init(M, D, F.G, (int)blockIdx.x);
        if (REP(7)) { pg8::EpiNull E0{}; pg8::gemm_phase<pg8::EpiNull, pg8::StaticOrder, true, true>(F.lds + RING_OFF, g, S, E0); }
        pg8::EpiResid E{F.out, F.out, nullptr, nullptr, D};
        pg8::gemm_phase<pg8::EpiResid, pg8::StaticOrder, true, true>(F.lds + RING_OFF, g, S, E);
        if (BOTH(7)) GRID_BAR(7);
    }
    if (IN(8)) { if (REP(8)) p8_final(F, true); p8_final(F, false); }
#if PROBE_T
    if (blockIdx.x == PROBE_BLOCK && F.tid == 0) {
        const unsigned long long t0 = RT(), span = (unsigned long long)PROBE_MULT * (PROBE_USE_B ? F.tB : F.tA);
        while (RT() - t0 < span) __builtin_amdgcn_s_sleep(8);
    }
#endif
#undef REP
#undef IN
#undef BOTH
}

extern "C" void kernel_launch(void* const* d_in, const int* in_sizes, int n_in, void* d_out, int out_size, void* d_ws, size_t ws_size, hipStream_t stream) {
    static int grid = 0;
    if (grid == 0) {
        if (n_in != 12 || in_sizes[0] != M * D || out_size != M * D || ws_size < WS_END) { fprintf(stderr, "kernel_launch: shape/workspace mismatch (n_in %d, in0 %d, out %d, ws %zu, need %zu)\n", n_in, n_in > 0 ? in_sizes[0] : -1, out_size, ws_size, (size_t)WS_END); grid = -1; return; }
        int dev = 0, cus = 0, per_cu = 0;
        if (hipGetDevice(&dev) != hipSuccess || hipDeviceGetAttribute(&cus, hipDeviceAttributeMultiprocessorCount, dev) != hipSuccess) { grid = -1; return; }
        if (hipFuncSetAttribute((const void*)mk_fwd, hipFuncAttributeMaxDynamicSharedMemorySize, LDS_BYTES) != hipSuccess) { fprintf(stderr, "kernel_launch: hipFuncSetAttribute failed\n"); grid = -1; return; }
        if (hipOccupancyMaxActiveBlocksPerMultiprocessor(&per_cu, (const void*)mk_fwd, NWAVES * 64, LDS_BYTES) != hipSuccess || per_cu < 1) fprintf(stderr, "kernel_launch: occupancy query reports %d\n", per_cu);
        (void)hipGetLastError();
        grid = cus;
    }
    if (grid < 0) return;
    (void)hipMemsetAsync((char*)d_ws + WS_CTL, 0, CTL_ZERO_BYTES, stream);
    Args a{};
    for (int i = 0; i < 12; ++i) a.in[i] = (const float*)d_in[i];
    a.out = (float*)d_out; a.ws = (unsigned char*)d_ws;
    if (N_LAUNCHES == 1) { a.ph_lo = 0; a.ph_hi = PER_PHASE; a.li = 0; hipLaunchKernelGGL(mk_fwd, dim3(grid), dim3(NWAVES * 64), LDS_BYTES, stream, a); }
    else for (int li = 0; li < PER_PHASE; ++li) { a.ph_lo = li; a.ph_hi = li + 1; a.li = li; hipLaunchKernelGGL(mk_fwd, dim3(grid), dim3(NWAVES * 64), LDS_BYTES, stream, a); }
}
```

```cpp
#include <hip/hip_runtime.h>
#include <cstdio>
#include <cstdint>
namespace pg8 {
#define PG8_LAS __attribute__((address_space(3)))
typedef unsigned short bf16_t;
typedef short bf16x8 __attribute__((ext_vector_type(8)));
typedef float f32x4 __attribute__((ext_vector_type(4)));
typedef unsigned u32x4 __attribute__((ext_vector_type(4)));
constexpr int BM = 256, BK = 64, HALF = 128, HTB = HALF * BK * 2  , STAGE_BYTES = 8 * HTB, NXCD = 8, WGM = 8;

__host__ __device__ __forceinline__ int lds_byte(int r, int c) { const int st = (r >> 4) * 2 + (c >> 5), rr = r & 15, cc = c & 31, ob = rr * 64 + cc * 2; return st * 1024 + (ob ^ (((ob >> 9) & 1) << 5)); }
__host__ __device__ __forceinline__ void stage_rc(int b, int& R, int& C) { const int st = b / 1024, sb = b % 1024, swz = sb ^ (((sb >> 9) & 1) << 5); R = (st >> 1) * 16 + swz / 64; C = (st & 1) * 32 + (swz % 64) / 2; }
__host__ __device__ __forceinline__ int perm32(int rho) { const int n = rho >> 4, i = rho & 15; return 8 * (i >> 2) + 4 * n + (i & 3); }

struct Unit { int pm, pn; };
struct Gemm { const bf16_t* A; const bf16_t* Bt; int M, N, K; };

struct StaticOrder {
    int nM, nN, nwg, G, c;
    __host__ __device__ void init(int M, int N, int G_, int c_) { nM = M / BM; nN = N / BM; nwg = nM * nN; G = G_; c = c_; }
    __host__ __device__ bool next(int i, Unit& u) const {
        const long L = (long)i * G + c; if (L >= nwg) return false;
        int wgid = (int)L; { const int q = nwg / NXCD, r = nwg % NXCD, xcd = wgid % NXCD, off = wgid / NXCD; wgid = (xcd < r ? xcd * (q + 1) : r * (q + 1) + (xcd - r) * q) + off; }
        const int nig = WGM * nN, gid = wgid / nig, fm = gid * WGM, gsz = (nM - fm) < WGM ? (nM - fm) : WGM;
        u.pm = fm + ((wgid % nig) % gsz); u.pn = (wgid % nig) / gsz; return true;
    }
    __device__ __forceinline__ void a_ready(const Unit&) const {}
    __device__ __forceinline__ void done(const Unit&) const {}
};

__device__ __forceinline__ unsigned cvt_pk_bf16(float lo, float hi) { unsigned r; asm volatile("v_cvt_pk_bf16_f32 %0, %1, %2" : "=v"(r) : "v"(lo), "v"(hi)); return r; }
typedef float f32x2 __attribute__((ext_vector_type(2)));
__device__ __forceinline__ f32x2 gelu_pk(f32x2 v) {
    const f32x2 av = __builtin_elementwise_abs(v), d = av * 0.2316418882f + 1.0f;
    f32x2 t; t.x = __builtin_amdgcn_rcpf(d.x); t.y = __builtin_amdgcn_rcpf(d.y);
    f32x2 q = t * 0.5307027145f + (-0.7265760135f); q = q * t + 0.7107068705f; q = q * t + (-0.142248368f); q = q * t + 0.127414796f; q = q * t;
    const f32x2 s = (v * v) * (-0.72134752044f);
    f32x2 e; e.x = __builtin_amdgcn_exp2f(s.x); e.y = __builtin_amdgcn_exp2f(s.y);
    const f32x2 m = v * (q * e), r = v - m;
    f32x2 o; o.x = v.x < 0.f ? m.x : r.x; o.y = v.y < 0.f ? m.y : r.y; return o;
}

template <int ACT  > struct EpiBf16 {
    static constexpr bool PERM = true, AFTER_DRAIN = false; static_assert(ACT == 0 || ACT == 1, "EpiBf16: ACT is 0 (none) or 1 (gelu_pk)");
    bf16_t* O; int ldc; const float* bias; int split_cols; size_t split_stride; float scale0;
    __device__ __forceinline__ void operator()(const f32x4 (&acc)[2][2][4][2], const Unit& u, int wr, int wc, int fr, int fq) const {
        const int row0 = u.pm * BM + wr * 64 + fr; int colt = u.pn * BM; bf16_t* base = O;
        float sc = 1.f; if (split_cols) { const int t = colt / split_cols; base += (size_t)t * split_stride; colt -= t * split_cols; if (t == 0) sc = scale0; }
        const int col0 = colt + wc * 32 + 8 * fq, bcol0 = u.pn * BM + wc * 32 + 8 * fq;
        f32x4 bv[2][2];
#pragma unroll
        for (int bj = 0; bj < 2; ++bj)
#pragma unroll
            for (int n = 0; n < 2; ++n) bv[bj][n] = bias ? *(const f32x4*)(bias + bcol0 + bj * HALF + 4 * n) : (f32x4){0.f, 0.f, 0.f, 0.f};
#pragma unroll
        for (int ai = 0; ai < 2; ++ai)
#pragma unroll
            for (int m = 0; m < 4; ++m) { bf16_t* rowp = base + (size_t)(row0 + ai * HALF + m * 16) * ldc + col0;
#pragma unroll
                for (int bj = 0; bj < 2; ++bj) { f32x4 v0 = acc[ai][bj][m][0] + bv[bj][0], v1 = acc[ai][bj][m][1] + bv[bj][1];
                    if (ACT == 1) { f32x2 a = gelu_pk((f32x2){v0[0], v0[1]}), b = gelu_pk((f32x2){v0[2], v0[3]}), c = gelu_pk((f32x2){v1[0], v1[1]}), d = gelu_pk((f32x2){v1[2], v1[3]});
                        v0 = (f32x4){a.x, a.y, b.x, b.y}; v1 = (f32x4){c.x, c.y, d.x, d.y}; }
                    v0 = v0 * sc; v1 = v1 * sc; u32x4 w; w.x = cvt_pk_bf16(v0[0], v0[1]); w.y = cvt_pk_bf16(v0[2], v0[3]); w.z = cvt_pk_bf16(v1[0], v1[1]); w.w = cvt_pk_bf16(v1[2], v1[3]);
                    *(u32x4*)(rowp + bj * HALF) = w; } }
    }
};
struct EpiResid {
    static constexpr bool PERM = true, AFTER_DRAIN = false;
    const float* base; float* out; bf16_t* hb; float* ss; int ldc;
    __device__ __forceinline__ void operator()(const f32x4 (&acc)[2][2][4][2], const Unit& u, int wr, int wc, int fr, int fq) const {
        const int row0 = u.pm * BM + wr * 64 + fr, col0 = u.pn * BM + wc * 32 + 8 * fq;
#pragma unroll
        for (int ai = 0; ai < 2; ++ai)
#pragma unroll
            for (int m = 0; m < 4; ++m) { const int row = row0 + ai * HALF + m * 16; const size_t off = (size_t)row * ldc + col0; float s = 0.f;
#pragma unroll
                for (int bj = 0; bj < 2; ++bj) {
                    const f32x4 b0 = *(const f32x4*)(base + off + bj * HALF), b1 = *(const f32x4*)(base + off + bj * HALF + 4);
                    const f32x4 v0 = acc[ai][bj][m][0] + b0, v1 = acc[ai][bj][m][1] + b1;
                    *(f32x4*)(out + off + bj * HALF) = v0; *(f32x4*)(out + off + bj * HALF + 4) = v1;
                    if (hb) { u32x4 w; w.x = cvt_pk_bf16(v0[0], v0[1]); w.y = cvt_pk_bf16(v0[2], v0[3]); w.z = cvt_pk_bf16(v1[0], v1[1]); w.w = cvt_pk_bf16(v1[2], v1[3]); *(u32x4*)(hb + off + bj * HALF) = w; }
                    s += (v0[0] * v0[0] + v0[1] * v0[1]) + (v0[2] * v0[2] + v0[3] * v0[3]) + (v1[0] * v1[0] + v1[1] * v1[1]) + (v1[2] * v1[2] + v1[3] * v1[3]);
                }
                if (ss) { s += __shfl_xor(s, 16); s += __shfl_xor(s, 32); if (fq == 0) (void)__hip_atomic_fetch_add(ss + row, s, __ATOMIC_RELAXED, __HIP_MEMORY_SCOPE_AGENT); }
                asm volatile("" ::: "memory"); }
    }
};
struct EpiSwiGLU {
    static constexpr bool PERM = true, AFTER_DRAIN = false;
    bf16_t* O; int ldc; const float* ss; float inv_d, eps;
    __device__ __forceinline__ void operator()(const f32x4 (&acc)[2][2][4][2], const Unit& u, int wr, int wc, int fr, int fq) const {
        const int row0 = u.pm * BM + wr * 64 + fr, col0 = u.pn * HALF + wc * 32 + 8 * fq;
#pragma unroll
        for (int ai = 0; ai < 2; ++ai)
#pragma unroll
            for (int m = 0; m < 4; ++m) { const int row = row0 + ai * HALF + m * 16; const float rstd = __builtin_amdgcn_rsqf(ss[row] * inv_d + eps);
                float a[8];
#pragma unroll
                for (int n = 0; n < 2; ++n)
#pragma unroll
                    for (int i = 0; i < 4; ++i) { const float g = acc[ai][0][m][n][i] * rstd, up = acc[ai][1][m][n][i] * rstd;
                        a[4 * n + i] = g * __builtin_amdgcn_rcpf(1.0f + __builtin_amdgcn_exp2f(-1.4426950408889634f * g)) * up; }
                u32x4 w; w.x = cvt_pk_bf16(a[0], a[1]); w.y = cvt_pk_bf16(a[2], a[3]); w.z = cvt_pk_bf16(a[4], a[5]); w.w = cvt_pk_bf16(a[6], a[7]);
                *(u32x4*)(O + (size_t)row * ldc + col0) = w; }
    }
};

struct EpiHeads {
    static constexpr bool PERM = true, AFTER_DRAIN = false;
    bf16_t* O; int Mrows;
    __device__ __forceinline__ void operator()(const f32x4 (&acc)[2][2][4][2], const Unit& u, int wr, int wc, int fr, int fq) const {
        const int row0 = u.pm * BM + wr * 64 + fr, col = wc * 32 + 8 * fq;
#pragma unroll
        for (int bj = 0; bj < 2; ++bj) { bf16_t* base = O + (size_t)(u.pn * 2 + bj) * Mrows * HALF + col;
#pragma unroll
            for (int ai = 0; ai < 2; ++ai)
#pragma unroll
                for (int m = 0; m < 4; ++m) { const f32x4 v0 = acc[ai][bj][m][0], v1 = acc[ai][bj][m][1];
                    u32x4 w; w.x = cvt_pk_bf16(v0[0], v0[1]); w.y = cvt_pk_bf16(v0[2], v0[3]); w.z = cvt_pk_bf16(v1[0], v1[1]); w.w = cvt_pk_bf16(v1[2], v1[3]);
                    *(u32x4*)(base + (size_t)(row0 + ai * HALF + m * 16) * HALF) = w; } }
    }
};
struct EpiNull {
    static constexpr bool PERM = true, AFTER_DRAIN = false;
    __device__ __forceinline__ void operator()(const f32x4 (&acc)[2][2][4][2], const Unit&, int, int, int, int) const {
#pragma unroll
        for (int ai = 0; ai < 2; ++ai)
#pragma unroll
            for (int bj = 0; bj < 2; ++bj)
#pragma unroll
                for (int m = 0; m < 4; ++m)
#pragma unroll
                    for (int n = 0; n < 2; ++n) asm volatile("" :: "v"(acc[ai][bj][m][n]));
    }
};

template <class Epi, class Sched, bool ALIGN_EPI = false, bool SP2 = false>
__device__ __forceinline__ void gemm_phase(PG8_LAS unsigned char* lds, const Gemm g, const Sched& S, const Epi& E) {
    int tid_ = threadIdx.x; asm volatile("" : "+v"(tid_));
    const int tid = tid_, wid = __builtin_amdgcn_readfirstlane(tid >> 6), lane = tid & 63, wr = wid >> 2, wc = wid & 3, fr = lane & 15, fq = lane >> 4;
    const int K = g.K, nt = K / BK;
    unsigned voffA[2], voffB[2];
#pragma unroll
    for (int i = 0; i < 2; ++i) { int R, C; stage_rc(tid * 16 + i * 8192, R, C); const int Rb = Epi::PERM ? ((R & ~31) + perm32(R & 31)) : R;
        voffA[i] = (unsigned)(R * K + C) * 2u; voffB[i] = (unsigned)(Rb * K + C) * 2u; }
    const size_t kstep = (size_t)(BK * 2);
    const size_t hstep = (size_t)HALF * K * 2;
    const size_t tstep = 2 * hstep;
    const unsigned ldsw = (unsigned)wid * 1024u;
    const int aoff = lds_byte(wr * 64 + fr, fq * 8), boff = lds_byte(wc * 32 + fr, fq * 8);
#define PG8_SA(b, h) (((b) * 2 + (h)) * HTB)
#define PG8_SB(b, h) ((4 + (b) * 2 + (h)) * HTB)
#define PG8_STAGE(bufoff, gbase, voff) do { _Pragma("unroll") for (int _i = 0; _i < 2; ++_i) \
        __builtin_amdgcn_global_load_lds((const unsigned*)((const char*)(gbase) + (voff)[_i]), (PG8_LAS unsigned*)(lds + (bufoff) + ldsw + _i * 8192), 16, 0, 0); } while (0)
#define PG8_LDA(dst, b, h) do { _Pragma("unroll") for (int m = 0; m < 4; ++m) _Pragma("unroll") for (int k = 0; k < 2; ++k) dst[m][k] = *(const PG8_LAS bf16x8*)(lds + PG8_SA(b, h) + aoff + m * 2048 + k * 1024); } while (0)
#define PG8_LDB(dst, b, h) do { _Pragma("unroll") for (int n = 0; n < 2; ++n) _Pragma("unroll") for (int k = 0; k < 2; ++k) dst[n][k] = *(const PG8_LAS bf16x8*)(lds + PG8_SB(b, h) + boff + n * 2048 + k * 1024); } while (0)
#define PG8_MMA(ai, bj, At, Bt) do { __builtin_amdgcn_s_setprio(1); _Pragma("unroll") for (int m = 0; m < 4; ++m) _Pragma("unroll") for (int n = 0; n < 2; ++n) _Pragma("unroll") for (int k = 0; k < 2; ++k) \
        acc[ai][bj][m][n] = __builtin_amdgcn_mfma_f32_16x16x32_bf16(Bt[n][k], At[m][k], acc[ai][bj][m][n], 0, 0, 0); __builtin_amdgcn_s_setprio(0); } while (0)
#define PG8_WAIT_V(n) asm volatile("s_waitcnt vmcnt(" #n ")" ::: "memory")
#define PG8_WAIT_L(n) asm volatile("s_waitcnt lgkmcnt(" #n ")" ::: "memory")
#define PG8_BAR __builtin_amdgcn_s_barrier()
#define PG8_SCHED __builtin_amdgcn_sched_barrier(0)
    Unit cur, nxt; int ui = 0;
    if (!S.next(0, cur)) return;
    f32x4 acc[2][2][4][2];
#pragma unroll
    for (int a = 0; a < 2; ++a)
#pragma unroll
        for (int b = 0; b < 2; ++b)
#pragma unroll
            for (int m = 0; m < 4; ++m)
#pragma unroll
                for (int n = 0; n < 2; ++n) acc[a][b][m][n] = (f32x4){0.f, 0.f, 0.f, 0.f};
    bf16x8 At[4][2], B0[2][2], B1[2][2];
    const char* cA = (const char*)g.A + (size_t)cur.pm * tstep; const char* cB = (const char*)g.Bt + (size_t)cur.pn * tstep;
    S.a_ready(cur);
    if constexpr (SP2) {
        PG8_STAGE(PG8_SB(0, 0), cB, voffB); PG8_STAGE(PG8_SB(0, 1), cB + hstep, voffB); PG8_STAGE(PG8_SA(0, 0), cA, voffA); PG8_STAGE(PG8_SA(0, 1), cA + hstep, voffA);
        if (wr == 1) PG8_BAR;
        PG8_WAIT_V(2); PG8_BAR;
        PG8_STAGE(PG8_SB(1, 0), cB + kstep, voffB); PG8_STAGE(PG8_SA(1, 0), cA + kstep, voffA); PG8_STAGE(PG8_SB(1, 1), cB + hstep + kstep, voffB);
        PG8_WAIT_V(6); PG8_BAR;
    } else {
        PG8_STAGE(PG8_SB(0, 0), cB, voffB); PG8_STAGE(PG8_SA(0, 0), cA, voffA); PG8_STAGE(PG8_SB(0, 1), cB + hstep, voffB); PG8_STAGE(PG8_SA(0, 1), cA + hstep, voffA);
        if (wr == 1) PG8_BAR;
        PG8_WAIT_V(4); PG8_BAR;
        PG8_STAGE(PG8_SB(1, 0), cB + kstep, voffB); PG8_STAGE(PG8_SA(1, 0), cA + kstep, voffA); PG8_STAGE(PG8_SB(1, 1), cB + hstep + kstep, voffB);
        PG8_WAIT_V(6); PG8_BAR;
    }
    for (;;) {
        const bool has_next = S.next(ui + 1, nxt);
        const char* nA = has_next ? (const char*)g.A + (size_t)nxt.pm * tstep : cA; const char* nB = has_next ? (const char*)g.Bt + (size_t)nxt.pn * tstep : cB;
        for (int t = 0; t < nt; t += 2) {
            const bool last = (t == nt - 2);
            const char* a1 = cA + (size_t)(t + 1) * kstep;
            const char* a2 = last ? nA : cA + (size_t)(t + 2) * kstep; const char* b2 = last ? nB : cB + (size_t)(t + 2) * kstep;
            const char* a3 = a2 + kstep; const char* b3 = b2 + kstep;
            if (last && has_next) S.a_ready(nxt);
            if constexpr (SP2) {
            PG8_LDB(B0, 0, 0); PG8_LDB(B1, 0, 1); PG8_SCHED; PG8_LDA(At, 0, 0); PG8_STAGE(PG8_SA(1, 1), a1 + hstep, voffA);
            PG8_WAIT_V(8); PG8_WAIT_L(0); PG8_BAR; PG8_MMA(0, 0, At, B0); PG8_MMA(0, 1, At, B1); PG8_BAR; PG8_SCHED;
            PG8_LDA(At, 0, 1); PG8_STAGE(PG8_SB(0, 0), b2, voffB); PG8_STAGE(PG8_SB(0, 1), b2 + hstep, voffB); PG8_STAGE(PG8_SA(0, 0), a2, voffA);
            PG8_WAIT_V(8); PG8_WAIT_L(0); PG8_BAR; PG8_MMA(1, 0, At, B0); PG8_MMA(1, 1, At, B1); PG8_BAR; PG8_SCHED;
            PG8_LDB(B0, 1, 0); PG8_LDB(B1, 1, 1); PG8_SCHED; PG8_LDA(At, 1, 0); PG8_STAGE(PG8_SA(0, 1), a2 + hstep, voffA);
            PG8_WAIT_V(8); PG8_WAIT_L(0); PG8_BAR; PG8_MMA(0, 0, At, B0); PG8_MMA(0, 1, At, B1); PG8_BAR; PG8_SCHED;
            PG8_LDA(At, 1, 1); PG8_STAGE(PG8_SB(1, 0), b3, voffB); PG8_STAGE(PG8_SB(1, 1), b3 + hstep, voffB); PG8_STAGE(PG8_SA(1, 0), a3, voffA);
            PG8_WAIT_V(8); PG8_WAIT_L(0); PG8_BAR; PG8_MMA(1, 0, At, B0); PG8_MMA(1, 1, At, B1); PG8_BAR; PG8_SCHED;
            } else {
            PG8_LDB(B0, 0, 0); PG8_SCHED; PG8_LDA(At, 0, 0); PG8_STAGE(PG8_SA(1, 1), a1 + hstep, voffA);
            PG8_WAIT_L(8); PG8_BAR; PG8_WAIT_L(0); PG8_MMA(0, 0, At, B0); PG8_BAR; PG8_SCHED;
            PG8_LDB(B1, 0, 1); PG8_STAGE(PG8_SB(0, 0), b2, voffB);
            PG8_BAR; PG8_WAIT_L(0); PG8_MMA(0, 1, At, B1); PG8_BAR;
            PG8_LDA(At, 0, 1); PG8_STAGE(PG8_SA(0, 0), a2, voffA);
            PG8_BAR; PG8_WAIT_L(0); PG8_MMA(1, 0, At, B0); PG8_BAR; PG8_SCHED;
            PG8_STAGE(PG8_SB(0, 1), b2 + hstep, voffB);
            PG8_WAIT_V(6); PG8_BAR; PG8_MMA(1, 1, At, B1); PG8_BAR;
            PG8_LDB(B0, 1, 0); PG8_SCHED; PG8_LDA(At, 1, 0); PG8_STAGE(PG8_SA(0, 1), a2 + hstep, voffA);
            PG8_WAIT_L(8); PG8_BAR; PG8_WAIT_L(0); PG8_MMA(0, 0, At, B0); PG8_BAR; PG8_SCHED;
            PG8_LDB(B1, 1, 1); PG8_STAGE(PG8_SB(1, 0), b3, voffB);
            PG8_BAR; PG8_WAIT_L(0); PG8_MMA(0, 1, At, B1); PG8_BAR;
            PG8_LDA(At, 1, 1); PG8_STAGE(PG8_SA(1, 0), a3, voffA);
            PG8_BAR; PG8_WAIT_L(0); PG8_MMA(1, 0, At, B0); PG8_BAR; PG8_SCHED;
            PG8_STAGE(PG8_SB(1, 1), b3 + hstep, voffB);
            PG8_WAIT_V(6); PG8_BAR; PG8_MMA(1, 1, At, B1); PG8_BAR;
            }
        }
        if constexpr (ALIGN_EPI) { if (wr == 0) PG8_BAR; }
        if constexpr (!Epi::AFTER_DRAIN) { E(acc, cur, wr, wc, fr, fq); S.done(cur); }
        if (!has_next) break;
#pragma unroll
        for (int a = 0; a < 2; ++a)
#pragma unroll
            for (int b = 0; b < 2; ++b)
#pragma unroll
                for (int m = 0; m < 4; ++m)
#pragma unroll
                    for (int n = 0; n < 2; ++n) acc[a][b][m][n] = (f32x4){0.f, 0.f, 0.f, 0.f};
        cur = nxt; cA = nA; cB = nB; ++ui;
        if constexpr (ALIGN_EPI) { if (wr == 1) PG8_BAR; }
    }
    PG8_WAIT_V(0);
    if constexpr (!ALIGN_EPI) { if (wr == 0) PG8_BAR; }
    PG8_BAR;
    if constexpr (Epi::AFTER_DRAIN) { E.fused(acc, cur, wr, wc, fr, fq, lds, wid, lane); S.done(cur); }
#undef PG8_SA
#undef PG8_SB
#undef PG8_STAGE
#undef PG8_LDA
#undef PG8_LDB
#undef PG8_MMA
#undef PG8_WAIT_V
#undef PG8_WAIT_L
#undef PG8_BAR
#undef PG8_SCHED
}
}

constexpr int NWAVES = 8;
#ifndef ATTN_NAIVE
#define ATTN_NAIVE 0
#endif
#ifndef ATTN_V1
#define ATTN_V1 0
#endif
#ifndef R1_V1
#define R1_V1 0
#endif
#ifndef R3_V1
#define R3_V1 0
#endif
#ifndef R1_NAIVE
#define R1_NAIVE 0
#endif
#ifndef R3_NAIVE
#define R3_NAIVE 0
#endif
#ifndef PROBE_REPEAT
#define PROBE_REPEAT 0
#endif
#ifndef PROBE_T
#define PROBE_T 0
#endif
#ifndef PROBE_MULT
#define PROBE_MULT 16
#endif
#ifndef PROBE_USE_B
#define PROBE_USE_B 0
#endif
#ifndef PROBE_BLOCK
#define PROBE_BLOCK 0
#endif
#ifndef MK_N_LAUNCHES
#define MK_N_LAUNCHES 1
#endif
constexpr int PER_PHASE = 9;
constexpr int N_LAUNCHES = MK_N_LAUNCHES;

constexpr int BATCH = 4, SEQ = 4096, D = 2048, M = BATCH * SEQ, HD = 128, NH = 8, DATT = 1024, DRET = 1024, DIN = 7168, DFF = 5632, NGU = 2 * DFF, CH = 128, NCH = SEQ / CH;
constexpr float EPS = 1e-6f;
constexpr int COL_QA = 0, COL_KA = 1024, COL_VA = 2048, COL_QR = 3072, COL_KR = 4096, COL_VR = 5120, COL_GR = 6144;

constexpr size_t MiB = 1u << 20;
constexpr size_t WS_CTL = 0, CTL_ZERO_BYTES = 1 * MiB;
constexpr size_t WS_WIN = 1 * MiB, WS_WOUT = 29 * MiB, WS_WGU = 37 * MiB, WS_WDN = 81 * MiB;
constexpr size_t WS_LSE = 103 * MiB;
constexpr size_t WS_XN = 105 * MiB;
constexpr size_t WS_PROJ = 169 * MiB;
constexpr size_t WS_MIX = 393 * MiB;
constexpr size_t WS_END = 457 * MiB;
static_assert(WS_WIN + (size_t)DIN * D * 2 <= WS_WOUT && WS_WOUT + (size_t)D * D * 2 <= WS_WGU && WS_WGU + (size_t)NGU * D * 2 <= WS_WDN && WS_WDN + (size_t)D * DFF * 2 <= WS_LSE, "weight map");
static_assert(WS_XN + (size_t)M * D * 2 <= WS_PROJ && WS_PROJ + (size_t)M * DIN * 2 <= WS_MIX && WS_MIX + (size_t)M * D * 2 <= WS_END, "activation map");
constexpr int CW_TMO = 0, CW_CODE = 1, CW_BAR = 4096;
constexpr size_t CTL_SS1 = 256 * 1024;
constexpr size_t ST_HALF = (size_t)BATCH * NH * NCH * HD * HD;

constexpr int RING_OFF = 0, RING_BYTES = 143360;
constexpr int LDSCTL_OFF = RING_BYTES, MISC_OFF = LDSCTL_OFF + 320;
constexpr int LDS_BYTES = 147456;
static_assert(MISC_OFF + 128 <= LDS_BYTES, "LDS map");

#define GAS __attribute__((address_space(1)))
#define LAS __attribute__((address_space(3)))
typedef unsigned short bf16;
typedef unsigned v4u __attribute__((ext_vector_type(4)));
typedef float f32x4 __attribute__((ext_vector_type(4)));
typedef GAS unsigned gu32;
#define RLX_AGENT __ATOMIC_RELAXED, __HIP_MEMORY_SCOPE_AGENT
#define LDS_WAIT() asm volatile("s_waitcnt lgkmcnt(0)" ::: "memory")
#define VM_WAIT() asm volatile("s_waitcnt vmcnt(0)" ::: "memory")
__device__ __forceinline__ unsigned f2bf(float f) { unsigned u = __builtin_bit_cast(unsigned, f); return (u + 0x7fffu + ((u >> 16) & 1u)) >> 16; }
__device__ __forceinline__ unsigned pk2(float lo, float hi) { return f2bf(lo) | (f2bf(hi) << 16); }
__device__ __forceinline__ float bflo(unsigned w) { return __builtin_bit_cast(float, w << 16); }
__device__ __forceinline__ float bfhi(unsigned w) { return __builtin_bit_cast(float, w & 0xffff0000u); }

#define XB_TMO      128
#define XB_XCNT(j)  (256  + 64 * (j))
#define XB_XSUB(j)  (1280 + 64 * (j))
#define XB_XGEN(j)  (2304 + 64 * (j))
#define XB_TOP      3328
#define XB_TOPGEN   3392
#define XCD_BAR_WORDS 3456
#define XB_SPIN_CAP (1u << 18)

__device__ __forceinline__ unsigned xb_ld(unsigned* p)              { return __hip_atomic_load(p, __ATOMIC_RELAXED, __HIP_MEMORY_SCOPE_AGENT); }
__device__ __forceinline__ unsigned xb_add(unsigned* p, unsigned v) { return __hip_atomic_fetch_add(p, v, __ATOMIC_RELAXED, __HIP_MEMORY_SCOPE_AGENT); }
__device__ __forceinline__ unsigned xb_xcc_id() { return (unsigned)__builtin_amdgcn_s_getreg((3 << 11) | 20) & 0xFu; }
#define XB_SPIN(cond, bar) do { unsigned _sp = 0; while (cond) { __builtin_amdgcn_s_sleep(1); \
    if ((++_sp & 255u) == 0u) { if (xb_ld(&(bar)[XB_TMO])) break; if (_sp > XB_SPIN_CAP) { atomicAdd(&(bar)[XB_TMO], 1u); break; } } } } while (0)

struct XcdBarrier {
    unsigned* bar; unsigned x;
    volatile LAS unsigned* st;
};

__device__ __forceinline__ XcdBarrier xcd_barrier_post(unsigned* bar, volatile LAS unsigned* st) {
    XcdBarrier b; b.bar = bar; b.x = xb_xcc_id(); b.st = st;
    if (threadIdx.x == 0) st[2] = xb_add(&bar[XB_XCNT(b.x)], 1u);
    return b;
}
__device__ __forceinline__ void xcd_barrier_complete(unsigned* bar, unsigned x, unsigned& nloc, unsigned& nx) {
    const unsigned G = gridDim.x * gridDim.y * gridDim.z;
    unsigned sum, cnt, mine, sp = 0u;
    for (;;) {
        sum = 0u; cnt = 0u; mine = 0u;
#pragma unroll
        for (unsigned j = 0; j < 16; ++j) { const unsigned c = xb_ld(&bar[XB_XCNT(j)]); sum += c; cnt += (c > 0u) ? 1u : 0u; mine = (j == x) ? c : mine; }
        if (sum == G) break;
        __builtin_amdgcn_s_sleep(1);
        if ((++sp & 255u) == 0u) { if (xb_ld(&bar[XB_TMO])) break; if (sp > XB_SPIN_CAP) { atomicAdd(&bar[XB_TMO], 1u); break; } }
    }
    nloc = mine > 0u ? mine : 1u; nx = cnt > 0u ? cnt : 1u;
}

__device__ __forceinline__ void xcd_barrier(const XcdBarrier& b) {
    asm volatile("s_waitcnt vmcnt(0)" ::: "memory");
    __syncthreads();
    if (threadIdx.x == 0) {
        unsigned* bar = b.bar;
        __builtin_amdgcn_s_waitcnt(0);
        unsigned nloc = b.st[0], nx = b.st[1];
        if (nloc == 0u) { xcd_barrier_complete(bar, b.x, nloc, nx); b.st[0] = nloc; b.st[1] = nx; }
        const unsigned old = xb_add(&bar[XB_XSUB(b.x)], 1u);
        const unsigned gen = old / nloc;
        if (old + 1u == (gen + 1u) * nloc) {
            __builtin_amdgcn_fence(__ATOMIC_RELEASE, "agent");
            asm volatile("s_waitcnt vmcnt(0)" ::: "memory");
            const unsigned og = xb_add(&bar[XB_TOP], 1u);
            const unsigned tg = og / nx;
            if (og + 1u == (tg + 1u) * nx) xb_add(&bar[XB_TOPGEN], 1u);
            else XB_SPIN(xb_ld(&bar[XB_TOPGEN]) == tg, bar);
            __builtin_amdgcn_fence(__ATOMIC_ACQUIRE, "agent");
            xb_add(&bar[XB_XGEN(b.x)], 1u);
            asm volatile("s_waitcnt vmcnt(0)" ::: "memory");
        } else {
            XB_SPIN(xb_ld(&bar[XB_XGEN(b.x)]) == gen, bar);
            __builtin_amdgcn_fence(__ATOMIC_ACQUIRE, "agent");
            asm volatile("s_waitcnt vmcnt(0)" ::: "memory");
        }
    }
    __syncthreads();
}

struct Frame {
    LAS unsigned char* lds;
    volatile LAS unsigned* MISC;
    gu32* ctl;
    int tid, lane, wave;
    int vcu, G;
    const float *x, *w_mix, *w_in, *decf, *decb, *w_retn, *w_out, *w_ffn, *w_gate, *w_up, *w_down, *w_fin; float* out;
    bf16 *Win_t, *Wout_t, *Wgu_t, *Wdn_t;
    bf16 *XN, *PROJ, *MIX, *ACT;
    float *STF, *STB, *SS1, *LSE;
    unsigned long long tA, tB;
};
#if PROBE_T
#define RT() __builtin_amdgcn_s_memrealtime()
#define T_ADD(acc, t0) do { __builtin_amdgcn_sched_barrier(0); (acc) += RT() - (t0); __builtin_amdgcn_sched_barrier(0); } while (0)
#define T_START(t0) do { __builtin_amdgcn_sched_barrier(0); (t0) = RT(); __builtin_amdgcn_sched_barrier(0); } while (0)
#else
#define T_ADD(acc, t0) do {} while (0)
#define T_START(t0) do {} while (0)
#endif

__device__ __forceinline__ float wave_sum(float v) {
#pragma unroll
    for (int o = 1; o < 64; o <<= 1) v += __shfl_xor(v, o);
    return v;
}
__device__ __forceinline__ float wave_max(float v) {
#pragma unroll
    for (int o = 1; o < 64; o <<= 1) v = fmaxf(v, __shfl_xor(v, o));
    return v;
}
__device__ __forceinline__ void p0_tr_load(f32x4 (&v)[16], const float* W, int N, int k0, int n0, int lane) {
#pragma unroll
    for (int i = 0; i < 16; ++i) v[i] = *(const GAS f32x4*)(W + (size_t)(k0 + 4 * i + (lane >> 4)) * N + n0 + 4 * (lane & 15));
}
__device__ __forceinline__ void p0_tr_store(f32x4 (&v)[16], int K, bf16* WT, int row_base, const float* kscale, LAS float* scr, int k0, int lane) {
#pragma unroll
    for (int i = 0; i < 16; ++i) { const int kk = 4 * i + (lane >> 4); f32x4 x = v[i]; if (kscale) x = x * kscale[k0 + kk]; LAS float* d = scr + kk * 65 + 4 * (lane & 15); d[0] = x.x; d[1] = x.y; d[2] = x.z; d[3] = x.w; }
    LDS_WAIT(); asm volatile("" ::: "memory");
    const int c = lane & 7;
#pragma unroll
    for (int j = 0; j < 8; ++j) { const int n = (lane >> 3) + 8 * j; const LAS float* s = scr + (8 * c) * 65 + n;
        v4u o; o.x = pk2(s[0 * 65], s[1 * 65]); o.y = pk2(s[2 * 65], s[3 * 65]); o.z = pk2(s[4 * 65], s[5 * 65]); o.w = pk2(s[6 * 65], s[7 * 65]);
        *(GAS v4u*)(WT + (size_t)(row_base + n) * K + k0 + 8 * c) = o; }
    LDS_WAIT(); asm volatile("" ::: "memory");
}
struct P0Item { const float* W; bf16* WT; const float* ks; int K, N, k0, n0, row_base; };
__device__ __forceinline__ P0Item p0_item(const Frame& F, int it) {
    constexpr int I_IN = (D / 64) * (DIN / 64), I_OUT = (D / 64) * (D / 64), I_G = (D / 64) * (DFF / 64);
    P0Item P; int r = it;
    if (r < I_IN) { const int nblk = DIN / 64; P.W = F.w_in; P.WT = F.Win_t; P.ks = nullptr; P.K = D; P.N = DIN; P.k0 = 64 * (r / nblk); P.n0 = 64 * (r % nblk); P.row_base = P.n0; return P; } r -= I_IN;
    if (r < I_OUT) { const int nblk = D / 64; P.W = F.w_out; P.WT = F.Wout_t; P.ks = nullptr; P.K = D; P.N = D; P.k0 = 64 * (r / nblk); P.n0 = 64 * (r % nblk); P.row_base = P.n0; return P; } r -= I_OUT;
    if (r < 2 * I_G) { const int up = r >= I_G; if (up) r -= I_G; const int nblk = DFF / 64; P.W = up ? F.w_up : F.w_gate; P.WT = F.Wgu_t; P.ks = F.w_ffn; P.K = D; P.N = DFF; P.k0 = 64 * (r / nblk); P.n0 = 64 * (r % nblk);
        P.row_base = 256 * (P.n0 >> 7) + (P.n0 & 127) + (up ? 128 : 0); return P; }
    r -= 2 * I_G;
    { const int nblk = D / 64; P.W = F.w_down; P.WT = F.Wdn_t; P.ks = nullptr; P.K = DFF; P.N = D; P.k0 = 64 * (r / nblk); P.n0 = 64 * (r % nblk); P.row_base = P.n0; return P; }
}
__device__ __forceinline__ void p0_prologue(Frame& F) {
    LAS float* scr = (LAS float*)(F.lds + RING_OFF + F.wave * 17408);
    const int gw = F.vcu * NWAVES + F.wave, NGW = F.G * NWAVES, lane = F.lane;
    constexpr int NITEMS = (D / 64) * (DIN / 64) + (D / 64) * (D / 64) + 2 * (D / 64) * (DFF / 64) + (DFF / 64) * (D / 64);
    for (int m = 2 * gw; m < M; m += 2 * NGW) {
        const GAS f32x4* x0 = (const GAS f32x4*)(F.x + (size_t)m * D) + lane; const GAS f32x4* x1 = x0 + D / 4; const GAS f32x4* wr = (const GAS f32x4*)F.w_mix + lane;
        f32x4 v0[8], v1[8]; float s0 = 0.f, s1 = 0.f;
#pragma unroll
        for (int j = 0; j < 8; ++j) { v0[j] = x0[64 * j]; v1[j] = x1[64 * j]; }
#pragma unroll
        for (int j = 0; j < 8; ++j) { s0 += (v0[j].x * v0[j].x + v0[j].y * v0[j].y) + (v0[j].z * v0[j].z + v0[j].w * v0[j].w); s1 += (v1[j].x * v1[j].x + v1[j].y * v1[j].y) + (v1[j].z * v1[j].z + v1[j].w * v1[j].w); }
        const float r0 = 1.0f / sqrtf(wave_sum(s0) * (1.0f / D) + EPS), r1 = 1.0f / sqrtf(wave_sum(s1) * (1.0f / D) + EPS);
        GAS unsigned long long* o0 = (GAS unsigned long long*)(F.XN + (size_t)m * D) + lane; GAS unsigned long long* o1 = o0 + D / 4;
#pragma unroll
        for (int j = 0; j < 8; ++j) { const f32x4 w = wr[64 * j];
            o0[64 * j] = (unsigned long long)pk2(v0[j].x * r0 * w.x, v0[j].y * r0 * w.y) | ((unsigned long long)pk2(v0[j].z * r0 * w.z, v0[j].w * r0 * w.w) << 32);
            o1[64 * j] = (unsigned long long)pk2(v1[j].x * r1 * w.x, v1[j].y * r1 * w.y) | ((unsigned long long)pk2(v1[j].z * r1 * w.z, v1[j].w * r1 * w.w) << 32); }
    }
    int it = gw; if (it >= NITEMS) return;
    P0Item P = p0_item(F, it); f32x4 v[16]; p0_tr_load(v, P.W, P.N, P.k0, P.n0, lane);
    for (;;) { const int nit = it + NGW; const bool more = nit < NITEMS; P0Item Pn = P; f32x4 vn[16];
        if (more) { Pn = p0_item(F, nit); p0_tr_load(vn, Pn.W, Pn.N, Pn.k0, Pn.n0, lane); }
        p0_tr_store(v, P.K, P.WT, P.row_base, P.ks, scr, P.k0, lane);
        if (!more) break;
#pragma unroll
        for (int i = 0; i < 16; ++i) v[i] = vn[i];
        P = Pn; it = nit; }
}

#define HP(col, h) (F.PROJ + (size_t)((col) / HD + (h)) * M * HD)
__device__ __forceinline__ void p2_attn_naive(Frame& F) {
    LAS float* qs = (LAS float*)(F.lds + RING_OFF + F.wave * 4096);
    LAS float* ps = qs + 128;
    const int gw = F.vcu * NWAVES + F.wave, NGW = F.G * NWAVES, lane = F.lane;
    for (int item = gw; item < BATCH * NH * SEQ; item += NGW) {
        const int bh = item >> 12, t = item & 4095, b = bh >> 3, h = bh & 7;
        const float slope = exp2f(-(float)(h + 1));
        const bf16* Qrow = HP(COL_QA, h) + (size_t)(b * SEQ + t) * HD;
        const bf16* Kb = HP(COL_KA, h) + (size_t)(b * SEQ) * HD;
        const bf16* Vb = HP(COL_VA, h) + (size_t)(b * SEQ) * HD;
        { const unsigned qq = *(const GAS unsigned*)(Qrow + 2 * lane); qs[2 * lane] = bflo(qq) * 0.08838834764831845f; qs[2 * lane + 1] = bfhi(qq) * 0.08838834764831845f; }
        LDS_WAIT();
        float sc[3][3]; float mx = -INFINITY;
#pragma unroll
        for (int p = 0; p < 3; ++p) { const int dil = 1 << (2 * p);
#pragma unroll
            for (int k = 0; k < 3; ++k) { const int idx = lane + 64 * k, j = idx - 64, s = t + j * dil; float v = -INFINITY;
                if (idx < 129 && s >= 0 && s < SEQ) { const GAS v4u* kr = (const GAS v4u*)(Kb + (size_t)s * HD); float dot = 0.f;
#pragma unroll 4
                    for (int c = 0; c < 16; ++c) { const v4u kk = kr[c]; const LAS float* q8 = qs + 8 * c;
                        dot += q8[0] * bflo(kk.x) + q8[1] * bfhi(kk.x) + q8[2] * bflo(kk.y) + q8[3] * bfhi(kk.y) + q8[4] * bflo(kk.z) + q8[5] * bfhi(kk.z) + q8[6] * bflo(kk.w) + q8[7] * bfhi(kk.w); }
                    v = dot - slope * (float)(dil * (j < 0 ? -j : j)); }
                sc[p][k] = v; mx = fmaxf(mx, v); } }
        mx = wave_max(mx);
        float l = 0.f;
#pragma unroll
        for (int p = 0; p < 3; ++p)
#pragma unroll
            for (int k = 0; k < 3; ++k) { const float e = __expf(sc[p][k] - mx); l += e; ps[p * 192 + lane + 64 * k] = e; }
        l = wave_sum(l);
        LDS_WAIT();
        float o0 = 0.f, o1 = 0.f;
#pragma unroll
        for (int p = 0; p < 3; ++p) { const int dil = 1 << (2 * p);
            for (int idx = 0; idx < 129; ++idx) { const int s = t + (idx - 64) * dil;
                if (s >= 0 && s < SEQ) { const float pv = ps[p * 192 + idx]; const unsigned vv = *(const GAS unsigned*)(Vb + (size_t)s * HD + 2 * lane); o0 += pv * bflo(vv); o1 += pv * bfhi(vv); } } }
        const float il = 1.0f / l;
        *(GAS unsigned*)(F.MIX + (size_t)(b * SEQ + t) * D + h * HD + 2 * lane) = pk2(o0 * il, o1 * il);
        LDS_WAIT();
    }
}
__device__ __forceinline__ void p2_r1_naive(Frame& F) {
    LAS float* Ks = (LAS float*)(F.lds + RING_OFF); LAS float* Vs = Ks + CH * HD;
    const int tid = F.tid;
    for (int item = F.vcu; item < BATCH * NH * NCH; item += F.G) {
        const int bh = item >> 5, c = item & 31, b = bh >> 3, h = bh & 7; const size_t row0 = (size_t)b * SEQ + c * CH;
        const bf16* Kg = HP(COL_KR, h) + row0 * HD; const bf16* Vg = HP(COL_VR, h) + row0 * HD;
        { const int row = tid >> 2, seg = tid & 3;
#pragma unroll
          for (int q = 0; q < 4; ++q) { const v4u kk = *(const GAS v4u*)(Kg + (size_t)row * HD + 32 * seg + 8 * q); const v4u vv = *(const GAS v4u*)(Vg + (size_t)row * HD + 32 * seg + 8 * q);
              LAS float* kd = Ks + row * HD + 32 * seg + 8 * q; LAS float* vd = Vs + row * HD + 32 * seg + 8 * q;
              kd[0] = bflo(kk.x); kd[1] = bfhi(kk.x); kd[2] = bflo(kk.y); kd[3] = bfhi(kk.y); kd[4] = bflo(kk.z); kd[5] = bfhi(kk.z); kd[6] = bflo(kk.w); kd[7] = bfhi(kk.w);
              vd[0] = bflo(vv.x); vd[1] = bfhi(vv.x); vd[2] = bflo(vv.y); vd[3] = bfhi(vv.y); vd[4] = bflo(vv.z); vd[5] = bfhi(vv.z); vd[6] = bflo(vv.w); vd[7] = bfhi(vv.w); } }
        __syncthreads();
        const float lgf = -__expf(F.decf[h]), lgb = -__expf(F.decb[h]);
        const int e = tid >> 2, dq = tid & 3;
        float af[32], ab[32];
#pragma unroll
        for (int i = 0; i < 32; ++i) { af[i] = 0.f; ab[i] = 0.f; }
        for (int j = 0; j < CH; ++j) { const float v = Vs[j * HD + e], vf = v * __expf(lgf * (float)(CH - 1 - j)), vb = v * __expf(lgb * (float)j);
            const LAS f32x4* k4 = (const LAS f32x4*)(Ks + j * HD + 32 * dq);
#pragma unroll
            for (int i = 0; i < 8; ++i) { const f32x4 k = k4[i];
                af[4 * i] += vf * k.x; af[4 * i + 1] += vf * k.y; af[4 * i + 2] += vf * k.z; af[4 * i + 3] += vf * k.w;
                ab[4 * i] += vb * k.x; ab[4 * i + 1] += vb * k.y; ab[4 * i + 2] += vb * k.z; ab[4 * i + 3] += vb * k.w; } }
        GAS f32x4* of = (GAS f32x4*)(F.STF + (size_t)item * HD * HD + e * HD + 32 * dq); GAS f32x4* ob = (GAS f32x4*)(F.STB + (size_t)item * HD * HD + e * HD + 32 * dq);
#pragma unroll
        for (int i = 0; i < 8; ++i) { of[i] = (f32x4){af[4 * i], af[4 * i + 1], af[4 * i + 2], af[4 * i + 3]}; ob[i] = (f32x4){ab[4 * i], ab[4 * i + 1], ab[4 * i + 2], ab[4 * i + 3]}; }
        __syncthreads();
    }
}
__device__ __forceinline__ bf16* sbf_row(bf16* proj, int slot, int e);
__device__ __forceinline__ void p3_scan(Frame& F) {
    const int gt = F.vcu * (NWAVES * 64) + F.tid, NT = F.G * NWAVES * 64;
    for (int idx = gt; idx < 2 * BATCH * NH * 4096; idx += NT) {
        const int dir = idx / (BATCH * NH * 4096), rem = idx % (BATCH * NH * 4096), bh = rem >> 12, q = rem & 4095, h = bh & 7;
        const float g = __expf(-__expf(dir ? F.decb[h] : F.decf[h]) * (float)CH);
        GAS f32x4* base = (GAS f32x4*)(dir ? F.STB : F.STF) + (size_t)bh * NCH * 4096 + q;
        f32x4 s = (f32x4){0.f, 0.f, 0.f, 0.f};
#pragma unroll 8
        for (int cc = 0; cc < NCH; ++cc) { const int c = dir ? NCH - 1 - cc : cc; const f32x4 t = base[(size_t)c * 4096];
#if R3_NAIVE
            base[(size_t)c * 4096] = s;
#else
            { unsigned long long o = (unsigned long long)pk2(s.x, s.y) | ((unsigned long long)pk2(s.z, s.w) << 32); *(GAS unsigned long long*)(sbf_row(F.PROJ, 2 * (bh * NCH + c) + dir, q >> 5) + 4 * (q & 31)) = o; }
#endif
            s = s * g + t; }
    }
}
__device__ __forceinline__ void p4_r3_naive(Frame& F) {
    LAS bf16* Qs = (LAS bf16*)(F.lds + RING_OFF); LAS bf16* KVs = Qs + CH * HD; LAS float* As = (LAS float*)(F.lds + RING_OFF + 65536);
    const int tid = F.tid; const float scale = 0.08838834764831845f;
    for (int item = F.vcu; item < BATCH * NH * NCH; item += F.G) {
        const int bh = item >> 5, c = item & 31, b = bh >> 3, h = bh & 7; const size_t row0 = (size_t)b * SEQ + c * CH;
        const bf16* Qg = HP(COL_QR, h) + row0 * HD; const bf16* Kg = HP(COL_KR, h) + row0 * HD;
        const bf16* Vg = HP(COL_VR, h) + row0 * HD; const bf16* Gg = HP(COL_GR, h) + row0 * HD;
        const float lgf = -__expf(F.decf[h]), lgb = -__expf(F.decb[h]);
        const int i = tid >> 2, part = tid & 3;
#pragma unroll
        for (int q = 0; q < 4; ++q) { *(LAS v4u*)(Qs + i * HD + 32 * part + 8 * q) = *(const GAS v4u*)(Qg + (size_t)i * HD + 32 * part + 8 * q);
                                      *(LAS v4u*)(KVs + i * HD + 32 * part + 8 * q) = *(const GAS v4u*)(Kg + (size_t)i * HD + 32 * part + 8 * q); }
        __syncthreads();
        for (int jj = 0; jj < 32; ++jj) { const int j = 32 * part + jj; float dot = 0.f;
#pragma unroll 4
            for (int c8 = 0; c8 < 16; ++c8) { const v4u qq = *(const LAS v4u*)(Qs + i * HD + 8 * c8), kk = *(const LAS v4u*)(KVs + j * HD + 8 * c8);
                dot += bflo(qq.x) * bflo(kk.x) + bfhi(qq.x) * bfhi(kk.x) + bflo(qq.y) * bflo(kk.y) + bfhi(qq.y) * bfhi(kk.y) + bflo(qq.z) * bflo(kk.z) + bfhi(qq.z) * bfhi(kk.z) + bflo(qq.w) * bflo(kk.w) + bfhi(qq.w) * bfhi(kk.w); }
            const float dec = (j <= i) ? __expf(lgf * (float)(i - j)) : __expf(lgb * (float)(j - i));
            As[i * CH + j] = dot * scale * dec; }
        __syncthreads();
#pragma unroll
        for (int q = 0; q < 4; ++q) *(LAS v4u*)(KVs + i * HD + 32 * part + 8 * q) = *(const GAS v4u*)(Vg + (size_t)i * HD + 32 * part + 8 * q);
        __syncthreads();
        const int e0 = 32 * part;
        float acc[32], accf[32], accb[32];
#pragma unroll
        for (int k = 0; k < 32; ++k) { acc[k] = 0.f; accf[k] = 0.f; accb[k] = 0.f; }
        for (int j = 0; j < CH; ++j) { const float a = As[i * CH + j];
#pragma unroll
            for (int q = 0; q < 4; ++q) { const v4u vv = *(const LAS v4u*)(KVs + j * HD + e0 + 8 * q);
                acc[8 * q] += a * bflo(vv.x); acc[8 * q + 1] += a * bfhi(vv.x); acc[8 * q + 2] += a * bflo(vv.y); acc[8 * q + 3] += a * bfhi(vv.y);
                acc[8 * q + 4] += a * bflo(vv.z); acc[8 * q + 5] += a * bfhi(vv.z); acc[8 * q + 6] += a * bflo(vv.w); acc[8 * q + 7] += a * bfhi(vv.w); } }
        const float* Sf = F.STF + (size_t)item * HD * HD; const float* Sb = F.STB + (size_t)item * HD * HD;
        for (int d4 = 0; d4 < HD; d4 += 4) { const unsigned long long qq = *(const LAS unsigned long long*)(Qs + i * HD + d4);
            const float q0 = bflo((unsigned)qq), q1 = bfhi((unsigned)qq), q2 = bflo((unsigned)(qq >> 32)), q3 = bfhi((unsigned)(qq >> 32));
#pragma unroll
            for (int k = 0; k < 32; ++k) { const f32x4 sf = *(const GAS f32x4*)(Sf + (size_t)(e0 + k) * HD + d4), sb = *(const GAS f32x4*)(Sb + (size_t)(e0 + k) * HD + d4);
                accf[k] += q0 * sf.x + q1 * sf.y + q2 * sf.z + q3 * sf.w; accb[k] += q0 * sb.x + q1 * sb.y + q2 * sb.z + q3 * sb.w; } }
        const float ff = __expf(lgf * (float)(i + 1)) * scale, fb = __expf(lgb * (float)(CH - i)) * scale;
        float ssq = 0.f;
#pragma unroll
        for (int k = 0; k < 32; ++k) { acc[k] += ff * accf[k] + fb * accb[k]; ssq += acc[k] * acc[k]; }
        ssq += __shfl_xor(ssq, 1); ssq += __shfl_xor(ssq, 2);
        const float rms = 1.0f / sqrtf(ssq * (1.0f / HD) + EPS);
        bf16* orow = F.MIX + (row0 + i) * D + DATT + h * HD + e0;
#pragma unroll
        for (int q = 0; q < 4; ++q) { const v4u gg = *(const GAS v4u*)(Gg + (size_t)i * HD + e0 + 8 * q); float r[8]; const float gv[8] = {bflo(gg.x), bfhi(gg.x), bflo(gg.y), bfhi(gg.y), bflo(gg.z), bfhi(gg.z), bflo(gg.w), bfhi(gg.w)};
#pragma unroll
            for (int k = 0; k < 8; ++k) { const float g = gv[k]; r[k] = acc[8 * q + k] * rms * F.w_retn[h * HD + e0 + 8 * q + k] * (g / (1.0f + __expf(-g))); }
            v4u o; o.x = pk2(r[0], r[1]); o.y = pk2(r[2], r[3]); o.z = pk2(r[4], r[5]); o.w = pk2(r[6], r[7]); *(GAS v4u*)(orow + 8 * q) = o; }
        __syncthreads();
    }
}
__device__ __forceinline__ void p8_final(Frame& F, bool dummy) {
    const int gw = F.vcu * NWAVES + F.wave, NGW = F.G * NWAVES;
    for (int m = gw; m < M; m += NGW) {
        GAS f32x4* xr = (GAS f32x4*)(F.out + (size_t)m * D) + F.lane; const GAS f32x4* wr = (const GAS f32x4*)F.w_fin + F.lane;
        f32x4 v[8]; float s = 0.f;
#pragma unroll
        for (int j = 0; j < 8; ++j) { v[j] = xr[64 * j]; s += (v[j].x * v[j].x + v[j].y * v[j].y) + (v[j].z * v[j].z + v[j].w * v[j].w); }
        const float rstd = 1.0f / sqrtf(wave_sum(s) * (1.0f / D) + EPS);
#pragma unroll
        for (int j = 0; j < 8; ++j) xr[64 * j] = dummy ? (v[j] + (rstd > 1e30f ? 1.0f : 0.0f)) : v[j] * rstd * wr[64 * j];
    }
}


typedef short bf16x8 __attribute__((ext_vector_type(8)));
typedef float f32x16 __attribute__((ext_vector_type(16)));
typedef unsigned u32x2 __attribute__((ext_vector_type(2)));
typedef float f32x2_t __attribute__((ext_vector_type(2))); typedef __bf16 bf16x2_t __attribute__((ext_vector_type(2)));
__device__ __forceinline__ unsigned cvtpk(float lo, float hi) { f32x2_t v = {lo, hi}; bf16x2_t b = __builtin_convertvector(v, bf16x2_t); return __builtin_bit_cast(unsigned, b); }
#define MFMA32(a, b, c) __builtin_amdgcn_mfma_f32_32x32x16_bf16((a), (b), (c), 0, 0, 0)
__device__ __forceinline__ f32x16 zero16() { f32x16 z;
#pragma unroll
    for (int i = 0; i < 16; ++i) z[i] = 0.f; return z; }
__device__ __forceinline__ bf16x8 pack8(const f32x16& x, int sp) {
    v4u p; p.x = cvtpk(x[8 * sp + 0], x[8 * sp + 1]); p.y = cvtpk(x[8 * sp + 2], x[8 * sp + 3]); p.z = cvtpk(x[8 * sp + 4], x[8 * sp + 5]); p.w = cvtpk(x[8 * sp + 6], x[8 * sp + 7]);
    return __builtin_bit_cast(bf16x8, p); }
__device__ __forceinline__ bf16x8 cat8(u32x2 lo, u32x2 hi) { v4u p; p.x = lo.x; p.y = lo.y; p.z = hi.x; p.w = hi.y; return __builtin_bit_cast(bf16x8, p); }
__device__ __forceinline__ unsigned elt16(const v4u& v, int i) { const unsigned w = v[i >> 1]; return (i & 1) ? (w >> 16) : (w & 0xffffu); }

__device__ __forceinline__ bf16* sbf_row(bf16* proj, int slot, int e) { return proj + ((size_t)slot * HD + e) * HD; }
__device__ __forceinline__ void p2_r1_mfma(Frame& F) {
    constexpr int P = 272;
    LAS unsigned char* KT = F.lds + RING_OFF; LAS unsigned char* VFT = KT + 128 * P; LAS unsigned char* VBT = VFT + 128 * P;
    const int w = F.wave;
    for (int item = F.vcu; item < BATCH * NH * NCH; item += F.G) {
        int tid = F.tid; asm volatile("" : "+v"(tid)); const int lane = tid & 63, r = lane & 31, hh = lane >> 5;
        const int bh = item >> 5, c = item & 31, b = bh >> 3, h = bh & 7; const size_t row0 = (size_t)b * SEQ + c * CH;
        const bf16* Kg = HP(COL_KR, h) + row0 * HD; const bf16* Vg = HP(COL_VR, h) + row0 * HD;
        const float lgf = -__expf(F.decf[h]), lgb = -__expf(F.decb[h]);
        {
            const int jg = tid & 31, dc = tid >> 5; v4u kr[4], vr[4]; float sf[4], sb[4];
#pragma unroll
            for (int q = 0; q < 4; ++q) { kr[q] = *(const GAS v4u*)(Kg + (size_t)(4 * jg + q) * HD + 8 * dc); vr[q] = *(const GAS v4u*)(Vg + (size_t)(4 * jg + q) * HD + 8 * dc);
                sf[q] = __expf(lgf * (float)(CH - 1 - (4 * jg + q))); sb[q] = __expf(lgb * (float)(4 * jg + q)); }
#pragma unroll
            for (int i = 0; i < 8; ++i) { const int off = (8 * dc + i) * P + 8 * jg;
                u32x2 kk; kk.x = elt16(kr[0], i) | (elt16(kr[1], i) << 16); kk.y = elt16(kr[2], i) | (elt16(kr[3], i) << 16); *(LAS u32x2*)(KT + off) = kk;
                const float v0 = __builtin_bit_cast(float, elt16(vr[0], i) << 16), v1 = __builtin_bit_cast(float, elt16(vr[1], i) << 16), v2 = __builtin_bit_cast(float, elt16(vr[2], i) << 16), v3 = __builtin_bit_cast(float, elt16(vr[3], i) << 16);
                u32x2 vf; vf.x = cvtpk(v0 * sf[0], v1 * sf[1]); vf.y = cvtpk(v2 * sf[2], v3 * sf[3]); *(LAS u32x2*)(VFT + off) = vf;
                u32x2 vb; vb.x = cvtpk(v0 * sb[0], v1 * sb[1]); vb.y = cvtpk(v2 * sb[2], v3 * sb[3]); *(LAS u32x2*)(VBT + off) = vb; }
        }
        __syncthreads();
        const int et = w & 3, dt0 = 2 * (w >> 2);
        f32x16 accf[2], accb[2]; accf[0] = zero16(); accf[1] = zero16(); accb[0] = zero16(); accb[1] = zero16();
#pragma unroll
        for (int s = 0; s < 8; ++s) {
            const bf16x8 af = *(const LAS bf16x8*)(VFT + (32 * et + r) * P + 32 * s + 16 * hh), ab = *(const LAS bf16x8*)(VBT + (32 * et + r) * P + 32 * s + 16 * hh);
#pragma unroll
            for (int t = 0; t < 2; ++t) { const bf16x8 bk = *(const LAS bf16x8*)(KT + (32 * (dt0 + t) + r) * P + 32 * s + 16 * hh);
                accf[t] = MFMA32(af, bk, accf[t]); accb[t] = MFMA32(ab, bk, accb[t]); }
        }
        float* of = F.STF + (size_t)item * HD * HD; float* ob = F.STB + (size_t)item * HD * HD;
#pragma unroll
        for (int t = 0; t < 2; ++t)
#pragma unroll
            for (int reg = 0; reg < 16; ++reg) { const int e = 32 * et + (reg & 3) + 8 * (reg >> 2) + 4 * hh, d = 32 * (dt0 + t) + r; of[e * HD + d] = accf[t][reg]; ob[e * HD + d] = accb[t][reg]; }
        __syncthreads();
    }
}
__device__ __forceinline__ void p4_r3_mfma(Frame& F) {
    constexpr int P = 264;
    LAS unsigned char* VT = F.lds + RING_OFF; LAS float* XS = (LAS float*)(F.lds + RING_OFF + 128 * P);
    const int w = F.wave, qt = w & 3, eh = w >> 2;
    const float scale = 0.08838834764831845f, L2E = 1.4426950408889634f;
    for (int item = F.vcu; item < BATCH * NH * NCH; item += F.G) {
        int tid = F.tid; asm volatile("" : "+v"(tid)); const int lane = tid & 63, r = lane & 31, hh = lane >> 5;
        const int bh = item >> 5, c = item & 31, b = bh >> 3, h = bh & 7; const size_t row0 = (size_t)b * SEQ + c * CH;
        const bf16* Qg = HP(COL_QR, h) + row0 * HD; const bf16* Kg = HP(COL_KR, h) + row0 * HD;
        const bf16* Vg = HP(COL_VR, h) + row0 * HD; const bf16* Gg = HP(COL_GR, h) + row0 * HD;
        const float lgf2 = -__expf(F.decf[h]) * L2E, lgb2 = -__expf(F.decb[h]) * L2E;
        {
            const int jg = tid & 31, dc = tid >> 5; v4u vr[4];
#pragma unroll
            for (int q = 0; q < 4; ++q) vr[q] = *(const GAS v4u*)(Vg + (size_t)(4 * jg + q) * HD + 8 * dc);
#pragma unroll
            for (int i = 0; i < 8; ++i) { u32x2 vv; vv.x = elt16(vr[0], i) | (elt16(vr[1], i) << 16); vv.y = elt16(vr[2], i) | (elt16(vr[3], i) << 16); *(LAS u32x2*)(VT + (8 * dc + i) * P + 8 * jg) = vv; }
        }
        const int iq = 32 * qt + r;
        bf16x8 qf[8];
#pragma unroll
        for (int s = 0; s < 8; ++s) qf[s] = *(const GAS bf16x8*)(Qg + (size_t)iq * HD + 64 * hh + 8 * s);
        f32x16 st[4];
#pragma unroll
        for (int kt = 0; kt < 4; ++kt) { st[kt] = zero16();
#pragma unroll
            for (int s = 0; s < 8; ++s) { const bf16x8 kf = *(const GAS bf16x8*)(Kg + (size_t)(32 * kt + r) * HD + 64 * hh + 8 * s); st[kt] = MFMA32(kf, qf[s], st[kt]); }
            __builtin_amdgcn_sched_barrier(0); }
        bf16x8 pf[4][2];
#pragma unroll
        for (int kt = 0; kt < 4; ++kt) {
#pragma unroll
            for (int reg = 0; reg < 16; ++reg) { const int j = 32 * kt + (reg & 3) + 8 * (reg >> 2) + 4 * hh, dj = iq - j;
                const float dec = __builtin_amdgcn_exp2f(dj >= 0 ? lgf2 * (float)dj : lgb2 * (float)(-dj)); st[kt][reg] *= scale * dec; }
            pf[kt][0] = pack8(st[kt], 0); pf[kt][1] = pack8(st[kt], 1); }
        const float ff = __builtin_amdgcn_exp2f(lgf2 * (float)(iq + 1)) * scale, fb = __builtin_amdgcn_exp2f(lgb2 * (float)(CH - iq)) * scale;
        f32x16 acc[2];
#pragma unroll
        for (int t = 0; t < 2; ++t) { const int e = 32 * (2 * eh + t) + r; f32x16 a1 = zero16(), a2 = zero16();
            const bf16* s1 = sbf_row(F.PROJ, 2 * item, e) + 64 * hh; const bf16* s2 = sbf_row(F.PROJ, 2 * item + 1, e) + 64 * hh;
#pragma unroll
            for (int s = 0; s < 8; ++s) { a1 = MFMA32(*(const GAS bf16x8*)(s1 + 8 * s), qf[s], a1); a2 = MFMA32(*(const GAS bf16x8*)(s2 + 8 * s), qf[s], a2); }
#pragma unroll
            for (int reg = 0; reg < 16; ++reg) acc[t][reg] = ff * a1[reg] + fb * a2[reg];
            __builtin_amdgcn_sched_barrier(0); }
        __syncthreads();
#pragma unroll
        for (int t = 0; t < 2; ++t) { const LAS unsigned char* vrow = VT + (32 * (2 * eh + t) + r) * P + 8 * hh;
#pragma unroll
            for (int kt = 0; kt < 4; ++kt)
#pragma unroll
                for (int sp = 0; sp < 2; ++sp) { const u32x2 lo = *(const LAS u32x2*)(vrow + 2 * (32 * kt + 16 * sp)), hi = *(const LAS u32x2*)(vrow + 2 * (32 * kt + 16 * sp + 8));
                    acc[t] = MFMA32(cat8(lo, hi), pf[kt][sp], acc[t]); } }
        float ssq = 0.f;
#pragma unroll
        for (int t = 0; t < 2; ++t)
#pragma unroll
            for (int reg = 0; reg < 16; ++reg) ssq += acc[t][reg] * acc[t][reg];
        ssq += __shfl_xor(ssq, 32);
        if (hh == 0) XS[w * 32 + r] = ssq;
        __syncthreads();
        const float rms = 1.0f / sqrtf((XS[w * 32 + r] + XS[(w ^ 4) * 32 + r]) * (1.0f / HD) + EPS);
#pragma unroll
        for (int t = 0; t < 2; ++t)
#pragma unroll
            for (int g = 0; g < 4; ++g) { const int e = 32 * (2 * eh + t) + 8 * g + 4 * hh;
                const u32x2 gg = *(const GAS u32x2*)(Gg + (size_t)iq * HD + e); const f32x4 wn = *(const GAS f32x4*)(F.w_retn + h * HD + e);
                const float g0 = bflo(gg.x), g1 = bfhi(gg.x), g2 = bflo(gg.y), g3 = bfhi(gg.y);
                const float o0 = acc[t][4 * g] * rms * wn.x * (g0 / (1.0f + __expf(-g0))), o1 = acc[t][4 * g + 1] * rms * wn.y * (g1 / (1.0f + __expf(-g1)));
                const float o2 = acc[t][4 * g + 2] * rms * wn.z * (g2 / (1.0f + __expf(-g2))), o3 = acc[t][4 * g + 3] * rms * wn.w * (g3 / (1.0f + __expf(-g3)));
                u32x2 o; o.x = cvtpk(o0, o1); o.y = cvtpk(o2, o3); *(GAS u32x2*)(F.MIX + (row0 + iq) * D + DATT + h * HD + e) = o; }
        __syncthreads();
    }
}
__device__ __forceinline__ void p2_attn_mfma(Frame& F) {
    constexpr int PK = 272, PV = 520;
    LAS unsigned char* KI = F.lds + RING_OFF; LAS unsigned char* VT = KI + 256 * PK;
    static_assert(256 * PK + 128 * PV <= RING_BYTES, "attention images fit the ring");
    const int w = F.wave, qt = w & 3, eh = w >> 2;
    const float scale = 0.08838834764831845f, L2E = 1.4426950408889634f;
    const int NU = BATCH * NH * 96;
    for (int n = F.vcu; n < NU; n += F.G) {
        int tid = F.tid; asm volatile("" : "+v"(tid)); const int lane = tid & 63, r = lane & 31, hh = lane >> 5;
        unsigned long long t0 = 0, t1 = 0; T_START(t0);
        int bh, u;
        if (F.G == 256) { const int it = n >> 8; bh = (F.vcu >> 5) + 8 * (it / 3); u = (F.vcu & 31) + 32 * (it % 3); }
        else { bh = n / 96; u = n % 96; }
        const int p = u >> 5, idx = u & 31, sh = 2 * p, dil = 1 << sh, nblk = 32 >> sh, cls = idx / nblk, l0 = 128 * (idx % nblk), L = SEQ >> sh;
        const int b = bh >> 3, h = bh & 7;
        const bf16* Qb = HP(COL_QA, h) + (size_t)(b * SEQ) * HD; const bf16* Kb = HP(COL_KA, h) + (size_t)(b * SEQ) * HD; const bf16* Vb = HP(COL_VA, h) + (size_t)(b * SEQ) * HD;
#pragma unroll
        for (int it = 0; it < 8; ++it) { const int pc = tid + 512 * it, row = pc >> 4, ch = pc & 15, lk = l0 - 64 + row;
            const int lkc = lk < 0 ? 0 : (lk >= L ? L - 1 : lk);
            *(LAS v4u*)(KI + row * PK + 16 * ch) = *(const GAS v4u*)(Kb + (size_t)(lkc * dil + cls) * HD + 8 * ch); }
#pragma unroll
        for (int it = 0; it < 2; ++it) { const int bid = tid + 512 * it, jg = bid & 63, dc = bid >> 6; v4u vr[4];
#pragma unroll
            for (int q = 0; q < 4; ++q) { const int lk = l0 - 64 + 4 * jg + q, lkc = lk < 0 ? 0 : (lk >= L ? L - 1 : lk); vr[q] = *(const GAS v4u*)(Vb + (size_t)(lkc * dil + cls) * HD + 8 * dc); }
#pragma unroll
            for (int i = 0; i < 8; ++i) { u32x2 vv; vv.x = elt16(vr[0], i) | (elt16(vr[1], i) << 16); vv.y = elt16(vr[2], i) | (elt16(vr[3], i) << 16); *(LAS u32x2*)(VT + (8 * dc + i) * PV + 8 * jg) = vv; } }
        const int lq = l0 + 32 * qt + r;
        const size_t qrow = (size_t)(lq * dil + cls);
        bf16x8 qf[8];
#pragma unroll
        for (int s = 0; s < 8; ++s) qf[s] = *(const GAS bf16x8*)(Qb + qrow * HD + 64 * hh + 8 * s);
        __syncthreads();
        if (PROBE_T == 1) T_ADD(F.tA, t0);
        T_START(t1);
        f32x16 st[5];
#pragma unroll
        for (int kt = 0; kt < 5; ++kt) { st[kt] = zero16(); const LAS unsigned char* krow = KI + (32 * qt + 32 * kt + r) * PK + 128 * hh;
#pragma unroll
            for (int s = 0; s < 8; ++s) st[kt] = MFMA32(*(const LAS bf16x8*)(krow + 16 * s), qf[s], st[kt]);
            __builtin_amdgcn_sched_barrier(0); }
        const float slope2 = exp2f(-(float)(h + 1)) * (float)dil * L2E, sc2 = scale * L2E;
        float mx = -INFINITY;
#pragma unroll
        for (int kt = 0; kt < 5; ++kt)
#pragma unroll
            for (int reg = 0; reg < 16; ++reg) { const int jl = 32 * kt + (reg & 3) + 8 * (reg >> 2) + 4 * hh, dist = r + 64 - jl, ad = dist < 0 ? -dist : dist, lk = l0 + 32 * qt - 64 + jl;
                const bool valid = (ad <= 64) && (lk >= 0) && (lk < L);
                const float s2 = valid ? st[kt][reg] * sc2 - slope2 * (float)ad : -INFINITY; st[kt][reg] = s2; mx = fmaxf(mx, s2); }
        mx = fmaxf(mx, __shfl_xor(mx, 32));
        if (PROBE_T == 3) { T_ADD(F.tA, t1); T_START(t1); }
        float l = 0.f;
#pragma unroll
        for (int kt = 0; kt < 5; ++kt)
#pragma unroll
            for (int reg = 0; reg < 16; ++reg) { const float e = __builtin_amdgcn_exp2f(st[kt][reg] - mx); st[kt][reg] = e; l += e; }
        l += __shfl_xor(l, 32);
        f32x16 acc[2]; acc[0] = zero16(); acc[1] = zero16();
#pragma unroll
        for (int kt = 0; kt < 5; ++kt)
#pragma unroll
            for (int sp = 0; sp < 2; ++sp) { const bf16x8 pfr = pack8(st[kt], sp);
#pragma unroll
                for (int t = 0; t < 2; ++t) { const LAS unsigned char* vrow = VT + (32 * (2 * eh + t) + r) * PV + 2 * (32 * qt + 32 * kt + 16 * sp + 4 * hh);
                    const u32x2 lo = *(const LAS u32x2*)(vrow), hi = *(const LAS u32x2*)(vrow + 16);
                    acc[t] = MFMA32(cat8(lo, hi), pfr, acc[t]); }
                __builtin_amdgcn_sched_barrier(0); }
        const float il = 1.0f / l; const size_t orow = (size_t)b * SEQ + qrow;
        bf16* ob = (p == 0) ? (F.MIX + orow * D + h * HD) : (F.XN + (size_t)(p - 1) * M * DATT + orow * DATT + h * HD);
#pragma unroll
        for (int t = 0; t < 2; ++t)
#pragma unroll
            for (int g = 0; g < 4; ++g) { const int e = 32 * (2 * eh + t) + 8 * g + 4 * hh; u32x2 o; o.x = cvtpk(acc[t][4 * g] * il, acc[t][4 * g + 1] * il); o.y = cvtpk(acc[t][4 * g + 2] * il, acc[t][4 * g + 3] * il); *(GAS u32x2*)(ob + e) = o; }
        if (eh == 0 && hh == 0) F.LSE[(size_t)p * M * NH + orow * NH + h] = (mx + __log2f(l)) * 0.6931471805599453f;
        __syncthreads();
        if (PROBE_T == 1) T_ADD(F.tB, t0);
        if (PROBE_T == 3) T_ADD(F.tB, t1);
    }
}
__device__ __forceinline__ void p3_merge(Frame& F) {
    const int gt = F.vcu * (NWAVES * 64) + F.tid, NT = F.G * NWAVES * 64;
    for (int idx = gt; idx < M * (DATT / 8); idx += NT) { const int row = idx >> 7, c8 = idx & 127, h = c8 >> 4;
        const float l1 = F.LSE[(size_t)row * NH + h], l4 = F.LSE[(size_t)M * NH + (size_t)row * NH + h], l16 = F.LSE[(size_t)2 * M * NH + (size_t)row * NH + h];
        const float mx = fmaxf(l1, fmaxf(l4, l16)); float w1 = __expf(l1 - mx), w4 = __expf(l4 - mx), w16 = __expf(l16 - mx); const float inv = 1.0f / (w1 + w4 + w16); w1 *= inv; w4 *= inv; w16 *= inv;
        GAS v4u* pm = (GAS v4u*)(F.MIX + (size_t)row * D + 8 * c8);
        const v4u a = *pm, bq = *(const GAS v4u*)(F.XN + (size_t)row * DATT + 8 * c8), cq = *(const GAS v4u*)(F.XN + (size_t)M * DATT + (size_t)row * DATT + 8 * c8);
        v4u o;
#pragma unroll
        for (int k = 0; k < 4; ++k) o[k] = cvtpk(w1 * bflo(a[k]) + w4 * bflo(bq[k]) + w16 * bflo(cq[k]), w1 * bfhi(a[k]) + w4 * bfhi(bq[k]) + w16 * bfhi(cq[k]));
        *pm = o; }
}
typedef short v4i16_t __attribute__((ext_vector_type(4)));
__device__ __forceinline__ unsigned swz16(unsigned row) { return ((row & 3u) << 2) | ((row >> 2) & 3u); }
struct AttnUnit { int b, h, p, dil, cls, l0, L; const bf16 *Qb, *Kb, *Vb; };
__device__ __forceinline__ AttnUnit attn_unit(const Frame& F, int n) {
    int bh, u;
    if (F.G == 256) { const int it = n >> 8; bh = (F.vcu >> 5) + 8 * (it / 3); u = (F.vcu & 31) + 32 * (it % 3); }
    else { bh = n / 96; u = n % 96; }
    AttnUnit U; U.p = u >> 5; const int idx = u & 31, sh = 2 * U.p, nblk = 32 >> sh; U.dil = 1 << sh; U.cls = idx / nblk; U.l0 = 128 * (idx % nblk); U.L = SEQ >> sh; U.b = bh >> 3; U.h = bh & 7;
    U.Qb = HP(COL_QA, U.h) + (size_t)(U.b * SEQ) * HD; U.Kb = HP(COL_KA, U.h) + (size_t)(U.b * SEQ) * HD; U.Vb = HP(COL_VA, U.h) + (size_t)(U.b * SEQ) * HD;
    return U;
}
__device__ __forceinline__ void attn_dma(LAS unsigned char* img, const bf16* Xb, const AttnUnit& U, int w, int lane) {
#pragma unroll
    for (int i = 0; i < 8; ++i) { const int pc = 8 * w + i, row = 4 * pc + (lane >> 4), ch = (lane & 15) ^ (int)swz16((unsigned)row);
        int lk = U.l0 - 64 + row; lk = lk < 0 ? 0 : (lk >= U.L ? U.L - 1 : lk);
        __builtin_amdgcn_global_load_lds((const unsigned*)(Xb + (size_t)(lk * U.dil + U.cls) * HD + 8 * ch), (LAS unsigned*)(img + pc * 1024), 16, 0, 0); }
}
__device__ __forceinline__ void p2_attn_dma(Frame& F) {
    LAS unsigned char* KI = F.lds + RING_OFF; LAS unsigned char* VI = KI + 65536;
    const int w = F.wave, qt = w & 3, eh = w >> 2;
    const float scale = 0.08838834764831845f, L2E = 1.4426950408889634f;
    const int NU = BATCH * NH * 96;
    int n = F.vcu; if (n >= NU) return;
    AttnUnit U = attn_unit(F, n);
    bf16x8 qf[8];
    { int tid = F.tid; asm volatile("" : "+v"(tid)); const int lane = tid & 63, r = lane & 31, hh = lane >> 5;
      attn_dma(KI, U.Kb, U, w, lane);
      const size_t qrow = (size_t)((U.l0 + 32 * qt + r) * U.dil + U.cls);
#pragma unroll
      for (int s = 0; s < 8; ++s) qf[s] = *(const GAS bf16x8*)(U.Qb + qrow * HD + 16 * s + 8 * hh); }
    for (;;) {
        int tid = F.tid; asm volatile("" : "+v"(tid)); const int lane = tid & 63, r = lane & 31, hh = lane >> 5;
        unsigned long long t0 = 0, t1 = 0; T_START(t0);
        __syncthreads();
        if (PROBE_T == 1) T_ADD(F.tA, t0);
        T_START(t1);
        attn_dma(VI, U.Vb, U, w, lane);
        const int lq0 = U.l0 + 32 * qt;
        f32x16 st[5];
        const unsigned swr = swz16((unsigned)r);
#pragma unroll
        for (int kt = 0; kt < 5; ++kt) { st[kt] = zero16(); const int lk0 = lq0 - 64 + 32 * kt;
            if (lk0 >= 0 && lk0 < U.L) { const LAS unsigned char* krow = KI + (32 * (qt + kt) + r) * 256;
#pragma unroll
                for (int s = 0; s < 8; ++s) st[kt] = MFMA32(*(const LAS bf16x8*)(krow + 16 * ((unsigned)(2 * s + hh) ^ swr)), qf[s], st[kt]); }
            __builtin_amdgcn_sched_barrier(0); }
        const float slope2 = exp2f(-(float)(U.h + 1)) * (float)U.dil * L2E, sc2 = scale * L2E, frr = (float)(r - 4 * hh);
        float mx = -INFINITY;
#pragma unroll
        for (int kt = 0; kt < 5; ++kt) { const int lk0 = lq0 - 64 + 32 * kt; const bool tin = (lk0 >= 0 && lk0 < U.L);
#pragma unroll
            for (int reg = 0; reg < 16; ++reg) { const float ad = fabsf(frr + (float)(64 - 32 * kt - ((reg & 3) + 8 * (reg >> 2))));
                float s2 = st[kt][reg] * sc2 - slope2 * ad;
                if (kt == 0 || kt == 4) s2 = (ad <= 64.0f) ? s2 : -INFINITY;
                s2 = tin ? s2 : -INFINITY;
                st[kt][reg] = s2; mx = fmaxf(mx, s2); } }
        mx = fmaxf(mx, __shfl_xor(mx, 32));
        if (PROBE_T == 3) { T_ADD(F.tA, t1); T_START(t1); }
        __syncthreads();
        const int nn = n + F.G; const bool has_next = nn < NU;
        AttnUnit Un = U; if (has_next) { Un = attn_unit(F, nn); attn_dma(KI, Un.Kb, Un, w, lane); }
        float l = 0.f;
#pragma unroll
        for (int kt = 0; kt < 5; ++kt)
#pragma unroll
            for (int reg = 0; reg < 16; ++reg) { const float e = __builtin_amdgcn_exp2f(st[kt][reg] - mx); st[kt][reg] = e; l += e; }
        l += __shfl_xor(l, 32);
        f32x16 acc[2]; acc[0] = zero16(); acc[1] = zero16();
        const int q4 = (lane & 15) >> 2, pp = lane & 3, blk = (lane >> 4) & 1;
        unsigned voff[2][2][2];
#pragma unroll
        for (int t2 = 0; t2 < 2; ++t2) { const unsigned rl = (unsigned)(4 * hh + 8 * t2 + q4), sw = swz16(rl);
#pragma unroll
            for (int t = 0; t < 2; ++t) { const unsigned chunk = (unsigned)(4 * (2 * eh + t) + 2 * blk + (pp >> 1)); voff[t2][t][0] = 256u * rl + 16u * (chunk ^ sw) + 8u * (unsigned)(pp & 1); voff[t2][t][1] = 0; } }
#pragma unroll
        for (int kt = 0; kt < 5; ++kt) { const int lk0 = lq0 - 64 + 32 * kt;
            if (lk0 >= 0 && lk0 < U.L) {
#pragma unroll
                for (int sp = 0; sp < 2; ++sp) { const bf16x8 pfr = pack8(st[kt], sp); const LAS unsigned char* vb = VI + (32 * (qt + kt) + 16 * sp) * 256;
#pragma unroll
                    for (int t = 0; t < 2; ++t) {
                        const v4i16_t lo = __builtin_amdgcn_ds_read_tr16_b64_v4i16((LAS v4i16_t*)(vb + voff[0][t][0])), hi = __builtin_amdgcn_ds_read_tr16_b64_v4i16((LAS v4i16_t*)(vb + voff[1][t][0]));
                        const bf16x8 vf = __builtin_shufflevector(lo, hi, 0, 1, 2, 3, 4, 5, 6, 7);
                        acc[t] = MFMA32(vf, pfr, acc[t]); } } }
            __builtin_amdgcn_sched_barrier(0); }
        const float il = 1.0f / l; const size_t qrow = (size_t)((lq0 + r) * U.dil + U.cls), orow = (size_t)U.b * SEQ + qrow;
        bf16* ob = (U.p == 0) ? (F.MIX + orow * D + U.h * HD) : (F.XN + (size_t)(U.p - 1) * M * DATT + orow * DATT + U.h * HD);
#pragma unroll
        for (int t = 0; t < 2; ++t)
#pragma unroll
            for (int g = 0; g < 4; ++g) { const int e = 32 * (2 * eh + t) + 8 * g + 4 * hh; u32x2 o; o.x = cvtpk(acc[t][4 * g] * il, acc[t][4 * g + 1] * il); o.y = cvtpk(acc[t][4 * g + 2] * il, acc[t][4 * g + 3] * il); *(GAS u32x2*)(ob + e) = o; }
        if (eh == 0 && hh == 0) F.LSE[(size_t)U.p * M * NH + orow * NH + U.h] = (mx + __log2f(l)) * 0.6931471805599453f;
        if (PROBE_T == 1) T_ADD(F.tB, t0);
        if (PROBE_T == 3) T_ADD(F.tB, t1);
        if (!has_next) break;
        U = Un; n = nn;
        { const size_t qr2 = (size_t)((U.l0 + 32 * qt + r) * U.dil + U.cls);
#pragma unroll
          for (int s = 0; s < 8; ++s) qf[s] = *(const GAS bf16x8*)(U.Qb + qr2 * HD + 16 * s + 8 * hh); }
    }
    __syncthreads();
}
__device__ __forceinline__ void dma_rows128(LAS unsigned char* img, const bf16* src, int w, int lane) {
#pragma unroll
    for (int i = 0; i < 4; ++i) { const int pc = 4 * w + i, row = 4 * pc + (lane >> 4), ch = (lane & 15) ^ (int)swz16((unsigned)row);
        __builtin_amdgcn_global_load_lds((const unsigned*)(src + (size_t)row * HD + 8 * ch), (LAS unsigned*)(img + pc * 1024), 16, 0, 0); }
}
__device__ __forceinline__ unsigned tr_nat(int lane, int c, int ks, int t2) { const unsigned h = lane >> 5, blk = (lane >> 4) & 1, q = (lane & 15) >> 2, p = lane & 3, row = 16 * ks + 8 * h + 4 * t2 + q;
    return 256u * row + 16u * ((unsigned)(4 * c + 2 * blk + (p >> 1)) ^ swz16(row)) + 8u * (p & 1); }
__device__ __forceinline__ v4i16_t trd(const LAS unsigned char* p) { return __builtin_amdgcn_ds_read_tr16_b64_v4i16((LAS v4i16_t*)p); }
__device__ __forceinline__ void p2_r1_dma(Frame& F) {
    const int w = F.wave, dt = w & 3, et0 = 2 * (w >> 2);
    const float L2E = 1.4426950408889634f;
    const int NI = BATCH * NH * NCH;
    int item = F.vcu; if (item >= NI) return;
    bf16* STFh = (bf16*)F.STF; bf16* STBh = STFh + (size_t)NI * HD * HD;
    { int tid = F.tid; asm volatile("" : "+v"(tid)); const int lane = tid & 63;
      const int bh = item >> 5, c = item & 31, b = bh >> 3, h = bh & 7; const size_t row0 = (size_t)b * SEQ + c * CH;
      dma_rows128(F.lds + RING_OFF, HP(COL_KR, h) + row0 * HD, w, lane); dma_rows128(F.lds + RING_OFF + 32768, HP(COL_VR, h) + row0 * HD, w, lane); }
    for (int k = 0;; ++k) {
        int tid = F.tid; asm volatile("" : "+v"(tid)); const int lane = tid & 63, r = lane & 31, hh = lane >> 5;
        const int bh = item >> 5, h = bh & 7;
        __syncthreads();
        const int nitem = item + F.G; const bool has_next = nitem < NI;
        LAS unsigned char* KI = F.lds + RING_OFF + (k & 1) * 65536; LAS unsigned char* VI = KI + 32768;
        if (has_next) { const int bh2 = nitem >> 5, c2 = nitem & 31, b2 = bh2 >> 3, h2 = bh2 & 7; const size_t row2 = (size_t)b2 * SEQ + c2 * CH; LAS unsigned char* NB = F.lds + RING_OFF + ((k + 1) & 1) * 65536;
            dma_rows128(NB, HP(COL_KR, h2) + row2 * HD, w, lane); dma_rows128(NB + 32768, HP(COL_VR, h2) + row2 * HD, w, lane); }
        const float lgf2 = -__expf(F.decf[h]) * L2E, lgb2 = -__expf(F.decb[h]) * L2E;
        float gfi[8], gbi[8];
#pragma unroll
        for (int q = 0; q < 8; ++q) { gfi[q] = __builtin_amdgcn_exp2f(-lgf2 * (float)q); gbi[q] = __builtin_amdgcn_exp2f(lgb2 * (float)q); }
        f32x16 accf[2], accb[2]; accf[0] = zero16(); accf[1] = zero16(); accb[0] = zero16(); accb[1] = zero16();
#pragma unroll
        for (int s = 0; s < 8; ++s) {
            const v4i16_t klo = trd(KI + tr_nat(lane, dt, s, 0)), khi = trd(KI + tr_nat(lane, dt, s, 1));
            const bf16x8 kf = __builtin_shufflevector(klo, khi, 0, 1, 2, 3, 4, 5, 6, 7);
            const float bfw = __builtin_amdgcn_exp2f(lgf2 * (float)(CH - 1 - 16 * s - 8 * hh)), bbw = __builtin_amdgcn_exp2f(lgb2 * (float)(16 * s + 8 * hh));
#pragma unroll
            for (int t = 0; t < 2; ++t) { const v4i16_t vlo = trd(VI + tr_nat(lane, et0 + t, s, 0)), vhi = trd(VI + tr_nat(lane, et0 + t, s, 1));
                float v[8];
#pragma unroll
                for (int q = 0; q < 4; ++q) { v[q] = __builtin_bit_cast(float, (unsigned)(unsigned short)vlo[q] << 16); v[4 + q] = __builtin_bit_cast(float, (unsigned)(unsigned short)vhi[q] << 16); }
                v4u pf_, pb_;
#pragma unroll
                for (int q = 0; q < 4; ++q) { pf_[q] = cvtpk(v[2 * q] * (bfw * gfi[2 * q]), v[2 * q + 1] * (bfw * gfi[2 * q + 1])); pb_[q] = cvtpk(v[2 * q] * (bbw * gbi[2 * q]), v[2 * q + 1] * (bbw * gbi[2 * q + 1])); }
                accf[t] = MFMA32(kf, __builtin_bit_cast(bf16x8, pf_), accf[t]); accb[t] = MFMA32(kf, __builtin_bit_cast(bf16x8, pb_), accb[t]); }
        }
        bf16* of = STFh + (size_t)item * HD * HD; bf16* ob = STBh + (size_t)item * HD * HD;
#pragma unroll
        for (int t = 0; t < 2; ++t) { const int e = 32 * (et0 + t) + r;
#pragma unroll
            for (int g = 0; g < 4; ++g) { const int d0 = 32 * dt + 8 * g + 4 * hh;
                u32x2 o1; o1.x = cvtpk(accf[t][4 * g], accf[t][4 * g + 1]); o1.y = cvtpk(accf[t][4 * g + 2], accf[t][4 * g + 3]); *(GAS u32x2*)(of + e * HD + d0) = o1;
                u32x2 o2; o2.x = cvtpk(accb[t][4 * g], accb[t][4 * g + 1]); o2.y = cvtpk(accb[t][4 * g + 2], accb[t][4 * g + 3]); *(GAS u32x2*)(ob + e * HD + d0) = o2; } }
        if (!has_next) break;
        item = nitem;
    }
    __syncthreads();
}
__device__ __forceinline__ void p3_scan_bf16(Frame& F) {
    const int gt = F.vcu * (NWAVES * 64) + F.tid, NT = F.G * NWAVES * 64;
    const bf16* STFh = (const bf16*)F.STF; const bf16* STBh = STFh + (size_t)BATCH * NH * NCH * HD * HD;
    for (int idx = gt; idx < 2 * BATCH * NH * 2048; idx += NT) {
        const int dir = idx / (BATCH * NH * 2048), rem = idx % (BATCH * NH * 2048), bh = rem >> 11, q = rem & 2047, h = bh & 7;
        const float g = __expf(-__expf(dir ? F.decb[h] : F.decf[h]) * (float)CH);
        const GAS v4u* base = (const GAS v4u*)(dir ? STBh : STFh) + (size_t)bh * NCH * 2048 + q;
        float s[8];
#pragma unroll
        for (int i = 0; i < 8; ++i) s[i] = 0.f;
#pragma unroll 8
        for (int cc = 0; cc < NCH; ++cc) { const int c = dir ? NCH - 1 - cc : cc; const v4u t = base[(size_t)c * 2048];
            v4u o; o.x = cvtpk(s[0], s[1]); o.y = cvtpk(s[2], s[3]); o.z = cvtpk(s[4], s[5]); o.w = cvtpk(s[6], s[7]);
            *(GAS v4u*)(sbf_row(F.PROJ, 2 * (bh * NCH + c) + dir, q >> 4) + 8 * (q & 15)) = o;
#pragma unroll
            for (int i = 0; i < 4; ++i) { s[2 * i] = s[2 * i] * g + bflo(t[i]); s[2 * i + 1] = s[2 * i + 1] * g + bfhi(t[i]); } }
    }
}
__device__ __forceinline__ void p4_r3_dma(Frame& F) {
    LAS unsigned char* KI = F.lds + RING_OFF; LAS unsigned char* VI = KI + 32768; LAS unsigned char* SFI = KI + 65536; LAS unsigned char* SBI = KI + 98304; LAS float* XS = (LAS float*)(KI + 131072);
    const int w = F.wave, qt = w & 3, eh = w >> 2;
    const float scale = 0.08838834764831845f, L2E = 1.4426950408889634f;
    const int NI = BATCH * NH * NCH;
    int item = F.vcu; if (item >= NI) return;
    bf16x8 qf[8];
    { int tid = F.tid; asm volatile("" : "+v"(tid)); const int lane = tid & 63, r = lane & 31, hh = lane >> 5;
      const int bh = item >> 5, c = item & 31, b = bh >> 3, h = bh & 7; const size_t row0 = (size_t)b * SEQ + c * CH;
      dma_rows128(KI, HP(COL_KR, h) + row0 * HD, w, lane); dma_rows128(SFI, sbf_row(F.PROJ, 2 * item, 0), w, lane); dma_rows128(SBI, sbf_row(F.PROJ, 2 * item + 1, 0), w, lane);
      const bf16* Qg = HP(COL_QR, h) + row0 * HD;
#pragma unroll
      for (int s = 0; s < 8; ++s) qf[s] = *(const GAS bf16x8*)(Qg + (size_t)(32 * qt + r) * HD + 16 * s + 8 * hh); }
    for (;;) {
        int tid = F.tid; asm volatile("" : "+v"(tid)); const int lane = tid & 63, r = lane & 31, hh = lane >> 5;
        const int bh = item >> 5, c = item & 31, b = bh >> 3, h = bh & 7; const size_t row0 = (size_t)b * SEQ + c * CH;
        const bf16* Gg = HP(COL_GR, h) + row0 * HD;
        const float lgf2 = -__expf(F.decf[h]) * L2E, lgb2 = -__expf(F.decb[h]) * L2E;
        const int iq = 32 * qt + r;
        __syncthreads();
        dma_rows128(VI, HP(COL_VR, h) + row0 * HD, w, lane);
        u32x2 gg[2][4];
        if (tid < 32) ((LAS f32x4*)(XS + 256))[tid] = *(const GAS f32x4*)(F.w_retn + h * HD + 4 * tid);
#pragma unroll
        for (int t = 0; t < 2; ++t)
#pragma unroll
            for (int g = 0; g < 4; ++g) gg[t][g] = *(const GAS u32x2*)(Gg + (size_t)iq * HD + 32 * (2 * eh + t) + 8 * g + 4 * hh);
        const unsigned swr = swz16((unsigned)r);
        f32x16 st[4];
#pragma unroll
        for (int kt = 0; kt < 4; ++kt) { st[kt] = zero16(); const LAS unsigned char* krow = KI + (32 * kt + r) * 256;
#pragma unroll
            for (int s = 0; s < 8; ++s) st[kt] = MFMA32(*(const LAS bf16x8*)(krow + 16 * ((unsigned)(2 * s + hh) ^ swr)), qf[s], st[kt]);
            __builtin_amdgcn_sched_barrier(0); }
        bf16x8 pf[4][2];
#pragma unroll
        for (int kt = 0; kt < 4; ++kt) {
#pragma unroll
            for (int reg = 0; reg < 16; ++reg) { const int j = 32 * kt + (reg & 3) + 8 * (reg >> 2) + 4 * hh, dj = iq - j;
                const float dec = __builtin_amdgcn_exp2f(dj >= 0 ? lgf2 * (float)dj : lgb2 * (float)(-dj)); st[kt][reg] *= scale * dec; }
            pf[kt][0] = pack8(st[kt], 0); pf[kt][1] = pack8(st[kt], 1); }
        const float ff = __builtin_amdgcn_exp2f(lgf2 * (float)(iq + 1)) * scale, fb = __builtin_amdgcn_exp2f(lgb2 * (float)(CH - iq)) * scale;
        f32x16 acc[2];
#pragma unroll
        for (int t = 0; t < 2; ++t) { f32x16 a1 = zero16(), a2 = zero16(); const int erow = (32 * (2 * eh + t) + r) * 256;
#pragma unroll
            for (int s = 0; s < 8; ++s) { const unsigned co = 16 * ((unsigned)(2 * s + hh) ^ swr);
                a1 = MFMA32(*(const LAS bf16x8*)(SFI + erow + co), qf[s], a1); a2 = MFMA32(*(const LAS bf16x8*)(SBI + erow + co), qf[s], a2); }
#pragma unroll
            for (int reg = 0; reg < 16; ++reg) acc[t][reg] = ff * a1[reg] + fb * a2[reg];
            __builtin_amdgcn_sched_barrier(0); }
        __syncthreads();
        const int nitem = item + F.G; const bool has_next = nitem < NI;
        if (has_next) { const int bh2 = nitem >> 5, c2 = nitem & 31, b2 = bh2 >> 3, h2 = bh2 & 7; const size_t row2 = (size_t)b2 * SEQ + c2 * CH;
            dma_rows128(KI, HP(COL_KR, h2) + row2 * HD, w, lane); dma_rows128(SFI, sbf_row(F.PROJ, 2 * nitem, 0), w, lane); dma_rows128(SBI, sbf_row(F.PROJ, 2 * nitem + 1, 0), w, lane); }
        { const int q4 = (lane & 15) >> 2, pp = lane & 3, blk = (lane >> 4) & 1; unsigned voff[2][2];
#pragma unroll
          for (int t2 = 0; t2 < 2; ++t2) { const unsigned rl = (unsigned)(4 * hh + 8 * t2 + q4), sw = swz16(rl);
#pragma unroll
              for (int t = 0; t < 2; ++t) voff[t2][t] = 256u * rl + 16u * ((unsigned)(4 * (2 * eh + t) + 2 * blk + (pp >> 1)) ^ sw) + 8u * (unsigned)(pp & 1); }
#pragma unroll
          for (int kt = 0; kt < 4; ++kt) {
#pragma unroll
              for (int sp = 0; sp < 2; ++sp) { const LAS unsigned char* vb = VI + (32 * kt + 16 * sp) * 256;
#pragma unroll
                  for (int t = 0; t < 2; ++t) { const v4i16_t lo = trd(vb + voff[0][t]), hi = trd(vb + voff[1][t]);
                      acc[t] = MFMA32(__builtin_shufflevector(lo, hi, 0, 1, 2, 3, 4, 5, 6, 7), pf[kt][sp], acc[t]); } }
              __builtin_amdgcn_sched_barrier(0); } }
        float ssq = 0.f;
#pragma unroll
        for (int t = 0; t < 2; ++t)
#pragma unroll
            for (int reg = 0; reg < 16; ++reg) ssq += acc[t][reg] * acc[t][reg];
        ssq += __shfl_xor(ssq, 32);
        if (hh == 0) XS[w * 32 + r] = ssq;
        asm volatile("s_waitcnt lgkmcnt(0)" ::: "memory"); __builtin_amdgcn_s_barrier(); asm volatile("" ::: "memory");
        const float rms = 1.0f / sqrtf((XS[w * 32 + r] + XS[(w ^ 4) * 32 + r]) * (1.0f / HD) + EPS);
#pragma unroll
        for (int t = 0; t < 2; ++t)
#pragma unroll
            for (int g = 0; g < 4; ++g) { const int e = 32 * (2 * eh + t) + 8 * g + 4 * hh; const f32x4 wn = *(const LAS f32x4*)(XS + 256 + e);
                const float g0 = bflo(gg[t][g].x), g1 = bfhi(gg[t][g].x), g2 = bflo(gg[t][g].y), g3 = bfhi(gg[t][g].y);
                const float o0 = acc[t][4 * g] * rms * wn.x * (g0 / (1.0f + __expf(-g0))), o1 = acc[t][4 * g + 1] * rms * wn.y * (g1 / (1.0f + __expf(-g1)));
                const float o2 = acc[t][4 * g + 2] * rms * wn.z * (g2 / (1.0f + __expf(-g2))), o3 = acc[t][4 * g + 3] * rms * wn.w * (g3 / (1.0f + __expf(-g3)));
                u32x2 o; o.x = cvtpk(o0, o1); o.y = cvtpk(o2, o3); *(GAS u32x2*)(F.MIX + (row0 + iq) * D + DATT + h * HD + e) = o; }
        if (!has_next) break;
        item = nitem;
        { const int bh2 = item >> 5, c2 = item & 31, b2 = bh2 >> 3, h2 = bh2 & 7; const bf16* Qg = HP(COL_QR, h2) + ((size_t)b2 * SEQ + c2 * CH) * HD;
#pragma unroll
          for (int s = 0; s < 8; ++s) qf[s] = *(const GAS bf16x8*)(Qg + (size_t)(32 * qt + r) * HD + 16 * s + 8 * hh); }
    }
    __syncthreads();
}
struct Args { const float* in[12]; float* out; unsigned char* ws; int ph_lo, ph_hi, li, pad; };
__global__ void __launch_bounds__(NWAVES * 64, 2) mk_fwd(Args args) {
    extern __shared__ __attribute__((aligned(16))) unsigned char lds[];
    Frame F;
    F.lds = (LAS unsigned char*)lds;
    F.MISC = (volatile LAS unsigned*)(F.lds + MISC_OFF);
    F.tid = threadIdx.x; F.lane = F.tid & 63; F.wave = __builtin_amdgcn_readfirstlane(F.tid >> 6);
    F.G = gridDim.x; { const int bx = blockIdx.x; F.vcu = (F.G % 8 == 0) ? (bx % 8) * (F.G / 8) + bx / 8 : bx; }
    unsigned char* ws = args.ws;
    F.ctl = (gu32*)(ws + WS_CTL);
    F.x = args.in[0]; F.w_mix = args.in[1]; F.w_in = args.in[2]; F.decf = args.in[3]; F.decb = args.in[4]; F.w_retn = args.in[5]; F.w_out = args.in[6];
    F.w_ffn = args.in[7]; F.w_gate = args.in[8]; F.w_up = args.in[9]; F.w_down = args.in[10]; F.w_fin = args.in[11]; F.out = args.out;
    F.Win_t = (bf16*)(ws + WS_WIN); F.Wout_t = (bf16*)(ws + WS_WOUT); F.Wgu_t = (bf16*)(ws + WS_WGU); F.Wdn_t = (bf16*)(ws + WS_WDN);
    F.XN = (bf16*)(ws + WS_XN); F.PROJ = (bf16*)(ws + WS_PROJ); F.MIX = (bf16*)(ws + WS_MIX); F.ACT = (bf16*)(ws + WS_PROJ);
    F.STF = args.out; F.STB = args.out + ST_HALF; F.SS1 = (float*)(ws + WS_CTL + CTL_SS1); F.LSE = (float*)(ws + WS_LSE);
    F.tA = 0; F.tB = 0;
    for (int u = F.tid; u < (LDS_BYTES - LDSCTL_OFF) / 4; u += NWAVES * 64) ((LAS unsigned*)(F.lds + LDSCTL_OFF))[u] = 0u;
    __syncthreads();
    XcdBarrier bar; bar.bar = (unsigned*)(F.ctl + CW_BAR); bar.x = 0; bar.st = nullptr;
    if (N_LAUNCHES != PER_PHASE) bar = xcd_barrier_post((unsigned*)(F.ctl + CW_BAR), F.MISC + 8);
#define GRID_BAR(seam) do { if (N_LAUNCHES == PER_PHASE) { if (F.tid == 0) __hip_atomic_store(F.ctl + CW_TMO, 0xBADBA0u | (unsigned)(seam), RLX_AGENT); } else { xcd_barrier(bar); } } while (0)
    const int lo = args.ph_lo, hi = args.ph_hi;
#define IN(k) (lo <= (k) && (k) < hi)
#define BOTH(k) (IN(k) && IN((k) + 1))

#define REP(k) (((PROBE_REPEAT) >> (k)) & 1)
    if (IN(0)) { p0_prologue(F); if (REP(0)) p0_prologue(F); if (BOTH(0)) GRID_BAR(0); }
    if (N_LAUNCHES != PER_PHASE && lo == 0 && hi > 1) {
        unsigned pre = 0;
        for (unsigned j = 0; j < bar.x; ++j) pre += xb_ld(&bar.bar[XB_XCNT(j)]);
        F.vcu = (int)(pre + F.MISC[10]);
    }
    if (IN(1)) {
        pg8::Gemm g{F.XN, F.Win_t, M, DIN, D}; pg8::StaticOrder S; S.init(M, DIN, F.G, (int)blockIdx.x);
        pg8::EpiHeads E{F.PROJ, M};
        for (int rep = 0; rep <= REP(1); ++rep) pg8::gemm_phase<pg8::EpiHeads, pg8::StaticOrder, true, true>(F.lds + RING_OFF, g, S, E);
        if (BOTH(1)) GRID_BAR(1);
    }
    if (IN(2)) {
        for (int rep = 0; rep <= REP(2); ++rep) {
#if ATTN_NAIVE
        p2_attn_naive(F); __syncthreads();
#elif ATTN_V1
        p2_attn_mfma(F);
#else
        p2_attn_dma(F);
#endif
#if R1_NAIVE
        p2_r1_naive(F);
#elif R1_V1
        p2_r1_mfma(F);
#else
        { unsigned long long tR1 = 0; T_START(tR1); p2_r1_dma(F); if (PROBE_T == 2) T_ADD(F.tA, tR1); }
#endif
        }
        if (BOTH(2)) GRID_BAR(2); }
#if R1_NAIVE || R1_V1
#define P3_SCAN p3_scan
#else
#define P3_SCAN p3_scan_bf16
#endif
    if (IN(3)) { P3_SCAN(F); if (REP(3)) P3_SCAN(F);
#if !ATTN_NAIVE
        p3_merge(F);
#endif
        if (BOTH(3)) GRID_BAR(3); }
    if (IN(4)) {
        for (int rep = 0; rep <= REP(4); ++rep) {
#if R3_NAIVE
        p4_r3_naive(F);
#elif R3_V1
        p4_r3_mfma(F);
#else
        { unsigned long long tR3 = 0; T_START(tR3); p4_r3_dma(F); if (PROBE_T == 2) T_ADD(F.tB, tR3); }
#endif
        }
        if (BOTH(4)) GRID_BAR(4); }
    if (IN(5)) {
        pg8::Gemm g{F.MIX, F.Wout_t, M, D, D}; pg8::StaticOrder S; S.init(M, D, F.G, (int)blockIdx.x);
        pg8::EpiResid E{F.x, F.out, F.XN, F.SS1, D};
        pg8::gemm_phase<pg8::EpiResid, pg8::StaticOrder, true, true>(F.lds + RING_OFF, g, S, E);
        if (REP(5)) { pg8::EpiResid E2{F.x, F.out, F.XN, nullptr, D}; pg8::gemm_phase<pg8::EpiResid, pg8::StaticOrder, true, true>(F.lds + RING_OFF, g, S, E2); }
        if (BOTH(5)) GRID_BAR(5);
    }
    if (IN(6)) {
        pg8::Gemm g{F.XN, F.Wgu_t, M, NGU, D}; pg8::StaticOrder S; S.init(M, NGU, F.G, (int)blockIdx.x);
        pg8::EpiSwiGLU E{F.ACT, DFF, F.SS1, 1.0f / D, EPS};
        for (int rep = 0; rep <= REP(6); ++rep) pg8::gemm_phase<pg8::EpiSwiGLU, pg8::StaticOrder, true, true>(F.lds + RING_OFF, g, S, E);
        if (BOTH(6)) GRID_BAR(6);
    }
    if (IN(7)) {
        pg8::Gemm g{F.ACT, F.Wdn_t, M, D, DFF}; pg8::StaticOrder S; S.init(M, D, F.G, (int)blockIdx.x);
        if (REP(7)) { pg8::EpiNull E0{}; pg8::gemm_phase<pg8::EpiNull, pg8::StaticOrder, true, true>(F.lds + RING_OFF, g, S, E0); }
        pg8::EpiResid E{F.out, F.out, nullptr, nullptr, D};
        pg8::gemm_phase<pg8::EpiResid, pg8::StaticOrder, true, true>(F.lds + RING_OFF, g, S, E);
        if (BOTH(7)) GRID_BAR(7);
    }
    if (IN(8)) { if (REP(8)) p8_final(F, true); p8_final(F, false); }
#if PROBE_T
    if (blockIdx.x == PROBE_BLOCK && F.tid == 0) {
        const unsigned long long t0 = RT(), span = (unsigned long long)PROBE_MULT * (PROBE_USE_B ? F.tB : F.tA);
        while (RT() - t0 < span) __builtin_amdgcn_s_sleep(8);
    }
#endif
#undef REP
#undef IN
#undef BOTH
}

extern "C" void kernel_launch(void* const* d_in, const int* in_sizes, int n_in, void* d_out, int out_size, void* d_ws, size_t ws_size, hipStream_t stream) {
    static int grid = 0;
    if (grid == 0) {
        if (n_in != 12 || in_sizes[0] != M * D || out_size != M * D || ws_size < WS_END) { fprintf(stderr, "kernel_launch: shape/workspace mismatch (n_in %d, in0 %d, out %d, ws %zu, need %zu)\n", n_in, n_in > 0 ? in_sizes[0] : -1, out_size, ws_size, (size_t)WS_END); grid = -1; return; }
        int dev = 0, cus = 0, per_cu = 0;
        if (hipGetDevice(&dev) != hipSuccess || hipDeviceGetAttribute(&cus, hipDeviceAttributeMultiprocessorCount, dev) != hipSuccess) { grid = -1; return; }
        if (hipFuncSetAttribute((const void*)mk_fwd, hipFuncAttributeMaxDynamicSharedMemorySize, LDS_BYTES) != hipSuccess) { fprintf(stderr, "kernel_launch: hipFuncSetAttribute failed\n"); grid = -1; return; }
        if (hipOccupancyMaxActiveBlocksPerMultiprocessor(&per_cu, (const void*)mk_fwd, NWAVES * 64, LDS_BYTES) != hipSuccess || per_cu < 1) fprintf(stderr, "kernel_launch: occupancy query reports %d\n", per_cu);
        (void)hipGetLastError();
        grid = cus;
    }
    if (grid < 0) return;
    (void)hipMemsetAsync((char*)d_ws + WS_CTL, 0, CTL_ZERO_BYTES, stream);
    Args a{};
    for (int i = 0; i < 12; ++i) a.in[i] = (const float*)d_in[i];
    a.out = (float*)d_out; a.ws = (unsigned char*)d_ws;
    if (N_LAUNCHES == 1) { a.ph_lo = 0; a.ph_hi = PER_PHASE; a.li = 0; hipLaunchKernelGGL(mk_fwd, dim3(grid), dim3(NWAVES * 64), LDS_BYTES, stream, a); }
    else for (int li = 0; li < PER_PHASE; ++li) { a.ph_lo = li; a.ph_hi = li + 1; a.li = li; hipLaunchKernelGGL(mk_fwd, dim3(grid), dim3(NWAVES * 64), LDS_BYTES, stream, a); }
}
```

```cpp
#include <hip/hip_runtime.h>
#include <cstdio>
#include <cstdint>
namespace pg8 {
#define PG8_LAS __attribute__((address_space(3)))
typedef unsigned short bf16_t;
typedef short bf16x8 __attribute__((ext_vector_type(8)));
typedef float f32x4 __attribute__((ext_vector_type(4)));
typedef unsigned u32x4 __attribute__((ext_vector_type(4)));
constexpr int BM = 256, BK = 64, HALF = 128, HTB = HALF * BK * 2  , STAGE_BYTES = 8 * HTB, NXCD = 8, WGM = 8;

__host__ __device__ __forceinline__ int lds_byte(int r, int c) { const int st = (r >> 4) * 2 + (c >> 5), rr = r & 15, cc = c & 31, ob = rr * 64 + cc * 2; return st * 1024 + (ob ^ (((ob >> 9) & 1) << 5)); }
__host__ __device__ __forceinline__ void stage_rc(int b, int& R, int& C) { const int st = b / 1024, sb = b % 1024, swz = sb ^ (((sb >> 9) & 1) << 5); R = (st >> 1) * 16 + swz / 64; C = (st & 1) * 32 + (swz % 64) / 2; }
__host__ __device__ __forceinline__ int perm32(int rho) { const int n = rho >> 4, i = rho & 15; return 8 * (i >> 2) + 4 * n + (i & 3); }

struct Unit { int pm, pn; };
struct Gemm { const bf16_t* A; const bf16_t* Bt; int M, N, K; };

struct StaticOrder {
    int nM, nN, nwg, G, c;
    __host__ __device__ void init(int M, int N, int G_, int c_) { nM = M / BM; nN = N / BM; nwg = nM * nN; G = G_; c = c_; }
    __host__ __device__ bool next(int i, Unit& u) const {
        const long L = (long)i * G + c; if (L >= nwg) return false;
        int wgid = (int)L; { const int q = nwg / NXCD, r = nwg % NXCD, xcd = wgid % NXCD, off = wgid / NXCD; wgid = (xcd < r ? xcd * (q + 1) : r * (q + 1) + (xcd - r) * q) + off; }
        const int nig = WGM * nN, gid = wgid / nig, fm = gid * WGM, gsz = (nM - fm) < WGM ? (nM - fm) : WGM;
        u.pm = fm + ((wgid % nig) % gsz); u.pn = (wgid % nig) / gsz; return true;
    }
    __device__ __forceinline__ void a_ready(const Unit&) const {}
    __device__ __forceinline__ void done(const Unit&) const {}
};

__device__ __forceinline__ unsigned cvt_pk_bf16(float lo, float hi) { unsigned r; asm volatile("v_cvt_pk_bf16_f32 %0, %1, %2" : "=v"(r) : "v"(lo), "v"(hi)); return r; }
typedef float f32x2 __attribute__((ext_vector_type(2)));
__device__ __forceinline__ f32x2 gelu_pk(f32x2 v) {
    const f32x2 av = __builtin_elementwise_abs(v), d = av * 0.2316418882f + 1.0f;
    f32x2 t; t.x = __builtin_amdgcn_rcpf(d.x); t.y = __builtin_amdgcn_rcpf(d.y);
    f32x2 q = t * 0.5307027145f + (-0.7265760135f); q = q * t + 0.7107068705f; q = q * t + (-0.142248368f); q = q * t + 0.127414796f; q = q * t;
    const f32x2 s = (v * v) * (-0.72134752044f);
    f32x2 e; e.x = __builtin_amdgcn_exp2f(s.x); e.y = __builtin_amdgcn_exp2f(s.y);
    const f32x2 m = v * (q * e), r = v - m;
    f32x2 o; o.x = v.x < 0.f ? m.x : r.x; o.y = v.y < 0.f ? m.y : r.y; return o;
}

template <int ACT  > struct EpiBf16 {
    static constexpr bool PERM = true, AFTER_DRAIN = false; static_assert(ACT == 0 || ACT == 1, "EpiBf16: ACT is 0 (none) or 1 (gelu_pk)");
    bf16_t* O; int ldc; const float* bias; int split_cols; size_t split_stride; float scale0;
    __device__ __forceinline__ void operator()(const f32x4 (&acc)[2][2][4][2], const Unit& u, int wr, int wc, int fr, int fq) const {
        const int row0 = u.pm * BM + wr * 64 + fr; int colt = u.pn * BM; bf16_t* base = O;
        float sc = 1.f; if (split_cols) { const int t = colt / split_cols; base += (size_t)t * split_stride; colt -= t * split_cols; if (t == 0) sc = scale0; }
        const int col0 = colt + wc * 32 + 8 * fq, bcol0 = u.pn * BM + wc * 32 + 8 * fq;
        f32x4 bv[2][2];
#pragma unroll
        for (int bj = 0; bj < 2; ++bj)
#pragma unroll
            for (int n = 0; n < 2; ++n) bv[bj][n] = bias ? *(const f32x4*)(bias + bcol0 + bj * HALF + 4 * n) : (f32x4){0.f, 0.f, 0.f, 0.f};
#pragma unroll
        for (int ai = 0; ai < 2; ++ai)
#pragma unroll
            for (int m = 0; m < 4; ++m) { bf16_t* rowp = base + (size_t)(row0 + ai * HALF + m * 16) * ldc + col0;
#pragma unroll
                for (int bj = 0; bj < 2; ++bj) { f32x4 v0 = acc[ai][bj][m][0] + bv[bj][0], v1 = acc[ai][bj][m][1] + bv[bj][1];
                    if (ACT == 1) { f32x2 a = gelu_pk((f32x2){v0[0], v0[1]}), b = gelu_pk((f32x2){v0[2], v0[3]}), c = gelu_pk((f32x2){v1[0], v1[1]}), d = gelu_pk((f32x2){v1[2], v1[3]});
                        v0 = (f32x4){a.x, a.y, b.x, b.y}; v1 = (f32x4){c.x, c.y, d.x, d.y}; }
                    v0 = v0 * sc; v1 = v1 * sc; u32x4 w; w.x = cvt_pk_bf16(v0[0], v0[1]); w.y = cvt_pk_bf16(v0[2], v0[3]); w.z = cvt_pk_bf16(v1[0], v1[1]); w.w = cvt_pk_bf16(v1[2], v1[3]);
                    *(u32x4*)(rowp + bj * HALF) = w; } }
    }
};
struct EpiResid {
    static constexpr bool PERM = true, AFTER_DRAIN = false;
    const float* base; float* out; bf16_t* hb; float* ss; int ldc;
    __device__ __forceinline__ void operator()(const f32x4 (&acc)[2][2][4][2], const Unit& u, int wr, int wc, int fr, int fq) const {
        const int row0 = u.pm * BM + wr * 64 + fr, col0 = u.pn * BM + wc * 32 + 8 * fq;
#pragma unroll
        for (int ai = 0; ai < 2; ++ai)
#pragma unroll
            for (int m = 0; m < 4; ++m) { const int row = row0 + ai * HALF + m * 16; const size_t off = (size_t)row * ldc + col0; float s = 0.f;
#pragma unroll
                for (int bj = 0; bj < 2; ++bj) {
                    const f32x4 b0 = *(const f32x4*)(base + off + bj * HALF), b1 = *(const f32x4*)(base + off + bj * HALF + 4);
                    const f32x4 v0 = acc[ai][bj][m][0] + b0, v1 = acc[ai][bj][m][1] + b1;
                    *(f32x4*)(out + off + bj * HALF) = v0; *(f32x4*)(out + off + bj * HALF + 4) = v1;
                    if (hb) { u32x4 w; w.x = cvt_pk_bf16(v0[0], v0[1]); w.y = cvt_pk_bf16(v0[2], v0[3]); w.z = cvt_pk_bf16(v1[0], v1[1]); w.w = cvt_pk_bf16(v1[2], v1[3]); *(u32x4*)(hb + off + bj * HALF) = w; }
                    s += (v0[0] * v0[0] + v0[1] * v0[1]) + (v0[2] * v0[2] + v0[3] * v0[3]) + (v1[0] * v1[0] + v1[1] * v1[1]) + (v1[2] * v1[2] + v1[3] * v1[3]);
                }
                if (ss) { s += __shfl_xor(s, 16); s += __shfl_xor(s, 32); if (fq == 0) (void)__hip_atomic_fetch_add(ss + row, s, __ATOMIC_RELAXED, __HIP_MEMORY_SCOPE_AGENT); }
                asm volatile("" ::: "memory"); }
    }
};
struct EpiResidToBf {
    static constexpr bool PERM = true, AFTER_DRAIN = false;
    const float* base; bf16_t* hb; float* ss; int ldc;
    __device__ __forceinline__ void operator()(const f32x4 (&acc)[2][2][4][2], const Unit& u, int wr, int wc, int fr, int fq) const {
        const int row0 = u.pm * BM + wr * 64 + fr, col0 = u.pn * BM + wc * 32 + 8 * fq;
#pragma unroll
        for (int ai = 0; ai < 2; ++ai)
#pragma unroll
            for (int m = 0; m < 4; ++m) { const int row = row0 + ai * HALF + m * 16; const size_t off = (size_t)row * ldc + col0; float s = 0.f;
#pragma unroll
                for (int bj = 0; bj < 2; ++bj) {
                    const f32x4 b0 = *(const f32x4*)(base + off + bj * HALF), b1 = *(const f32x4*)(base + off + bj * HALF + 4);
                    const f32x4 v0 = acc[ai][bj][m][0] + b0, v1 = acc[ai][bj][m][1] + b1;
                    u32x4 w; w.x = cvt_pk_bf16(v0[0], v0[1]); w.y = cvt_pk_bf16(v0[2], v0[3]); w.z = cvt_pk_bf16(v1[0], v1[1]); w.w = cvt_pk_bf16(v1[2], v1[3]); *(u32x4*)(hb + off + bj * HALF) = w;
                    s += (v0[0] * v0[0] + v0[1] * v0[1]) + (v0[2] * v0[2] + v0[3] * v0[3]) + (v1[0] * v1[0] + v1[1] * v1[1]) + (v1[2] * v1[2] + v1[3] * v1[3]);
                }
                if (ss) { s += __shfl_xor(s, 16); s += __shfl_xor(s, 32); if (fq == 0) (void)__hip_atomic_fetch_add(ss + row, s, __ATOMIC_RELAXED, __HIP_MEMORY_SCOPE_AGENT); }
                asm volatile("" ::: "memory"); }
    }
};
struct EpiResidFromBf {
    static constexpr bool PERM = true, AFTER_DRAIN = false;
    const bf16_t* hb; float* out; int ldc;
    __device__ __forceinline__ void operator()(const f32x4 (&acc)[2][2][4][2], const Unit& u, int wr, int wc, int fr, int fq) const {
        const int row0 = u.pm * BM + wr * 64 + fr, col0 = u.pn * BM + wc * 32 + 8 * fq;
#pragma unroll
        for (int ai = 0; ai < 2; ++ai)
#pragma unroll
            for (int m = 0; m < 4; ++m) { const size_t off = (size_t)(row0 + ai * HALF + m * 16) * ldc + col0;
#pragma unroll
                for (int bj = 0; bj < 2; ++bj) { const u32x4 h = *(const u32x4*)(hb + off + bj * HALF);
                    f32x4 v0, v1; v0[0] = __builtin_bit_cast(float, h.x << 16); v0[1] = __builtin_bit_cast(float, h.x & 0xffff0000u); v0[2] = __builtin_bit_cast(float, h.y << 16); v0[3] = __builtin_bit_cast(float, h.y & 0xffff0000u);
                    v1[0] = __builtin_bit_cast(float, h.z << 16); v1[1] = __builtin_bit_cast(float, h.z & 0xffff0000u); v1[2] = __builtin_bit_cast(float, h.w << 16); v1[3] = __builtin_bit_cast(float, h.w & 0xffff0000u);
                    *(f32x4*)(out + off + bj * HALF) = acc[ai][bj][m][0] + v0; *(f32x4*)(out + off + bj * HALF + 4) = acc[ai][bj][m][1] + v1; }
                asm volatile("" ::: "memory"); }
    }
};
struct EpiSwiGLU {
    static constexpr bool PERM = true, AFTER_DRAIN = false;
    bf16_t* O; int ldc; const float* ss; float inv_d, eps;
    __device__ __forceinline__ void operator()(const f32x4 (&acc)[2][2][4][2], const Unit& u, int wr, int wc, int fr, int fq) const {
        const int row0 = u.pm * BM + wr * 64 + fr, col0 = u.pn * HALF + wc * 32 + 8 * fq;
#pragma unroll
        for (int ai = 0; ai < 2; ++ai)
#pragma unroll
            for (int m = 0; m < 4; ++m) { const int row = row0 + ai * HALF + m * 16; const float rstd = __builtin_amdgcn_rsqf(ss[row] * inv_d + eps);
                float a[8];
#pragma unroll
                for (int n = 0; n < 2; ++n)
#pragma unroll
                    for (int i = 0; i < 4; ++i) { const float g = acc[ai][0][m][n][i] * rstd, up = acc[ai][1][m][n][i] * rstd;
                        a[4 * n + i] = g * __builtin_amdgcn_rcpf(1.0f + __builtin_amdgcn_exp2f(-1.4426950408889634f * g)) * up; }
                u32x4 w; w.x = cvt_pk_bf16(a[0], a[1]); w.y = cvt_pk_bf16(a[2], a[3]); w.z = cvt_pk_bf16(a[4], a[5]); w.w = cvt_pk_bf16(a[6], a[7]);
                *(u32x4*)(O + (size_t)row * ldc + col0) = w; }
    }
};

struct EpiHeads {
    static constexpr bool PERM = true, AFTER_DRAIN = false;
    bf16_t* O; int Mrows;
    __device__ __forceinline__ void operator()(const f32x4 (&acc)[2][2][4][2], const Unit& u, int wr, int wc, int fr, int fq) const {
        const int row0 = u.pm * BM + wr * 64 + fr, col = wc * 32 + 8 * fq;
#pragma unroll
        for (int bj = 0; bj < 2; ++bj) { bf16_t* base = O + (size_t)(u.pn * 2 + bj) * Mrows * HALF + col;
#pragma unroll
            for (int ai = 0; ai < 2; ++ai)
#pragma unroll
                for (int m = 0; m < 4; ++m) { const f32x4 v0 = acc[ai][bj][m][0], v1 = acc[ai][bj][m][1];
                    u32x4 w; w.x = cvt_pk_bf16(v0[0], v0[1]); w.y = cvt_pk_bf16(v0[2], v0[3]); w.z = cvt_pk_bf16(v1[0], v1[1]); w.w = cvt_pk_bf16(v1[2], v1[3]);
                    *(u32x4*)(base + (size_t)(row0 + ai * HALF + m * 16) * HALF) = w; } }
    }
};
struct EpiNull {
    static constexpr bool PERM = true, AFTER_DRAIN = false;
    __device__ __forceinline__ void operator()(const f32x4 (&acc)[2][2][4][2], const Unit&, int, int, int, int) const {
#pragma unroll
        for (int ai = 0; ai < 2; ++ai)
#pragma unroll
            for (int bj = 0; bj < 2; ++bj)
#pragma unroll
                for (int m = 0; m < 4; ++m)
#pragma unroll
                    for (int n = 0; n < 2; ++n) asm volatile("" :: "v"(acc[ai][bj][m][n]));
    }
};

template <class Epi, class Sched, bool ALIGN_EPI = false, bool SP2 = false>
__device__ __forceinline__ void gemm_phase(PG8_LAS unsigned char* lds, const Gemm g, const Sched& S, const Epi& E) {
    int tid_ = threadIdx.x; asm volatile("" : "+v"(tid_));
    const int tid = tid_, wid = __builtin_amdgcn_readfirstlane(tid >> 6), lane = tid & 63, wr = wid >> 2, wc = wid & 3, fr = lane & 15, fq = lane >> 4;
    const int K = g.K, nt = K / BK;
    unsigned voffA[2], voffB[2];
#pragma unroll
    for (int i = 0; i < 2; ++i) { int R, C; stage_rc(tid * 16 + i * 8192, R, C); const int Rb = Epi::PERM ? ((R & ~31) + perm32(R & 31)) : R;
        voffA[i] = (unsigned)(R * K + C) * 2u; voffB[i] = (unsigned)(Rb * K + C) * 2u; }
    const size_t kstep = (size_t)(BK * 2);
    const size_t hstep = (size_t)HALF * K * 2;
    const size_t tstep = 2 * hstep;
    const unsigned ldsw = (unsigned)wid * 1024u;
    const int aoff = lds_byte(wr * 64 + fr, fq * 8), boff = lds_byte(wc * 32 + fr, fq * 8);
#define PG8_SA(b, h) (((b) * 2 + (h)) * HTB)
#define PG8_SB(b, h) ((4 + (b) * 2 + (h)) * HTB)
#define PG8_STAGE(bufoff, gbase, voff) do { _Pragma("unroll") for (int _i = 0; _i < 2; ++_i) \
        __builtin_amdgcn_global_load_lds((const unsigned*)((const char*)(gbase) + (voff)[_i]), (PG8_LAS unsigned*)(lds + (bufoff) + ldsw + _i * 8192), 16, 0, 0); } while (0)
#define PG8_LDA(dst, b, h) do { _Pragma("unroll") for (int m = 0; m < 4; ++m) _Pragma("unroll") for (int k = 0; k < 2; ++k) dst[m][k] = *(const PG8_LAS bf16x8*)(lds + PG8_SA(b, h) + aoff + m * 2048 + k * 1024); } while (0)
#define PG8_LDB(dst, b, h) do { _Pragma("unroll") for (int n = 0; n < 2; ++n) _Pragma("unroll") for (int k = 0; k < 2; ++k) dst[n][k] = *(const PG8_LAS bf16x8*)(lds + PG8_SB(b, h) + boff + n * 2048 + k * 1024); } while (0)
#define PG8_MMA(ai, bj, At, Bt) do { __builtin_amdgcn_s_setprio(1); _Pragma("unroll") for (int m = 0; m < 4; ++m) _Pragma("unroll") for (int n = 0; n < 2; ++n) _Pragma("unroll") for (int k = 0; k < 2; ++k) \
        acc[ai][bj][m][n] = __builtin_amdgcn_mfma_f32_16x16x32_bf16(Bt[n][k], At[m][k], acc[ai][bj][m][n], 0, 0, 0); __builtin_amdgcn_s_setprio(0); } while (0)
#define PG8_WAIT_V(n) asm volatile("s_waitcnt vmcnt(" #n ")" ::: "memory")
#define PG8_WAIT_L(n) asm volatile("s_waitcnt lgkmcnt(" #n ")" ::: "memory")
#define PG8_BAR __builtin_amdgcn_s_barrier()
#define PG8_SCHED __builtin_amdgcn_sched_barrier(0)
    Unit cur, nxt; int ui = 0;
    if (!S.next(0, cur)) return;
    f32x4 acc[2][2][4][2];
#pragma unroll
    for (int a = 0; a < 2; ++a)
#pragma unroll
        for (int b = 0; b < 2; ++b)
#pragma unroll
            for (int m = 0; m < 4; ++m)
#pragma unroll
                for (int n = 0; n < 2; ++n) acc[a][b][m][n] = (f32x4){0.f, 0.f, 0.f, 0.f};
    bf16x8 At[4][2], B0[2][2], B1[2][2];
    const char* cA = (const char*)g.A + (size_t)cur.pm * tstep; const char* cB = (const char*)g.Bt + (size_t)cur.pn * tstep;
    S.a_ready(cur);
    if constexpr (SP2) {
        PG8_STAGE(PG8_SB(0, 0), cB, voffB); PG8_STAGE(PG8_SB(0, 1), cB + hstep, voffB); PG8_STAGE(PG8_SA(0, 0), cA, voffA); PG8_STAGE(PG8_SA(0, 1), cA + hstep, voffA);
        if (wr == 1) PG8_BAR;
        PG8_WAIT_V(2); PG8_BAR;
        PG8_STAGE(PG8_SB(1, 0), cB + kstep, voffB); PG8_STAGE(PG8_SA(1, 0), cA + kstep, voffA); PG8_STAGE(PG8_SB(1, 1), cB + hstep + kstep, voffB);
        PG8_WAIT_V(6); PG8_BAR;
    } else {
        PG8_STAGE(PG8_SB(0, 0), cB, voffB); PG8_STAGE(PG8_SA(0, 0), cA, voffA); PG8_STAGE(PG8_SB(0, 1), cB + hstep, voffB); PG8_STAGE(PG8_SA(0, 1), cA + hstep, voffA);
        if (wr == 1) PG8_BAR;
        PG8_WAIT_V(4); PG8_BAR;
        PG8_STAGE(PG8_SB(1, 0), cB + kstep, voffB); PG8_STAGE(PG8_SA(1, 0), cA + kstep, voffA); PG8_STAGE(PG8_SB(1, 1), cB + hstep + kstep, voffB);
        PG8_WAIT_V(6); PG8_BAR;
    }
    for (;;) {
        const bool has_next = S.next(ui + 1, nxt);
        const char* nA = has_next ? (const char*)g.A + (size_t)nxt.pm * tstep : cA; const char* nB = has_next ? (const char*)g.Bt + (size_t)nxt.pn * tstep : cB;
        for (int t = 0; t < nt; t += 2) {
            const bool last = (t == nt - 2);
            const char* a1 = cA + (size_t)(t + 1) * kstep;
            const char* a2 = last ? nA : cA + (size_t)(t + 2) * kstep; const char* b2 = last ? nB : cB + (size_t)(t + 2) * kstep;
            const char* a3 = a2 + kstep; const char* b3 = b2 + kstep;
            if (last && has_next) S.a_ready(nxt);
            if constexpr (SP2) {
            PG8_LDB(B0, 0, 0); PG8_LDB(B1, 0, 1); PG8_SCHED; PG8_LDA(At, 0, 0); PG8_STAGE(PG8_SA(1, 1), a1 + hstep, voffA);
            PG8_WAIT_V(8); PG8_WAIT_L(0); PG8_BAR; PG8_MMA(0, 0, At, B0); PG8_MMA(0, 1, At, B1); PG8_BAR; PG8_SCHED;
            PG8_LDA(At, 0, 1); PG8_STAGE(PG8_SB(0, 0), b2, voffB); PG8_STAGE(PG8_SB(0, 1), b2 + hstep, voffB); PG8_STAGE(PG8_SA(0, 0), a2, voffA);
            PG8_WAIT_V(8); PG8_WAIT_L(0); PG8_BAR; PG8_MMA(1, 0, At, B0); PG8_MMA(1, 1, At, B1); PG8_BAR; PG8_SCHED;
            PG8_LDB(B0, 1, 0); PG8_LDB(B1, 1, 1); PG8_SCHED; PG8_LDA(At, 1, 0); PG8_STAGE(PG8_SA(0, 1), a2 + hstep, voffA);
            PG8_WAIT_V(8); PG8_WAIT_L(0); PG8_BAR; PG8_MMA(0, 0, At, B0); PG8_MMA(0, 1, At, B1); PG8_BAR; PG8_SCHED;
            PG8_LDA(At, 1, 1); PG8_STAGE(PG8_SB(1, 0), b3, voffB); PG8_STAGE(PG8_SB(1, 1), b3 + hstep, voffB); PG8_STAGE(PG8_SA(1, 0), a3, voffA);
            PG8_WAIT_V(8); PG8_WAIT_L(0); PG8_BAR; PG8_MMA(1, 0, At, B0); PG8_MMA(1, 1, At, B1); PG8_BAR; PG8_SCHED;
            } else {
            PG8_LDB(B0, 0, 0); PG8_SCHED; PG8_LDA(At, 0, 0); PG8_STAGE(PG8_SA(1, 1), a1 + hstep, voffA);
            PG8_WAIT_L(8); PG8_BAR; PG8_WAIT_L(0); PG8_MMA(0, 0, At, B0); PG8_BAR; PG8_SCHED;
            PG8_LDB(B1, 0, 1); PG8_STAGE(PG8_SB(0, 0), b2, voffB);
            PG8_BAR; PG8_WAIT_L(0); PG8_MMA(0, 1, At, B1); PG8_BAR;
            PG8_LDA(At, 0, 1); PG8_STAGE(PG8_SA(0, 0), a2, voffA);
            PG8_BAR; PG8_WAIT_L(0); PG8_MMA(1, 0, At, B0); PG8_BAR; PG8_SCHED;
            PG8_STAGE(PG8_SB(0, 1), b2 + hstep, voffB);
            PG8_WAIT_V(6); PG8_BAR; PG8_MMA(1, 1, At, B1); PG8_BAR;
            PG8_LDB(B0, 1, 0); PG8_SCHED; PG8_LDA(At, 1, 0); PG8_STAGE(PG8_SA(0, 1), a2 + hstep, voffA);
            PG8_WAIT_L(8); PG8_BAR; PG8_WAIT_L(0); PG8_MMA(0, 0, At, B0); PG8_BAR; PG8_SCHED;
            PG8_LDB(B1, 1, 1); PG8_STAGE(PG8_SB(1, 0), b3, voffB);
            PG8_BAR; PG8_WAIT_L(0); PG8_MMA(0, 1, At, B1); PG8_BAR;
            PG8_LDA(At, 1, 1); PG8_STAGE(PG8_SA(1, 0), a3, voffA);
            PG8_BAR; PG8_WAIT_L(0); PG8_MMA(1, 0, At, B0); PG8_BAR; PG8_SCHED;
            PG8_STAGE(PG8_SB(1, 1), b3 + hstep, voffB);
            PG8_WAIT_V(6); PG8_BAR; PG8_MMA(1, 1, At, B1); PG8_BAR;
            }
        }
        if constexpr (ALIGN_EPI) { if (wr == 0) PG8_BAR; }
        if constexpr (!Epi::AFTER_DRAIN) { E(acc, cur, wr, wc, fr, fq); S.done(cur); }
        if (!has_next) break;
#pragma unroll
        for (int a = 0; a < 2; ++a)
#pragma unroll
            for (int b = 0; b < 2; ++b)
#pragma unroll
                for (int m = 0; m < 4; ++m)
#pragma unroll
                    for (int n = 0; n < 2; ++n) acc[a][b][m][n] = (f32x4){0.f, 0.f, 0.f, 0.f};
        cur = nxt; cA = nA; cB = nB; ++ui;
        if constexpr (ALIGN_EPI) { if (wr == 1) PG8_BAR; }
    }
    PG8_WAIT_V(0);
    if constexpr (!ALIGN_EPI) { if (wr == 0) PG8_BAR; }
    PG8_BAR;
    if constexpr (Epi::AFTER_DRAIN) { E.fused(acc, cur, wr, wc, fr, fq, lds, wid, lane); S.done(cur); }
#undef PG8_SA
#undef PG8_SB
#undef PG8_STAGE
#undef PG8_LDA
#undef PG8_LDB
#undef PG8_MMA
#undef PG8_WAIT_V
#undef PG8_WAIT_L
#undef PG8_BAR
#undef PG8_SCHED
}
}

constexpr int NWAVES = 8;
#ifndef ATTN_NAIVE
#define ATTN_NAIVE 0
#endif
#ifndef ATTN_V1
#define ATTN_V1 0
#endif
#ifndef R1_V1
#define R1_V1 0
#endif
#ifndef R3_V1
#define R3_V1 0
#endif
#ifndef R1_NAIVE
#define R1_NAIVE 0
#endif
#ifndef R3_NAIVE
#define R3_NAIVE 0
#endif
#ifndef PROBE_REPEAT
#define PROBE_REPEAT 0
#endif
#ifndef PROBE_T
#define PROBE_T 0
#endif
#ifndef PROBE_MULT
#define PROBE_MULT 16
#endif
#ifndef PROBE_USE_B
#define PROBE_USE_B 0
#endif
#ifndef PROBE_BLOCK
#define PROBE_BLOCK 0
#endif
#ifndef MK_N_LAUNCHES
#define MK_N_LAUNCHES 1
#endif
constexpr int PER_PHASE = 9;
constexpr int N_LAUNCHES = MK_N_LAUNCHES;

constexpr int BATCH = 4, SEQ = 4096, D = 2048, M = BATCH * SEQ, HD = 128, NH = 8, DATT = 1024, DRET = 1024, DIN = 7168, DFF = 5632, NGU = 2 * DFF, CH = 128, NCH = SEQ / CH;
constexpr float EPS = 1e-6f;
constexpr int COL_QA = 0, COL_KA = 1024, COL_VA = 2048, COL_QR = 3072, COL_KR = 4096, COL_VR = 5120, COL_GR = 6144;

constexpr size_t MiB = 1u << 20;
constexpr size_t WS_CTL = 0, CTL_ZERO_BYTES = 1 * MiB;
constexpr size_t WS_WIN = 1 * MiB, WS_WOUT = 29 * MiB, WS_WGU = 37 * MiB, WS_WDN = 81 * MiB;
constexpr size_t WS_LSE = 103 * MiB;
constexpr size_t WS_XN = 105 * MiB;
constexpr size_t WS_PROJ = 169 * MiB;
constexpr size_t WS_MIX = 393 * MiB;
constexpr size_t WS_END = 457 * MiB;
static_assert(WS_WIN + (size_t)DIN * D * 2 <= WS_WOUT && WS_WOUT + (size_t)D * D * 2 <= WS_WGU && WS_WGU + (size_t)NGU * D * 2 <= WS_WDN && WS_WDN + (size_t)D * DFF * 2 <= WS_LSE, "weight map");
static_assert(WS_XN + (size_t)M * D * 2 <= WS_PROJ && WS_PROJ + (size_t)M * DIN * 2 <= WS_MIX && WS_MIX + (size_t)M * D * 2 <= WS_END, "activation map");
constexpr int CW_TMO = 0, CW_CODE = 1, CW_BAR = 4096;
constexpr size_t CTL_SS1 = 256 * 1024;
constexpr size_t ST_HALF = (size_t)BATCH * NH * NCH * HD * HD;

constexpr int RING_OFF = 0, RING_BYTES = 143360;
constexpr int LDSCTL_OFF = RING_BYTES, MISC_OFF = LDSCTL_OFF + 320;
constexpr int LDS_BYTES = 147456;
static_assert(MISC_OFF + 128 <= LDS_BYTES, "LDS map");

#define GAS __attribute__((address_space(1)))
#define LAS __attribute__((address_space(3)))
typedef unsigned short bf16;
typedef unsigned v4u __attribute__((ext_vector_type(4)));
typedef float f32x4 __attribute__((ext_vector_type(4)));
typedef GAS unsigned gu32;
#define RLX_AGENT __ATOMIC_RELAXED, __HIP_MEMORY_SCOPE_AGENT
#define LDS_WAIT() asm volatile("s_waitcnt lgkmcnt(0)" ::: "memory")
#define VM_WAIT() asm volatile("s_waitcnt vmcnt(0)" ::: "memory")
__device__ __forceinline__ unsigned f2bf(float f) { unsigned u = __builtin_bit_cast(unsigned, f); return (u + 0x7fffu + ((u >> 16) & 1u)) >> 16; }
__device__ __forceinline__ unsigned pk2(float lo, float hi) { return f2bf(lo) | (f2bf(hi) << 16); }
__device__ __forceinline__ float bflo(unsigned w) { return __builtin_bit_cast(float, w << 16); }
__device__ __forceinline__ float bfhi(unsigned w) { return __builtin_bit_cast(float, w & 0xffff0000u); }

#define XB_TMO      128
#define XB_XCNT(j)  (256  + 64 * (j))
#define XB_XSUB(j)  (1280 + 64 * (j))
#define XB_XGEN(j)  (2304 + 64 * (j))
#define XB_TOP      3328
#define XB_TOPGEN   3392
#define XCD_BAR_WORDS 3456
#define XB_SPIN_CAP (1u << 18)

__device__ __forceinline__ unsigned xb_ld(unsigned* p)              { return __hip_atomic_load(p, __ATOMIC_RELAXED, __HIP_MEMORY_SCOPE_AGENT); }
__device__ __forceinline__ unsigned xb_add(unsigned* p, unsigned v) { return __hip_atomic_fetch_add(p, v, __ATOMIC_RELAXED, __HIP_MEMORY_SCOPE_AGENT); }
__device__ __forceinline__ unsigned xb_xcc_id() { return (unsigned)__builtin_amdgcn_s_getreg((3 << 11) | 20) & 0xFu; }
#define XB_SPIN(cond, bar) do { unsigned _sp = 0; while (cond) { __builtin_amdgcn_s_sleep(1); \
    if ((++_sp & 255u) == 0u) { if (xb_ld(&(bar)[XB_TMO])) break; if (_sp > XB_SPIN_CAP) { atomicAdd(&(bar)[XB_TMO], 1u); break; } } } } while (0)

struct XcdBarrier {
    unsigned* bar; unsigned x;
    volatile LAS unsigned* st;
};

__device__ __forceinline__ XcdBarrier xcd_barrier_post(unsigned* bar, volatile LAS unsigned* st) {
    XcdBarrier b; b.bar = bar; b.x = xb_xcc_id(); b.st = st;
    if (threadIdx.x == 0) st[2] = xb_add(&bar[XB_XCNT(b.x)], 1u);
    return b;
}
__device__ __forceinline__ void xcd_barrier_complete(unsigned* bar, unsigned x, unsigned& nloc, unsigned& nx) {
    const unsigned G = gridDim.x * gridDim.y * gridDim.z;
    unsigned sum, cnt, mine, sp = 0u;
    for (;;) {
        sum = 0u; cnt = 0u; mine = 0u;
#pragma unroll
        for (unsigned j = 0; j < 16; ++j) { const unsigned c = xb_ld(&bar[XB_XCNT(j)]); sum += c; cnt += (c > 0u) ? 1u : 0u; mine = (j == x) ? c : mine; }
        if (sum == G) break;
        __builtin_amdgcn_s_sleep(1);
        if ((++sp & 255u) == 0u) { if (xb_ld(&bar[XB_TMO])) break; if (sp > XB_SPIN_CAP) { atomicAdd(&bar[XB_TMO], 1u); break; } }
    }
    nloc = mine > 0u ? mine : 1u; nx = cnt > 0u ? cnt : 1u;
}

__device__ __forceinline__ void xcd_barrier(const XcdBarrier& b) {
    asm volatile("s_waitcnt vmcnt(0)" ::: "memory");
    __syncthreads();
    if (threadIdx.x == 0) {
        unsigned* bar = b.bar;
        __builtin_amdgcn_s_waitcnt(0);
        unsigned nloc = b.st[0], nx = b.st[1];
        if (nloc == 0u) { xcd_barrier_complete(bar, b.x, nloc, nx); b.st[0] = nloc; b.st[1] = nx; }
        const unsigned old = xb_add(&bar[XB_XSUB(b.x)], 1u);
        const unsigned gen = old / nloc;
        if (old + 1u == (gen + 1u) * nloc) {
            __builtin_amdgcn_fence(__ATOMIC_RELEASE, "agent");
            asm volatile("s_waitcnt vmcnt(0)" ::: "memory");
            const unsigned og = xb_add(&bar[XB_TOP], 1u);
            const unsigned tg = og / nx;
            if (og + 1u == (tg + 1u) * nx) xb_add(&bar[XB_TOPGEN], 1u);
            else XB_SPIN(xb_ld(&bar[XB_TOPGEN]) == tg, bar);
            __builtin_amdgcn_fence(__ATOMIC_ACQUIRE, "agent");
            xb_add(&bar[XB_XGEN(b.x)], 1u);
            asm volatile("s_waitcnt vmcnt(0)" ::: "memory");
        } else {
            XB_SPIN(xb_ld(&bar[XB_XGEN(b.x)]) == gen, bar);
            __builtin_amdgcn_fence(__ATOMIC_ACQUIRE, "agent");
            asm volatile("s_waitcnt vmcnt(0)" ::: "memory");
        }
    }
    __syncthreads();
}

struct Frame {
    LAS unsigned char* lds;
    volatile LAS unsigned* MISC;
    gu32* ctl;
    int tid, lane, wave;
    int vcu, G;
    const float *x, *w_mix, *w_in, *decf, *decb, *w_retn, *w_out, *w_ffn, *w_gate, *w_up, *w_down, *w_fin; float* out;
    bf16 *Win_t, *Wout_t, *Wgu_t, *Wdn_t;
    bf16 *XN, *PROJ, *MIX, *ACT;
    float *STF, *STB, *SS1, *LSE;
    unsigned long long tA, tB;
};
#if PROBE_T
#define RT() __builtin_amdgcn_s_memrealtime()
#define T_ADD(acc, t0) do { __builtin_amdgcn_sched_barrier(0); (acc) += RT() - (t0); __builtin_amdgcn_sched_barrier(0); } while (0)
#define T_START(t0) do { __builtin_amdgcn_sched_barrier(0); (t0) = RT(); __builtin_amdgcn_sched_barrier(0); } while (0)
#else
#define T_ADD(acc, t0) do {} while (0)
#define T_START(t0) do {} while (0)
#endif

__device__ __forceinline__ float wave_sum(float v) {
#pragma unroll
    for (int o = 1; o < 64; o <<= 1) v += __shfl_xor(v, o);
    return v;
}
__device__ __forceinline__ float wave_max(float v) {
#pragma unroll
    for (int o = 1; o < 64; o <<= 1) v = fmaxf(v, __shfl_xor(v, o));
    return v;
}
__device__ __forceinline__ void p0_tr_load(f32x4 (&v)[16], const float* W, int N, int k0, int n0, int lane) {
#pragma unroll
    for (int i = 0; i < 16; ++i) v[i] = *(const GAS f32x4*)(W + (size_t)(k0 + 4 * i + (lane >> 4)) * N + n0 + 4 * (lane & 15));
}
__device__ __forceinline__ void p0_tr_store(f32x4 (&v)[16], int K, bf16* WT, int row_base, const float* kscale, LAS float* scr, int k0, int lane) {
#pragma unroll
    for (int i = 0; i < 16; ++i) { const int kk = 4 * i + (lane >> 4); f32x4 x = v[i]; if (kscale) x = x * kscale[k0 + kk]; LAS float* d = scr + kk * 65 + 4 * (lane & 15); d[0] = x.x; d[1] = x.y; d[2] = x.z; d[3] = x.w; }
    LDS_WAIT(); asm volatile("" ::: "memory");
    const int c = lane & 7;
#pragma unroll
    for (int j = 0; j < 8; ++j) { const int n = (lane >> 3) + 8 * j; const LAS float* s = scr + (8 * c) * 65 + n;
        v4u o; o.x = pk2(s[0 * 65], s[1 * 65]); o.y = pk2(s[2 * 65], s[3 * 65]); o.z = pk2(s[4 * 65], s[5 * 65]); o.w = pk2(s[6 * 65], s[7 * 65]);
        *(GAS v4u*)(WT + (size_t)(row_base + n) * K + k0 + 8 * c) = o; }
    LDS_WAIT(); asm volatile("" ::: "memory");
}
struct P0Item { const float* W; bf16* WT; const float* ks; int K, N, k0, n0, row_base; };
__device__ __forceinline__ P0Item p0_item(const Frame& F, int it) {
    constexpr int I_IN = (D / 64) * (DIN / 64), I_OUT = (D / 64) * (D / 64), I_G = (D / 64) * (DFF / 64);
    P0Item P; int r = it;
    if (r < I_IN) { const int nblk = DIN / 64; P.W = F.w_in; P.WT = F.Win_t; P.ks = nullptr; P.K = D; P.N = DIN; P.k0 = 64 * (r / nblk); P.n0 = 64 * (r % nblk); P.row_base = P.n0; return P; } r -= I_IN;
    if (r < I_OUT) { const int nblk = D / 64; P.W = F.w_out; P.WT = F.Wout_t; P.ks = nullptr; P.K = D; P.N = D; P.k0 = 64 * (r / nblk); P.n0 = 64 * (r % nblk); P.row_base = P.n0; return P; } r -= I_OUT;
    if (r < 2 * I_G) { const int up = r >= I_G; if (up) r -= I_G; const int nblk = DFF / 64; P.W = up ? F.w_up : F.w_gate; P.WT = F.Wgu_t; P.ks = F.w_ffn; P.K = D; P.N = DFF; P.k0 = 64 * (r / nblk); P.n0 = 64 * (r % nblk);
        P.row_base = 256 * (P.n0 >> 7) + (P.n0 & 127) + (up ? 128 : 0); return P; }
    r -= 2 * I_G;
    { const int nblk = D / 64; P.W = F.w_down; P.WT = F.Wdn_t; P.ks = nullptr; P.K = DFF; P.N = D; P.k0 = 64 * (r / nblk); P.n0 = 64 * (r % nblk); P.row_base = P.n0; return P; }
}
__device__ __forceinline__ void p0_prologue(Frame& F) {
    LAS float* scr = (LAS float*)(F.lds + RING_OFF + F.wave * 17408);
    const int gw = F.vcu * NWAVES + F.wave, NGW = F.G * NWAVES, lane = F.lane;
    constexpr int NITEMS = (D / 64) * (DIN / 64) + (D / 64) * (D / 64) + 2 * (D / 64) * (DFF / 64) + (DFF / 64) * (D / 64);
    for (int m = 2 * gw; m < M; m += 2 * NGW) {
        const GAS f32x4* x0 = (const GAS f32x4*)(F.x + (size_t)m * D) + lane; const GAS f32x4* x1 = x0 + D / 4; const GAS f32x4* wr = (const GAS f32x4*)F.w_mix + lane;
        f32x4 v0[8], v1[8]; float s0 = 0.f, s1 = 0.f;
#pragma unroll
        for (int j = 0; j < 8; ++j) { v0[j] = x0[64 * j]; v1[j] = x1[64 * j]; }
#pragma unroll
        for (int j = 0; j < 8; ++j) { s0 += (v0[j].x * v0[j].x + v0[j].y * v0[j].y) + (v0[j].z * v0[j].z + v0[j].w * v0[j].w); s1 += (v1[j].x * v1[j].x + v1[j].y * v1[j].y) + (v1[j].z * v1[j].z + v1[j].w * v1[j].w); }
        const float r0 = 1.0f / sqrtf(wave_sum(s0) * (1.0f / D) + EPS), r1 = 1.0f / sqrtf(wave_sum(s1) * (1.0f / D) + EPS);
        GAS unsigned long long* o0 = (GAS unsigned long long*)(F.XN + (size_t)m * D) + lane; GAS unsigned long long* o1 = o0 + D / 4;
#pragma unroll
        for (int j = 0; j < 8; ++j) { const f32x4 w = wr[64 * j];
            o0[64 * j] = (unsigned long long)pk2(v0[j].x * r0 * w.x, v0[j].y * r0 * w.y) | ((unsigned long long)pk2(v0[j].z * r0 * w.z, v0[j].w * r0 * w.w) << 32);
            o1[64 * j] = (unsigned long long)pk2(v1[j].x * r1 * w.x, v1[j].y * r1 * w.y) | ((unsigned long long)pk2(v1[j].z * r1 * w.z, v1[j].w * r1 * w.w) << 32); }
    }
    int it = gw; if (it >= NITEMS) return;
    P0Item P = p0_item(F, it); f32x4 v[16]; p0_tr_load(v, P.W, P.N, P.k0, P.n0, lane);
    for (;;) { const int nit = it + NGW; const bool more = nit < NITEMS; P0Item Pn = P; f32x4 vn[16];
        if (more) { Pn = p0_item(F, nit); p0_tr_load(vn, Pn.W, Pn.N, Pn.k0, Pn.n0, lane); }
        p0_tr_store(v, P.K, P.WT, P.row_base, P.ks, scr, P.k0, lane);
        if (!more) break;
#pragma unroll
        for (int i = 0; i < 16; ++i) v[i] = vn[i];
        P = Pn; it = nit; }
}

#define HP(col, h) (F.PROJ + (size_t)((col) / HD + (h)) * M * HD)
__device__ __forceinline__ void p2_attn_naive(Frame& F) {
    LAS float* qs = (LAS float*)(F.lds + RING_OFF + F.wave * 4096);
    LAS float* ps = qs + 128;
    const int gw = F.vcu * NWAVES + F.wave, NGW = F.G * NWAVES, lane = F.lane;
    for (int item = gw; item < BATCH * NH * SEQ; item += NGW) {
        const int bh = item >> 12, t = item & 4095, b = bh >> 3, h = bh & 7;
        const float slope = exp2f(-(float)(h + 1));
        const bf16* Qrow = HP(COL_QA, h) + (size_t)(b * SEQ + t) * HD;
        const bf16* Kb = HP(COL_KA, h) + (size_t)(b * SEQ) * HD;
        const bf16* Vb = HP(COL_VA, h) + (size_t)(b * SEQ) * HD;
        { const unsigned qq = *(const GAS unsigned*)(Qrow + 2 * lane); qs[2 * lane] = bflo(qq) * 0.08838834764831845f; qs[2 * lane + 1] = bfhi(qq) * 0.08838834764831845f; }
        LDS_WAIT();
        float sc[3][3]; float mx = -INFINITY;
#pragma unroll
        for (int p = 0; p < 3; ++p) { const int dil = 1 << (2 * p);
#pragma unroll
            for (int k = 0; k < 3; ++k) { const int idx = lane + 64 * k, j = idx - 64, s = t + j * dil; float v = -INFINITY;
                if (idx < 129 && s >= 0 && s < SEQ) { const GAS v4u* kr = (const GAS v4u*)(Kb + (size_t)s * HD); float dot = 0.f;
#pragma unroll 4
                    for (int c = 0; c < 16; ++c) { const v4u kk = kr[c]; const LAS float* q8 = qs + 8 * c;
                        dot += q8[0] * bflo(kk.x) + q8[1] * bfhi(kk.x) + q8[2] * bflo(kk.y) + q8[3] * bfhi(kk.y) + q8[4] * bflo(kk.z) + q8[5] * bfhi(kk.z) + q8[6] * bflo(kk.w) + q8[7] * bfhi(kk.w); }
                    v = dot - slope * (float)(dil * (j < 0 ? -j : j)); }
                sc[p][k] = v; mx = fmaxf(mx, v); } }
        mx = wave_max(mx);
        float l = 0.f;
#pragma unroll
        for (int p = 0; p < 3; ++p)
#pragma unroll
            for (int k = 0; k < 3; ++k) { const float e = __expf(sc[p][k] - mx); l += e; ps[p * 192 + lane + 64 * k] = e; }
        l = wave_sum(l);
        LDS_WAIT();
        float o0 = 0.f, o1 = 0.f;
#pragma unroll
        for (int p = 0; p < 3; ++p) { const int dil = 1 << (2 * p);
            for (int idx = 0; idx < 129; ++idx) { const int s = t + (idx - 64) * dil;
                if (s >= 0 && s < SEQ) { const float pv = ps[p * 192 + idx]; const unsigned vv = *(const GAS unsigned*)(Vb + (size_t)s * HD + 2 * lane); o0 += pv * bflo(vv); o1 += pv * bfhi(vv); } } }
        const float il = 1.0f / l;
        *(GAS unsigned*)(F.MIX + (size_t)(b * SEQ + t) * D + h * HD + 2 * lane) = pk2(o0 * il, o1 * il);
        LDS_WAIT();
    }
}
__device__ __forceinline__ void p2_r1_naive(Frame& F) {
    LAS float* Ks = (LAS float*)(F.lds + RING_OFF); LAS float* Vs = Ks + CH * HD;
    const int tid = F.tid;
    for (int item = F.vcu; item < BATCH * NH * NCH; item += F.G) {
        const int bh = item >> 5, c = item & 31, b = bh >> 3, h = bh & 7; const size_t row0 = (size_t)b * SEQ + c * CH;
        const bf16* Kg = HP(COL_KR, h) + row0 * HD; const bf16* Vg = HP(COL_VR, h) + row0 * HD;
        { const int row = tid >> 2, seg = tid & 3;
#pragma unroll
          for (int q = 0; q < 4; ++q) { const v4u kk = *(const GAS v4u*)(Kg + (size_t)row * HD + 32 * seg + 8 * q); const v4u vv = *(const GAS v4u*)(Vg + (size_t)row * HD + 32 * seg + 8 * q);
              LAS float* kd = Ks + row * HD + 32 * seg + 8 * q; LAS float* vd = Vs + row * HD + 32 * seg + 8 * q;
              kd[0] = bflo(kk.x); kd[1] = bfhi(kk.x); kd[2] = bflo(kk.y); kd[3] = bfhi(kk.y); kd[4] = bflo(kk.z); kd[5] = bfhi(kk.z); kd[6] = bflo(kk.w); kd[7] = bfhi(kk.w);
              vd[0] = bflo(vv.x); vd[1] = bfhi(vv.x); vd[2] = bflo(vv.y); vd[3] = bfhi(vv.y); vd[4] = bflo(vv.z); vd[5] = bfhi(vv.z); vd[6] = bflo(vv.w); vd[7] = bfhi(vv.w); } }
        __syncthreads();
        const float lgf = -__expf(F.decf[h]), lgb = -__expf(F.decb[h]);
        const int e = tid >> 2, dq = tid & 3;
        float af[32], ab[32];
#pragma unroll
        for (int i = 0; i < 32; ++i) { af[i] = 0.f; ab[i] = 0.f; }
        for (int j = 0; j < CH; ++j) { const float v = Vs[j * HD + e], vf = v * __expf(lgf * (float)(CH - 1 - j)), vb = v * __expf(lgb * (float)j);
            const LAS f32x4* k4 = (const LAS f32x4*)(Ks + j * HD + 32 * dq);
#pragma unroll
            for (int i = 0; i < 8; ++i) { const f32x4 k = k4[i];
                af[4 * i] += vf * k.x; af[4 * i + 1] += vf * k.y; af[4 * i + 2] += vf * k.z; af[4 * i + 3] += vf * k.w;
                ab[4 * i] += vb * k.x; ab[4 * i + 1] += vb * k.y; ab[4 * i + 2] += vb * k.z; ab[4 * i + 3] += vb * k.w; } }
        GAS f32x4* of = (GAS f32x4*)(F.STF + (size_t)item * HD * HD + e * HD + 32 * dq); GAS f32x4* ob = (GAS f32x4*)(F.STB + (size_t)item * HD * HD + e * HD + 32 * dq);
#pragma unroll
        for (int i = 0; i < 8; ++i) { of[i] = (f32x4){af[4 * i], af[4 * i + 1], af[4 * i + 2], af[4 * i + 3]}; ob[i] = (f32x4){ab[4 * i], ab[4 * i + 1], ab[4 * i + 2], ab[4 * i + 3]}; }
        __syncthreads();
    }
}
__device__ __forceinline__ bf16* sbf_row(bf16* proj, int slot, int e);
__device__ __forceinline__ void p3_scan(Frame& F) {
    const int gt = F.vcu * (NWAVES * 64) + F.tid, NT = F.G * NWAVES * 64;
    for (int idx = gt; idx < 2 * BATCH * NH * 4096; idx += NT) {
        const int dir = idx / (BATCH * NH * 4096), rem = idx % (BATCH * NH * 4096), bh = rem >> 12, q = rem & 4095, h = bh & 7;
        const float g = __expf(-__expf(dir ? F.decb[h] : F.decf[h]) * (float)CH);
        GAS f32x4* base = (GAS f32x4*)(dir ? F.STB : F.STF) + (size_t)bh * NCH * 4096 + q;
        f32x4 s = (f32x4){0.f, 0.f, 0.f, 0.f};
#pragma unroll 8
        for (int cc = 0; cc < NCH; ++cc) { const int c = dir ? NCH - 1 - cc : cc; const f32x4 t = base[(size_t)c * 4096];
#if R3_NAIVE
            base[(size_t)c * 4096] = s;
#else
            { unsigned long long o = (unsigned long long)pk2(s.x, s.y) | ((unsigned long long)pk2(s.z, s.w) << 32); *(GAS unsigned long long*)(sbf_row(F.PROJ, 2 * (bh * NCH + c) + dir, q >> 5) + 4 * (q & 31)) = o; }
#endif
            s = s * g + t; }
    }
}
__device__ __forceinline__ void p4_r3_naive(Frame& F) {
    LAS bf16* Qs = (LAS bf16*)(F.lds + RING_OFF); LAS bf16* KVs = Qs + CH * HD; LAS float* As = (LAS float*)(F.lds + RING_OFF + 65536);
    const int tid = F.tid; const float scale = 0.08838834764831845f;
    for (int item = F.vcu; item < BATCH * NH * NCH; item += F.G) {
        const int bh = item >> 5, c = item & 31, b = bh >> 3, h = bh & 7; const size_t row0 = (size_t)b * SEQ + c * CH;
        const bf16* Qg = HP(COL_QR, h) + row0 * HD; const bf16* Kg = HP(COL_KR, h) + row0 * HD;
        const bf16* Vg = HP(COL_VR, h) + row0 * HD; const bf16* Gg = HP(COL_GR, h) + row0 * HD;
        const float lgf = -__expf(F.decf[h]), lgb = -__expf(F.decb[h]);
        const int i = tid >> 2, part = tid & 3;
#pragma unroll
        for (int q = 0; q < 4; ++q) { *(LAS v4u*)(Qs + i * HD + 32 * part + 8 * q) = *(const GAS v4u*)(Qg + (size_t)i * HD + 32 * part + 8 * q);
                                      *(LAS v4u*)(KVs + i * HD + 32 * part + 8 * q) = *(const GAS v4u*)(Kg + (size_t)i * HD + 32 * part + 8 * q); }
        __syncthreads();
        for (int jj = 0; jj < 32; ++jj) { const int j = 32 * part + jj; float dot = 0.f;
#pragma unroll 4
            for (int c8 = 0; c8 < 16; ++c8) { const v4u qq = *(const LAS v4u*)(Qs + i * HD + 8 * c8), kk = *(const LAS v4u*)(KVs + j * HD + 8 * c8);
                dot += bflo(qq.x) * bflo(kk.x) + bfhi(qq.x) * bfhi(kk.x) + bflo(qq.y) * bflo(kk.y) + bfhi(qq.y) * bfhi(kk.y) + bflo(qq.z) * bflo(kk.z) + bfhi(qq.z) * bfhi(kk.z) + bflo(qq.w) * bflo(kk.w) + bfhi(qq.w) * bfhi(kk.w); }
            const float dec = (j <= i) ? __expf(lgf * (float)(i - j)) : __expf(lgb * (float)(j - i));
            As[i * CH + j] = dot * scale * dec; }
        __syncthreads();
#pragma unroll
        for (int q = 0; q < 4; ++q) *(LAS v4u*)(KVs + i * HD + 32 * part + 8 * q) = *(const GAS v4u*)(Vg + (size_t)i * HD + 32 * part + 8 * q);
        __syncthreads();
        const int e0 = 32 * part;
        float acc[32], accf[32], accb[32];
#pragma unroll
        for (int k = 0; k < 32; ++k) { acc[k] = 0.f; accf[k] = 0.f; accb[k] = 0.f; }
        for (int j = 0; j < CH; ++j) { const float a = As[i * CH + j];
#pragma unroll
            for (int q = 0; q < 4; ++q) { const v4u vv = *(const LAS v4u*)(KVs + j * HD + e0 + 8 * q);
                acc[8 * q] += a * bflo(vv.x); acc[8 * q + 1] += a * bfhi(vv.x); acc[8 * q + 2] += a * bflo(vv.y); acc[8 * q + 3] += a * bfhi(vv.y);
                acc[8 * q + 4] += a * bflo(vv.z); acc[8 * q + 5] += a * bfhi(vv.z); acc[8 * q + 6] += a * bflo(vv.w); acc[8 * q + 7] += a * bfhi(vv.w); } }
        const float* Sf = F.STF + (size_t)item * HD * HD; const float* Sb = F.STB + (size_t)item * HD * HD;
        for (int d4 = 0; d4 < HD; d4 += 4) { const unsigned long long qq = *(const LAS unsigned long long*)(Qs + i * HD + d4);
            const float q0 = bflo((unsigned)qq), q1 = bfhi((unsigned)qq), q2 = bflo((unsigned)(qq >> 32)), q3 = bfhi((unsigned)(qq >> 32));
#pragma unroll
            for (int k = 0; k < 32; ++k) { const f32x4 sf = *(const GAS f32x4*)(Sf + (size_t)(e0 + k) * HD + d4), sb = *(const GAS f32x4*)(Sb + (size_t)(e0 + k) * HD + d4);
                accf[k] += q0 * sf.x + q1 * sf.y + q2 * sf.z + q3 * sf.w; accb[k] += q0 * sb.x + q1 * sb.y + q2 * sb.z + q3 * sb.w; } }
        const float ff = __expf(lgf * (float)(i + 1)) * scale, fb = __expf(lgb * (float)(CH - i)) * scale;
        float ssq = 0.f;
#pragma unroll
        for (int k = 0; k < 32; ++k) { acc[k] += ff * accf[k] + fb * accb[k]; ssq += acc[k] * acc[k]; }
        ssq += __shfl_xor(ssq, 1); ssq += __shfl_xor(ssq, 2);
        const float rms = 1.0f / sqrtf(ssq * (1.0f / HD) + EPS);
        bf16* orow = F.MIX + (row0 + i) * D + DATT + h * HD + e0;
#pragma unroll
        for (int q = 0; q < 4; ++q) { const v4u gg = *(const GAS v4u*)(Gg + (size_t)i * HD + e0 + 8 * q); float r[8]; const float gv[8] = {bflo(gg.x), bfhi(gg.x), bflo(gg.y), bfhi(gg.y), bflo(gg.z), bfhi(gg.z), bflo(gg.w), bfhi(gg.w)};
#pragma unroll
            for (int k = 0; k < 8; ++k) { const float g = gv[k]; r[k] = acc[8 * q + k] * rms * F.w_retn[h * HD + e0 + 8 * q + k] * (g / (1.0f + __expf(-g))); }
            v4u o; o.x = pk2(r[0], r[1]); o.y = pk2(r[2], r[3]); o.z = pk2(r[4], r[5]); o.w = pk2(r[6], r[7]); *(GAS v4u*)(orow + 8 * q) = o; }
        __syncthreads();
    }
}
__device__ __forceinline__ void p8_final(Frame& F, bool dummy) {
    const int gw = F.vcu * NWAVES + F.wave, NGW = F.G * NWAVES;
    for (int m = gw; m < M; m += NGW) {
        GAS f32x4* xr = (GAS f32x4*)(F.out + (size_t)m * D) + F.lane; const GAS f32x4* wr = (const GAS f32x4*)F.w_fin + F.lane;
        f32x4 v[8]; float s = 0.f;
#pragma unroll
        for (int j = 0; j < 8; ++j) { v[j] = xr[64 * j]; s += (v[j].x * v[j].x + v[j].y * v[j].y) + (v[j].z * v[j].z + v[j].w * v[j].w); }
        const float rstd = 1.0f / sqrtf(wave_sum(s) * (1.0f / D) + EPS);
#pragma unroll
        for (int j = 0; j < 8; ++j) xr[64 * j] = dummy ? (v[j] + (rstd > 1e30f ? 1.0f : 0.0f)) : v[j] * rstd * wr[64 * j];
    }
}


typedef short bf16x8 __attribute__((ext_vector_type(8)));
typedef float f32x16 __attribute__((ext_vector_type(16)));
typedef unsigned u32x2 __attribute__((ext_vector_type(2)));
typedef float f32x2_t __attribute__((ext_vector_type(2))); typedef __bf16 bf16x2_t __attribute__((ext_vector_type(2)));
__device__ __forceinline__ unsigned cvtpk(float lo, float hi) { f32x2_t v = {lo, hi}; bf16x2_t b = __builtin_convertvector(v, bf16x2_t); return __builtin_bit_cast(unsigned, b); }
#define MFMA32(a, b, c) __builtin_amdgcn_mfma_f32_32x32x16_bf16((a), (b), (c), 0, 0, 0)
__device__ __forceinline__ f32x16 zero16() { f32x16 z;
#pragma unroll
    for (int i = 0; i < 16; ++i) z[i] = 0.f; return z; }
__device__ __forceinline__ bf16x8 pack8(const f32x16& x, int sp) {
    v4u p; p.x = cvtpk(x[8 * sp + 0], x[8 * sp + 1]); p.y = cvtpk(x[8 * sp + 2], x[8 * sp + 3]); p.z = cvtpk(x[8 * sp + 4], x[8 * sp + 5]); p.w = cvtpk(x[8 * sp + 6], x[8 * sp + 7]);
    return __builtin_bit_cast(bf16x8, p); }
__device__ __forceinline__ bf16x8 cat8(u32x2 lo, u32x2 hi) { v4u p; p.x = lo.x; p.y = lo.y; p.z = hi.x; p.w = hi.y; return __builtin_bit_cast(bf16x8, p); }
__device__ __forceinline__ unsigned elt16(const v4u& v, int i) { const unsigned w = v[i >> 1]; return (i & 1) ? (w >> 16) : (w & 0xffffu); }

__device__ __forceinline__ bf16* sbf_row(bf16* proj, int slot, int e) { return proj + ((size_t)slot * HD + e) * HD; }
__device__ __forceinline__ void p2_r1_mfma(Frame& F) {
    constexpr int P = 272;
    LAS unsigned char* KT = F.lds + RING_OFF; LAS unsigned char* VFT = KT + 128 * P; LAS unsigned char* VBT = VFT + 128 * P;
    const int w = F.wave;
    for (int item = F.vcu; item < BATCH * NH * NCH; item += F.G) {
        int tid = F.tid; asm volatile("" : "+v"(tid)); const int lane = tid & 63, r = lane & 31, hh = lane >> 5;
        const int bh = item >> 5, c = item & 31, b = bh >> 3, h = bh & 7; const size_t row0 = (size_t)b * SEQ + c * CH;
        const bf16* Kg = HP(COL_KR, h) + row0 * HD; const bf16* Vg = HP(COL_VR, h) + row0 * HD;
        const float lgf = -__expf(F.decf[h]), lgb = -__expf(F.decb[h]);
        {
            const int jg = tid & 31, dc = tid >> 5; v4u kr[4], vr[4]; float sf[4], sb[4];
#pragma unroll
            for (int q = 0; q < 4; ++q) { kr[q] = *(const GAS v4u*)(Kg + (size_t)(4 * jg + q) * HD + 8 * dc); vr[q] = *(const GAS v4u*)(Vg + (size_t)(4 * jg + q) * HD + 8 * dc);
                sf[q] = __expf(lgf * (float)(CH - 1 - (4 * jg + q))); sb[q] = __expf(lgb * (float)(4 * jg + q)); }
#pragma unroll
            for (int i = 0; i < 8; ++i) { const int off = (8 * dc + i) * P + 8 * jg;
                u32x2 kk; kk.x = elt16(kr[0], i) | (elt16(kr[1], i) << 16); kk.y = elt16(kr[2], i) | (elt16(kr[3], i) << 16); *(LAS u32x2*)(KT + off) = kk;
                const float v0 = __builtin_bit_cast(float, elt16(vr[0], i) << 16), v1 = __builtin_bit_cast(float, elt16(vr[1], i) << 16), v2 = __builtin_bit_cast(float, elt16(vr[2], i) << 16), v3 = __builtin_bit_cast(float, elt16(vr[3], i) << 16);
                u32x2 vf; vf.x = cvtpk(v0 * sf[0], v1 * sf[1]); vf.y = cvtpk(v2 * sf[2], v3 * sf[3]); *(LAS u32x2*)(VFT + off) = vf;
                u32x2 vb; vb.x = cvtpk(v0 * sb[0], v1 * sb[1]); vb.y = cvtpk(v2 * sb[2], v3 * sb[3]); *(LAS u32x2*)(VBT + off) = vb; }
        }
        __syncthreads();
        const int et = w & 3, dt0 = 2 * (w >> 2);
        f32x16 accf[2], accb[2]; accf[0] = zero16(); accf[1] = zero16(); accb[0] = zero16(); accb[1] = zero16();
#pragma unroll
        for (int s = 0; s < 8; ++s) {
            const bf16x8 af = *(const LAS bf16x8*)(VFT + (32 * et + r) * P + 32 * s + 16 * hh), ab = *(const LAS bf16x8*)(VBT + (32 * et + r) * P + 32 * s + 16 * hh);
#pragma unroll
            for (int t = 0; t < 2; ++t) { const bf16x8 bk = *(const LAS bf16x8*)(KT + (32 * (dt0 + t) + r) * P + 32 * s + 16 * hh);
                accf[t] = MFMA32(af, bk, accf[t]); accb[t] = MFMA32(ab, bk, accb[t]); }
        }
        float* of = F.STF + (size_t)item * HD * HD; float* ob = F.STB + (size_t)item * HD * HD;
#pragma unroll
        for (int t = 0; t < 2; ++t)
#pragma unroll
            for (int reg = 0; reg < 16; ++reg) { const int e = 32 * et + (reg & 3) + 8 * (reg >> 2) + 4 * hh, d = 32 * (dt0 + t) + r; of[e * HD + d] = accf[t][reg]; ob[e * HD + d] = accb[t][reg]; }
        __syncthreads();
    }
}
__device__ __forceinline__ void p4_r3_mfma(Frame& F) {
    constexpr int P = 264;
    LAS unsigned char* VT = F.lds + RING_OFF; LAS float* XS = (LAS float*)(F.lds + RING_OFF + 128 * P);
    const int w = F.wave, qt = w & 3, eh = w >> 2;
    const float scale = 0.08838834764831845f, L2E = 1.4426950408889634f;
    for (int item = F.vcu; item < BATCH * NH * NCH; item += F.G) {
        int tid = F.tid; asm volatile("" : "+v"(tid)); const int lane = tid & 63, r = lane & 31, hh = lane >> 5;
        const int bh = item >> 5, c = item & 31, b = bh >> 3, h = bh & 7; const size_t row0 = (size_t)b * SEQ + c * CH;
        const bf16* Qg = HP(COL_QR, h) + row0 * HD; const bf16* Kg = HP(COL_KR, h) + row0 * HD;
        const bf16* Vg = HP(COL_VR, h) + row0 * HD; const bf16* Gg = HP(COL_GR, h) + row0 * HD;
        const float lgf2 = -__expf(F.decf[h]) * L2E, lgb2 = -__expf(F.decb[h]) * L2E;
        {
            const int jg = tid & 31, dc = tid >> 5; v4u vr[4];
#pragma unroll
            for (int q = 0; q < 4; ++q) vr[q] = *(const GAS v4u*)(Vg + (size_t)(4 * jg + q) * HD + 8 * dc);
#pragma unroll
            for (int i = 0; i < 8; ++i) { u32x2 vv; vv.x = elt16(vr[0], i) | (elt16(vr[1], i) << 16); vv.y = elt16(vr[2], i) | (elt16(vr[3], i) << 16); *(LAS u32x2*)(VT + (8 * dc + i) * P + 8 * jg) = vv; }
        }
        const int iq = 32 * qt + r;
        bf16x8 qf[8];
#pragma unroll
        for (int s = 0; s < 8; ++s) qf[s] = *(const GAS bf16x8*)(Qg + (size_t)iq * HD + 64 * hh + 8 * s);
        f32x16 st[4];
#pragma unroll
        for (int kt = 0; kt < 4; ++kt) { st[kt] = zero16();
#pragma unroll
            for (int s = 0; s < 8; ++s) { const bf16x8 kf = *(const GAS bf16x8*)(Kg + (size_t)(32 * kt + r) * HD + 64 * hh + 8 * s); st[kt] = MFMA32(kf, qf[s], st[kt]); }
            __builtin_amdgcn_sched_barrier(0); }
        bf16x8 pf[4][2];
#pragma unroll
        for (int kt = 0; kt < 4; ++kt) {
#pragma unroll
            for (int reg = 0; reg < 16; ++reg) { const int j = 32 * kt + (reg & 3) + 8 * (reg >> 2) + 4 * hh, dj = iq - j;
                const float dec = __builtin_amdgcn_exp2f(dj >= 0 ? lgf2 * (float)dj : lgb2 * (float)(-dj)); st[kt][reg] *= scale * dec; }
            pf[kt][0] = pack8(st[kt], 0); pf[kt][1] = pack8(st[kt], 1); }
        const float ff = __builtin_amdgcn_exp2f(lgf2 * (float)(iq + 1)) * scale, fb = __builtin_amdgcn_exp2f(lgb2 * (float)(CH - iq)) * scale;
        f32x16 acc[2];
#pragma unroll
        for (int t = 0; t < 2; ++t) { const int e = 32 * (2 * eh + t) + r; f32x16 a1 = zero16(), a2 = zero16();
            const bf16* s1 = sbf_row(F.PROJ, 2 * item, e) + 64 * hh; const bf16* s2 = sbf_row(F.PROJ, 2 * item + 1, e) + 64 * hh;
#pragma unroll
            for (int s = 0; s < 8; ++s) { a1 = MFMA32(*(const GAS bf16x8*)(s1 + 8 * s), qf[s], a1); a2 = MFMA32(*(const GAS bf16x8*)(s2 + 8 * s), qf[s], a2); }
#pragma unroll
            for (int reg = 0; reg < 16; ++reg) acc[t][reg] = ff * a1[reg] + fb * a2[reg];
            __builtin_amdgcn_sched_barrier(0); }
        __syncthreads();
#pragma unroll
        for (int t = 0; t < 2; ++t) { const LAS unsigned char* vrow = VT + (32 * (2 * eh + t) + r) * P + 8 * hh;
#pragma unroll
            for (int kt = 0; kt < 4; ++kt)
#pragma unroll
                for (int sp = 0; sp < 2; ++sp) { const u32x2 lo = *(const LAS u32x2*)(vrow + 2 * (32 * kt + 16 * sp)), hi = *(const LAS u32x2*)(vrow + 2 * (32 * kt + 16 * sp + 8));
                    acc[t] = MFMA32(cat8(lo, hi), pf[kt][sp], acc[t]); } }
        float ssq = 0.f;
#pragma unroll
        for (int t = 0; t < 2; ++t)
#pragma unroll
            for (int reg = 0; reg < 16; ++reg) ssq += acc[t][reg] * acc[t][reg];
        ssq += __shfl_xor(ssq, 32);
        if (hh == 0) XS[w * 32 + r] = ssq;
        __syncthreads();
        const float rms = 1.0f / sqrtf((XS[w * 32 + r] + XS[(w ^ 4) * 32 + r]) * (1.0f / HD) + EPS);
#pragma unroll
        for (int t = 0; t < 2; ++t)
#pragma unroll
            for (int g = 0; g < 4; ++g) { const int e = 32 * (2 * eh + t) + 8 * g + 4 * hh;
                const u32x2 gg = *(const GAS u32x2*)(Gg + (size_t)iq * HD + e); const f32x4 wn = *(const GAS f32x4*)(F.w_retn + h * HD + e);
                const float g0 = bflo(gg.x), g1 = bfhi(gg.x), g2 = bflo(gg.y), g3 = bfhi(gg.y);
                const float o0 = acc[t][4 * g] * rms * wn.x * (g0 / (1.0f + __expf(-g0))), o1 = acc[t][4 * g + 1] * rms * wn.y * (g1 / (1.0f + __expf(-g1)));
                const float o2 = acc[t][4 * g + 2] * rms * wn.z * (g2 / (1.0f + __expf(-g2))), o3 = acc[t][4 * g + 3] * rms * wn.w * (g3 / (1.0f + __expf(-g3)));
                u32x2 o; o.x = cvtpk(o0, o1); o.y = cvtpk(o2, o3); *(GAS u32x2*)(F.MIX + (row0 + iq) * D + DATT + h * HD + e) = o; }
        __syncthreads();
    }
}
__device__ __forceinline__ void p2_attn_mfma(Frame& F) {
    constexpr int PK = 272, PV = 520;
    LAS unsigned char* KI = F.lds + RING_OFF; LAS unsigned char* VT = KI + 256 * PK;
    static_assert(256 * PK + 128 * PV <= RING_BYTES, "attention images fit the ring");
    const int w = F.wave, qt = w & 3, eh = w >> 2;
    const float scale = 0.08838834764831845f, L2E = 1.4426950408889634f;
    const int NU = BATCH * NH * 96;
    for (int n = F.vcu; n < NU; n += F.G) {
        int tid = F.tid; asm volatile("" : "+v"(tid)); const int lane = tid & 63, r = lane & 31, hh = lane >> 5;
        unsigned long long t0 = 0, t1 = 0; T_START(t0);
        int bh, u;
        if (F.G == 256) { const int it = n >> 8; bh = (F.vcu >> 5) + 8 * (it / 3); u = (F.vcu & 31) + 32 * (it % 3); }
        else { bh = n / 96; u = n % 96; }
        const int p = u >> 5, idx = u & 31, sh = 2 * p, dil = 1 << sh, nblk = 32 >> sh, cls = idx / nblk, l0 = 128 * (idx % nblk), L = SEQ >> sh;
        const int b = bh >> 3, h = bh & 7;
        const bf16* Qb = HP(COL_QA, h) + (size_t)(b * SEQ) * HD; const bf16* Kb = HP(COL_KA, h) + (size_t)(b * SEQ) * HD; const bf16* Vb = HP(COL_VA, h) + (size_t)(b * SEQ) * HD;
#pragma unroll
        for (int it = 0; it < 8; ++it) { const int pc = tid + 512 * it, row = pc >> 4, ch = pc & 15, lk = l0 - 64 + row;
            const int lkc = lk < 0 ? 0 : (lk >= L ? L - 1 : lk);
            *(LAS v4u*)(KI + row * PK + 16 * ch) = *(const GAS v4u*)(Kb + (size_t)(lkc * dil + cls) * HD + 8 * ch); }
#pragma unroll
        for (int it = 0; it < 2; ++it) { const int bid = tid + 512 * it, jg = bid & 63, dc = bid >> 6; v4u vr[4];
#pragma unroll
            for (int q = 0; q < 4; ++q) { const int lk = l0 - 64 + 4 * jg + q, lkc = lk < 0 ? 0 : (lk >= L ? L - 1 : lk); vr[q] = *(const GAS v4u*)(Vb + (size_t)(lkc * dil + cls) * HD + 8 * dc); }
#pragma unroll
            for (int i = 0; i < 8; ++i) { u32x2 vv; vv.x = elt16(vr[0], i) | (elt16(vr[1], i) << 16); vv.y = elt16(vr[2], i) | (elt16(vr[3], i) << 16); *(LAS u32x2*)(VT + (8 * dc + i) * PV + 8 * jg) = vv; } }
        const int lq = l0 + 32 * qt + r;
        const size_t qrow = (size_t)(lq * dil + cls);
        bf16x8 qf[8];
#pragma unroll
        for (int s = 0; s < 8; ++s) qf[s] = *(const GAS bf16x8*)(Qb + qrow * HD + 64 * hh + 8 * s);
        __syncthreads();
        if (PROBE_T == 1) T_ADD(F.tA, t0);
        T_START(t1);
        f32x16 st[5];
#pragma unroll
        for (int kt = 0; kt < 5; ++kt) { st[kt] = zero16(); const LAS unsigned char* krow = KI + (32 * qt + 32 * kt + r) * PK + 128 * hh;
#pragma unroll
            for (int s = 0; s < 8; ++s) st[kt] = MFMA32(*(const LAS bf16x8*)(krow + 16 * s), qf[s], st[kt]);
            __builtin_amdgcn_sched_barrier(0); }
        const float slope2 = exp2f(-(float)(h + 1)) * (float)dil * L2E, sc2 = scale * L2E;
        float mx = -INFINITY;
#pragma unroll
        for (int kt = 0; kt < 5; ++kt)
#pragma unroll
            for (int reg = 0; reg < 16; ++reg) { const int jl = 32 * kt + (reg & 3) + 8 * (reg >> 2) + 4 * hh, dist = r + 64 - jl, ad = dist < 0 ? -dist : dist, lk = l0 + 32 * qt - 64 + jl;
                const bool valid = (ad <= 64) && (lk >= 0) && (lk < L);
                const float s2 = valid ? st[kt][reg] * sc2 - slope2 * (float)ad : -INFINITY; st[kt][reg] = s2; mx = fmaxf(mx, s2); }
        mx = fmaxf(mx, __shfl_xor(mx, 32));
        if (PROBE_T == 3) { T_ADD(F.tA, t1); T_START(t1); }
        float l = 0.f;
#pragma unroll
        for (int kt = 0; kt < 5; ++kt)
#pragma unroll
            for (int reg = 0; reg < 16; ++reg) { const float e = __builtin_amdgcn_exp2f(st[kt][reg] - mx); st[kt][reg] = e; l += e; }
        l += __shfl_xor(l, 32);
        f32x16 acc[2]; acc[0] = zero16(); acc[1] = zero16();
#pragma unroll
        for (int kt = 0; kt < 5; ++kt)
#pragma unroll
            for (int sp = 0; sp < 2; ++sp) { const bf16x8 pfr = pack8(st[kt], sp);
#pragma unroll
                for (int t = 0; t < 2; ++t) { const LAS unsigned char* vrow = VT + (32 * (2 * eh + t) + r) * PV + 2 * (32 * qt + 32 * kt + 16 * sp + 4 * hh);
                    const u32x2 lo = *(const LAS u32x2*)(vrow), hi = *(const LAS u32x2*)(vrow + 16);
                    acc[t] = MFMA32(cat8(lo, hi), pfr, acc[t]); }
                __builtin_amdgcn_sched_barrier(0); }
        const float il = 1.0f / l; const size_t orow = (size_t)b * SEQ + qrow;
        bf16* ob = (p == 0) ? (F.MIX + orow * D + h * HD) : (F.XN + (size_t)(p - 1) * M * DATT + orow * DATT + h * HD);
#pragma unroll
        for (int t = 0; t < 2; ++t)
#pragma unroll
            for (int g = 0; g < 4; ++g) { const int e = 32 * (2 * eh + t) + 8 * g + 4 * hh; u32x2 o; o.x = cvtpk(acc[t][4 * g] * il, acc[t][4 * g + 1] * il); o.y = cvtpk(acc[t][4 * g + 2] * il, acc[t][4 * g + 3] * il); *(GAS u32x2*)(ob + e) = o; }
        if (eh == 0 && hh == 0) F.LSE[(size_t)p * M * NH + orow * NH + h] = (mx + __log2f(l)) * 0.6931471805599453f;
        __syncthreads();
        if (PROBE_T == 1) T_ADD(F.tB, t0);
        if (PROBE_T == 3) T_ADD(F.tB, t1);
    }
}
__device__ __forceinline__ void p3_merge(Frame& F) {
    const int gt = F.vcu * (NWAVES * 64) + F.tid, NT = F.G * NWAVES * 64;
    for (int idx = gt; idx < M * (DATT / 8); idx += NT) { const int row = idx >> 7, c8 = idx & 127, h = c8 >> 4;
        const float l1 = F.LSE[(size_t)row * NH + h], l4 = F.LSE[(size_t)M * NH + (size_t)row * NH + h], l16 = F.LSE[(size_t)2 * M * NH + (size_t)row * NH + h];
        const float mx = fmaxf(l1, fmaxf(l4, l16)); float w1 = __expf(l1 - mx), w4 = __expf(l4 - mx), w16 = __expf(l16 - mx); const float inv = 1.0f / (w1 + w4 + w16); w1 *= inv; w4 *= inv; w16 *= inv;
        GAS v4u* pm = (GAS v4u*)(F.MIX + (size_t)row * D + 8 * c8);
        const v4u a = *pm, bq = *(const GAS v4u*)(F.XN + (size_t)row * DATT + 8 * c8), cq = *(const GAS v4u*)(F.XN + (size_t)M * DATT + (size_t)row * DATT + 8 * c8);
        v4u o;
#pragma unroll
        for (int k = 0; k < 4; ++k) o[k] = cvtpk(w1 * bflo(a[k]) + w4 * bflo(bq[k]) + w16 * bflo(cq[k]), w1 * bfhi(a[k]) + w4 * bfhi(bq[k]) + w16 * bfhi(cq[k]));
        *pm = o; }
}
typedef short v4i16_t __attribute__((ext_vector_type(4)));
__device__ __forceinline__ unsigned swz16(unsigned row) { return ((row & 3u) << 2) | ((row >> 2) & 3u); }
struct AttnUnit { int b, h, p, dil, cls, l0, L; const bf16 *Qb, *Kb, *Vb; };
__device__ __forceinline__ AttnUnit attn_unit(const Frame& F, int n) {
    int bh, u;
    if (F.G == 256) { const int it = n >> 8; bh = (F.vcu >> 5) + 8 * (it / 3); u = (F.vcu & 31) + 32 * (it % 3); }
    else { bh = n / 96; u = n % 96; }
    AttnUnit U; U.p = u >> 5; const int idx = u & 31, sh = 2 * U.p, nblk = 32 >> sh; U.dil = 1 << sh; U.cls = idx / nblk; U.l0 = 128 * (idx % nblk); U.L = SEQ >> sh; U.b = bh >> 3; U.h = bh & 7;
    U.Qb = HP(COL_QA, U.h) + (size_t)(U.b * SEQ) * HD; U.Kb = HP(COL_KA, U.h) + (size_t)(U.b * SEQ) * HD; U.Vb = HP(COL_VA, U.h) + (size_t)(U.b * SEQ) * HD;
    return U;
}
__device__ __forceinline__ void attn_dma(LAS unsigned char* img, const bf16* Xb, const AttnUnit& U, int w, int lane) {
#pragma unroll
    for (int i = 0; i < 8; ++i) { const int pc = 8 * w + i, row = 4 * pc + (lane >> 4), ch = (lane & 15) ^ (int)swz16((unsigned)row);
        int lk = U.l0 - 64 + row; lk = lk < 0 ? 0 : (lk >= U.L ? U.L - 1 : lk);
        __builtin_amdgcn_global_load_lds((const unsigned*)(Xb + (size_t)(lk * U.dil + U.cls) * HD + 8 * ch), (LAS unsigned*)(img + pc * 1024), 16, 0, 0); }
}
__device__ __forceinline__ void p2_attn_dma(Frame& F) {
    LAS unsigned char* KI = F.lds + RING_OFF; LAS unsigned char* VI = KI + 65536;
    const int w = F.wave, qt = w & 3, eh = w >> 2;
    const float scale = 0.08838834764831845f, L2E = 1.4426950408889634f;
    const int NU = BATCH * NH * 96;
    int n = F.vcu; if (n >= NU) return;
    AttnUnit U = attn_unit(F, n);
    bf16x8 qf[8];
    { int tid = F.tid; asm volatile("" : "+v"(tid)); const int lane = tid & 63, r = lane & 31, hh = lane >> 5;
      attn_dma(KI, U.Kb, U, w, lane);
      const size_t qrow = (size_t)((U.l0 + 32 * qt + r) * U.dil + U.cls);
#pragma unroll
      for (int s = 0; s < 8; ++s) qf[s] = *(const GAS bf16x8*)(U.Qb + qrow * HD + 16 * s + 8 * hh); }
    for (;;) {
        int tid = F.tid; asm volatile("" : "+v"(tid)); const int lane = tid & 63, r = lane & 31, hh = lane >> 5;
        unsigned long long t0 = 0, t1 = 0; T_START(t0);
        __syncthreads();
        if (PROBE_T == 1) T_ADD(F.tA, t0);
        T_START(t1);
        attn_dma(VI, U.Vb, U, w, lane);
        const int lq0 = U.l0 + 32 * qt;
        f32x16 st[5];
        const unsigned swr = swz16((unsigned)r);
#pragma unroll
        for (int kt = 0; kt < 5; ++kt) { st[kt] = zero16(); const int lk0 = lq0 - 64 + 32 * kt;
            if (lk0 >= 0 && lk0 < U.L) { const LAS unsigned char* krow = KI + (32 * (qt + kt) + r) * 256;
#pragma unroll
                for (int s = 0; s < 8; ++s) st[kt] = MFMA32(*(const LAS bf16x8*)(krow + 16 * ((unsigned)(2 * s + hh) ^ swr)), qf[s], st[kt]); }
            __builtin_amdgcn_sched_barrier(0); }
        const float slope2 = exp2f(-(float)(U.h + 1)) * (float)U.dil * L2E, sc2 = scale * L2E, frr = (float)(r - 4 * hh);
        float mx = -INFINITY;
#pragma unroll
        for (int kt = 0; kt < 5; ++kt) { const int lk0 = lq0 - 64 + 32 * kt; const bool tin = (lk0 >= 0 && lk0 < U.L);
#pragma unroll
            for (int reg = 0; reg < 16; ++reg) { const float ad = fabsf(frr + (float)(64 - 32 * kt - ((reg & 3) + 8 * (reg >> 2))));
                float s2 = st[kt][reg] * sc2 - slope2 * ad;
                if (kt == 0 || kt == 4) s2 = (ad <= 64.0f) ? s2 : -INFINITY;
                s2 = tin ? s2 : -INFINITY;
                st[kt][reg] = s2; mx = fmaxf(mx, s2); } }
        mx = fmaxf(mx, __shfl_xor(mx, 32));
        if (PROBE_T == 3) { T_ADD(F.tA, t1); T_START(t1); }
        __syncthreads();
        const int nn = n + F.G; const bool has_next = nn < NU;
        AttnUnit Un = U; if (has_next) { Un = attn_unit(F, nn); attn_dma(KI, Un.Kb, Un, w, lane); }
        float l = 0.f;
#pragma unroll
        for (int kt = 0; kt < 5; ++kt)
#pragma unroll
            for (int reg = 0; reg < 16; ++reg) { const float e = __builtin_amdgcn_exp2f(st[kt][reg] - mx); st[kt][reg] = e; l += e; }
        l += __shfl_xor(l, 32);
        f32x16 acc[2]; acc[0] = zero16(); acc[1] = zero16();
        const int q4 = (lane & 15) >> 2, pp = lane & 3, blk = (lane >> 4) & 1;
        unsigned voff[2][2][2];
#pragma unroll
        for (int t2 = 0; t2 < 2; ++t2) { const unsigned rl = (unsigned)(4 * hh + 8 * t2 + q4), sw = swz16(rl);
#pragma unroll
            for (int t = 0; t < 2; ++t) { const unsigned chunk = (unsigned)(4 * (2 * eh + t) + 2 * blk + (pp >> 1)); voff[t2][t][0] = 256u * rl + 16u * (chunk ^ sw) + 8u * (unsigned)(pp & 1); voff[t2][t][1] = 0; } }
#pragma unroll
        for (int kt = 0; kt < 5; ++kt) { const int lk0 = lq0 - 64 + 32 * kt;
            if (lk0 >= 0 && lk0 < U.L) {
#pragma unroll
                for (int sp = 0; sp < 2; ++sp) { const bf16x8 pfr = pack8(st[kt], sp); const LAS unsigned char* vb = VI + (32 * (qt + kt) + 16 * sp) * 256;
#pragma unroll
                    for (int t = 0; t < 2; ++t) {
                        const v4i16_t lo = __builtin_amdgcn_ds_read_tr16_b64_v4i16((LAS v4i16_t*)(vb + voff[0][t][0])), hi = __builtin_amdgcn_ds_read_tr16_b64_v4i16((LAS v4i16_t*)(vb + voff[1][t][0]));
                        const bf16x8 vf = __builtin_shufflevector(lo, hi, 0, 1, 2, 3, 4, 5, 6, 7);
                        acc[t] = MFMA32(vf, pfr, acc[t]); } } }
            __builtin_amdgcn_sched_barrier(0); }
        const float il = 1.0f / l; const size_t qrow = (size_t)((lq0 + r) * U.dil + U.cls), orow = (size_t)U.b * SEQ + qrow;
        bf16* ob = (U.p == 0) ? (F.MIX + orow * D + U.h * HD) : (F.XN + (size_t)(U.p - 1) * M * DATT + orow * DATT + U.h * HD);
#pragma unroll
        for (int t = 0; t < 2; ++t)
#pragma unroll
            for (int g = 0; g < 4; ++g) { const int e = 32 * (2 * eh + t) + 8 * g + 4 * hh; u32x2 o; o.x = cvtpk(acc[t][4 * g] * il, acc[t][4 * g + 1] * il); o.y = cvtpk(acc[t][4 * g + 2] * il, acc[t][4 * g + 3] * il); *(GAS u32x2*)(ob + e) = o; }
        if (eh == 0 && hh == 0) F.LSE[(size_t)U.p * M * NH + orow * NH + U.h] = (mx + __log2f(l)) * 0.6931471805599453f;
        if (PROBE_T == 1) T_ADD(F.tB, t0);
        if (PROBE_T == 3) T_ADD(F.tB, t1);
        if (!has_next) break;
        U = Un; n = nn;
        { const size_t qr2 = (size_t)((U.l0 + 32 * qt + r) * U.dil + U.cls);
#pragma unroll
          for (int s = 0; s < 8; ++s) qf[s] = *(const GAS bf16x8*)(U.Qb + qr2 * HD + 16 * s + 8 * hh); }
    }
    __syncthreads();
}
__device__ __forceinline__ void dma_rows128(LAS unsigned char* img, const bf16* src, int w, int lane) {
#pragma unroll
    for (int i = 0; i < 4; ++i) { const int pc = 4 * w + i, row = 4 * pc + (lane >> 4), ch = (lane & 15) ^ (int)swz16((unsigned)row);
        __builtin_amdgcn_global_load_lds((const unsigned*)(src + (size_t)row * HD + 8 * ch), (LAS unsigned*)(img + pc * 1024), 16, 0, 0); }
}
__device__ __forceinline__ unsigned tr_nat(int lane, int c, int ks, int t2) { const unsigned h = lane >> 5, blk = (lane >> 4) & 1, q = (lane & 15) >> 2, p = lane & 3, row = 16 * ks + 8 * h + 4 * t2 + q;
    return 256u * row + 16u * ((unsigned)(4 * c + 2 * blk + (p >> 1)) ^ swz16(row)) + 8u * (p & 1); }
__device__ __forceinline__ v4i16_t trd(const LAS unsigned char* p) { return __builtin_amdgcn_ds_read_tr16_b64_v4i16((LAS v4i16_t*)p); }
__device__ __forceinline__ void p2_r1_dma(Frame& F) {
    const int w = F.wave, dt = w & 3, et0 = 2 * (w >> 2);
    const float L2E = 1.4426950408889634f;
    const int NI = BATCH * NH * NCH;
    int item = F.vcu; if (item >= NI) return;
    bf16* STFh = (bf16*)F.STF; bf16* STBh = STFh + (size_t)NI * HD * HD;
    { int tid = F.tid; asm volatile("" : "+v"(tid)); const int lane = tid & 63;
      const int bh = item >> 5, c = item & 31, b = bh >> 3, h = bh & 7; const size_t row0 = (size_t)b * SEQ + c * CH;
      dma_rows128(F.lds + RING_OFF, HP(COL_KR, h) + row0 * HD, w, lane); dma_rows128(F.lds + RING_OFF + 32768, HP(COL_VR, h) + row0 * HD, w, lane); }
    for (int k = 0;; ++k) {
        int tid = F.tid; asm volatile("" : "+v"(tid)); const int lane = tid & 63, r = lane & 31, hh = lane >> 5;
        const int bh = item >> 5, h = bh & 7;
        __syncthreads();
        const int nitem = item + F.G; const bool has_next = nitem < NI;
        LAS unsigned char* KI = F.lds + RING_OFF + (k & 1) * 65536; LAS unsigned char* VI = KI + 32768;
        if (has_next) { const int bh2 = nitem >> 5, c2 = nitem & 31, b2 = bh2 >> 3, h2 = bh2 & 7; const size_t row2 = (size_t)b2 * SEQ + c2 * CH; LAS unsigned char* NB = F.lds + RING_OFF + ((k + 1) & 1) * 65536;
            dma_rows128(NB, HP(COL_KR, h2) + row2 * HD, w, lane); dma_rows128(NB + 32768, HP(COL_VR, h2) + row2 * HD, w, lane); }
        const float lgf2 = -__expf(F.decf[h]) * L2E, lgb2 = -__expf(F.decb[h]) * L2E;
        float gfi[8], gbi[8];
#pragma unroll
        for (int q = 0; q < 8; ++q) { gfi[q] = __builtin_amdgcn_exp2f(-lgf2 * (float)q); gbi[q] = __builtin_amdgcn_exp2f(lgb2 * (float)q); }
        f32x16 accf[2], accb[2]; accf[0] = zero16(); accf[1] = zero16(); accb[0] = zero16(); accb[1] = zero16();
#pragma unroll
        for (int s = 0; s < 8; ++s) {
            const v4i16_t klo = trd(KI + tr_nat(lane, dt, s, 0)), khi = trd(KI + tr_nat(lane, dt, s, 1));
            const bf16x8 kf = __builtin_shufflevector(klo, khi, 0, 1, 2, 3, 4, 5, 6, 7);
            const float bfw = __builtin_amdgcn_exp2f(lgf2 * (float)(CH - 1 - 16 * s - 8 * hh)), bbw = __builtin_amdgcn_exp2f(lgb2 * (float)(16 * s + 8 * hh));
#pragma unroll
            for (int t = 0; t < 2; ++t) { const v4i16_t vlo = trd(VI + tr_nat(lane, et0 + t, s, 0)), vhi = trd(VI + tr_nat(lane, et0 + t, s, 1));
                float v[8];
#pragma unroll
                for (int q = 0; q < 4; ++q) { v[q] = __builtin_bit_cast(float, (unsigned)(unsigned short)vlo[q] << 16); v[4 + q] = __builtin_bit_cast(float, (unsigned)(unsigned short)vhi[q] << 16); }
                v4u pf_, pb_;
#pragma unroll
                for (int q = 0; q < 4; ++q) { pf_[q] = cvtpk(v[2 * q] * (bfw * gfi[2 * q]), v[2 * q + 1] * (bfw * gfi[2 * q + 1])); pb_[q] = cvtpk(v[2 * q] * (bbw * gbi[2 * q]), v[2 * q + 1] * (bbw * gbi[2 * q + 1])); }
                accf[t] = MFMA32(kf, __builtin_bit_cast(bf16x8, pf_), accf[t]); accb[t] = MFMA32(kf, __builtin_bit_cast(bf16x8, pb_), accb[t]); }
        }
        bf16* of = STFh + (size_t)item * HD * HD; bf16* ob = STBh + (size_t)item * HD * HD;
#pragma unroll
        for (int t = 0; t < 2; ++t) { const int e = 32 * (et0 + t) + r;
#pragma unroll
            for (int g = 0; g < 4; ++g) { const int d0 = 32 * dt + 8 * g + 4 * hh;
                u32x2 o1; o1.x = cvtpk(accf[t][4 * g], accf[t][4 * g + 1]); o1.y = cvtpk(accf[t][4 * g + 2], accf[t][4 * g + 3]); *(GAS u32x2*)(of + e * HD + d0) = o1;
                u32x2 o2; o2.x = cvtpk(accb[t][4 * g], accb[t][4 * g + 1]); o2.y = cvtpk(accb[t][4 * g + 2], accb[t][4 * g + 3]); *(GAS u32x2*)(ob + e * HD + d0) = o2; } }
        if (!has_next) break;
        item = nitem;
    }
    __syncthreads();
}
__device__ __forceinline__ void p3_scan_bf16(Frame& F) {
    const int gt = F.vcu * (NWAVES * 64) + F.tid, NT = F.G * NWAVES * 64;
    const bf16* STFh = (const bf16*)F.STF; const bf16* STBh = STFh + (size_t)BATCH * NH * NCH * HD * HD;
    for (int idx = gt; idx < 2 * BATCH * NH * 2048; idx += NT) {
        const int dir = idx / (BATCH * NH * 2048), rem = idx % (BATCH * NH * 2048), bh = rem >> 11, q = rem & 2047, h = bh & 7;
        const float g = __expf(-__expf(dir ? F.decb[h] : F.decf[h]) * (float)CH);
        const GAS v4u* base = (const GAS v4u*)(dir ? STBh : STFh) + (size_t)bh * NCH * 2048 + q;
        float s[8];
#pragma unroll
        for (int i = 0; i < 8; ++i) s[i] = 0.f;
#pragma unroll 8
        for (int cc = 0; cc < NCH; ++cc) { const int c = dir ? NCH - 1 - cc : cc; const v4u t = base[(size_t)c * 2048];
            v4u o; o.x = cvtpk(s[0], s[1]); o.y = cvtpk(s[2], s[3]); o.z = cvtpk(s[4], s[5]); o.w = cvtpk(s[6], s[7]);
            *(GAS v4u*)(sbf_row(F.PROJ, 2 * (bh * NCH + c) + dir, q >> 4) + 8 * (q & 15)) = o;
#pragma unroll
            for (int i = 0; i < 4; ++i) { s[2 * i] = s[2 * i] * g + bflo(t[i]); s[2 * i + 1] = s[2 * i + 1] * g + bfhi(t[i]); } }
    }
}
__device__ __forceinline__ void p4_r3_dma(Frame& F) {
    LAS unsigned char* KI = F.lds + RING_OFF; LAS unsigned char* VI = KI + 32768; LAS unsigned char* SFI = KI + 65536; LAS unsigned char* SBI = KI + 98304; LAS float* XS = (LAS float*)(KI + 131072);
    const int w = F.wave, qt = w & 3, eh = w >> 2;
    const float scale = 0.08838834764831845f, L2E = 1.4426950408889634f;
    const int NI = BATCH * NH * NCH;
    int item = F.vcu; if (item >= NI) return;
    bf16x8 qf[8];
    { int tid = F.tid; asm volatile("" : "+v"(tid)); const int lane = tid & 63, r = lane & 31, hh = lane >> 5;
      const int bh = item >> 5, c = item & 31, b = bh >> 3, h = bh & 7; const size_t row0 = (size_t)b * SEQ + c * CH;
      dma_rows128(KI, HP(COL_KR, h) + row0 * HD, w, lane); dma_rows128(SFI, sbf_row(F.PROJ, 2 * item, 0), w, lane); dma_rows128(SBI, sbf_row(F.PROJ, 2 * item + 1, 0), w, lane);
      const bf16* Qg = HP(COL_QR, h) + row0 * HD;
#pragma unroll
      for (int s = 0; s < 8; ++s) qf[s] = *(const GAS bf16x8*)(Qg + (size_t)(32 * qt + r) * HD + 16 * s + 8 * hh); }
    for (;;) {
        int tid = F.tid; asm volatile("" : "+v"(tid)); const int lane = tid & 63, r = lane & 31, hh = lane >> 5;
        const int bh = item >> 5, c = item & 31, b = bh >> 3, h = bh & 7; const size_t row0 = (size_t)b * SEQ + c * CH;
        const bf16* Gg = HP(COL_GR, h) + row0 * HD;
        const float lgf2 = -__expf(F.decf[h]) * L2E, lgb2 = -__expf(F.decb[h]) * L2E;
        const int iq = 32 * qt + r;
        __syncthreads();
        dma_rows128(VI, HP(COL_VR, h) + row0 * HD, w, lane);
        u32x2 gg[2][4];
        if (tid < 32) ((LAS f32x4*)(XS + 256))[tid] = *(const GAS f32x4*)(F.w_retn + h * HD + 4 * tid);
#pragma unroll
        for (int t = 0; t < 2; ++t)
#pragma unroll
            for (int g = 0; g < 4; ++g) gg[t][g] = *(const GAS u32x2*)(Gg + (size_t)iq * HD + 32 * (2 * eh + t) + 8 * g + 4 * hh);
        const unsigned swr = swz16((unsigned)r);
        f32x16 st[4];
#pragma unroll
        for (int kt = 0; kt < 4; ++kt) { st[kt] = zero16(); const LAS unsigned char* krow = KI + (32 * kt + r) * 256;
#pragma unroll
            for (int s = 0; s < 8; ++s) st[kt] = MFMA32(*(const LAS bf16x8*)(krow + 16 * ((unsigned)(2 * s + hh) ^ swr)), qf[s], st[kt]);
            __builtin_amdgcn_sched_barrier(0); }
        bf16x8 pf[4][2];
#pragma unroll
        for (int kt = 0; kt < 4; ++kt) {
#pragma unroll
            for (int reg = 0; reg < 16; ++reg) { const int j = 32 * kt + (reg & 3) + 8 * (reg >> 2) + 4 * hh, dj = iq - j;
                const float dec = __builtin_amdgcn_exp2f(dj >= 0 ? lgf2 * (float)dj : lgb2 * (float)(-dj)); st[kt][reg] *= scale * dec; }
            pf[kt][0] = pack8(st[kt], 0); pf[kt][1] = pack8(st[kt], 1); }
        const float ff = __builtin_amdgcn_exp2f(lgf2 * (float)(iq + 1)) * scale, fb = __builtin_amdgcn_exp2f(lgb2 * (float)(CH - iq)) * scale;
        f32x16 acc[2];
#pragma unroll
        for (int t = 0; t < 2; ++t) { f32x16 a1 = zero16(), a2 = zero16(); const int erow = (32 * (2 * eh + t) + r) * 256;
#pragma unroll
            for (int s = 0; s < 8; ++s) { const unsigned co = 16 * ((unsigned)(2 * s + hh) ^ swr);
                a1 = MFMA32(*(const LAS bf16x8*)(SFI + erow + co), qf[s], a1); a2 = MFMA32(*(const LAS bf16x8*)(SBI + erow + co), qf[s], a2); }
#pragma unroll
            for (int reg = 0; reg < 16; ++reg) acc[t][reg] = ff * a1[reg] + fb * a2[reg];
            __builtin_amdgcn_sched_barrier(0); }
        __syncthreads();
        const int nitem = item + F.G; const bool has_next = nitem < NI;
        if (has_next) { const int bh2 = nitem >> 5, c2 = nitem & 31, b2 = bh2 >> 3, h2 = bh2 & 7; const size_t row2 = (size_t)b2 * SEQ + c2 * CH;
            dma_rows128(KI, HP(COL_KR, h2) + row2 * HD, w, lane); dma_rows128(SFI, sbf_row(F.PROJ, 2 * nitem, 0), w, lane); dma_rows128(SBI, sbf_row(F.PROJ, 2 * nitem + 1, 0), w, lane); }
        { const int q4 = (lane & 15) >> 2, pp = lane & 3, blk = (lane >> 4) & 1; unsigned voff[2][2];
#pragma unroll
          for (int t2 = 0; t2 < 2; ++t2) { const unsigned rl = (unsigned)(4 * hh + 8 * t2 + q4), sw = swz16(rl);
#pragma unroll
              for (int t = 0; t < 2; ++t) voff[t2][t] = 256u * rl + 16u * ((unsigned)(4 * (2 * eh + t) + 2 * blk + (pp >> 1)) ^ sw) + 8u * (unsigned)(pp & 1); }
#pragma unroll
          for (int kt = 0; kt < 4; ++kt) {
#pragma unroll
              for (int sp = 0; sp < 2; ++sp) { const LAS unsigned char* vb = VI + (32 * kt + 16 * sp) * 256;
#pragma unroll
                  for (int t = 0; t < 2; ++t) { const v4i16_t lo = trd(vb + voff[0][t]), hi = trd(vb + voff[1][t]);
                      acc[t] = MFMA32(__builtin_shufflevector(lo, hi, 0, 1, 2, 3, 4, 5, 6, 7), pf[kt][sp], acc[t]); } }
              __builtin_amdgcn_sched_barrier(0); } }
        float ssq = 0.f;
#pragma unroll
        for (int t = 0; t < 2; ++t)
#pragma unroll
            for (int reg = 0; reg < 16; ++reg) ssq += acc[t][reg] * acc[t][reg];
        ssq += __shfl_xor(ssq, 32);
        if (hh == 0) XS[w * 32 + r] = ssq;
        asm volatile("s_waitcnt lgkmcnt(0)" ::: "memory"); __builtin_amdgcn_s_barrier(); asm volatile("" ::: "memory");
        const float rms = 1.0f / sqrtf((XS[w * 32 + r] + XS[(w ^ 4) * 32 + r]) * (1.0f / HD) + EPS);
#pragma unroll
        for (int t = 0; t < 2; ++t)
#pragma unroll
            for (int g = 0; g < 4; ++g) { const int e = 32 * (2 * eh + t) + 8 * g + 4 * hh; const f32x4 wn = *(const LAS f32x4*)(XS + 256 + e);
                const float g0 = bflo(gg[t][g].x), g1 = bfhi(gg[t][g].x), g2 = bflo(gg[t][g].y), g3 = bfhi(gg[t][g].y);
                const float o0 = acc[t][4 * g] * rms * wn.x * (g0 / (1.0f + __expf(-g0))), o1 = acc[t][4 * g + 1] * rms * wn.y * (g1 / (1.0f + __expf(-g1)));
                const float o2 = acc[t][4 * g + 2] * rms * wn.z * (g2 / (1.0f + __expf(-g2))), o3 = acc[t][4 * g + 3] * rms * wn.w * (g3 / (1.0f + __expf(-g3)));
                u32x2 o; o.x = cvtpk(o0, o1); o.y = cvtpk(o2, o3); *(GAS u32x2*)(F.MIX + (row0 + iq) * D + DATT + h * HD + e) = o; }
        if (!has_next) break;
        item = nitem;
        { const int bh2 = item >> 5, c2 = item & 31, b2 = bh2 >> 3, h2 = bh2 & 7; const bf16* Qg = HP(COL_QR, h2) + ((size_t)b2 * SEQ + c2 * CH) * HD;
#pragma unroll
          for (int s = 0; s < 8; ++s) qf[s] = *(const GAS bf16x8*)(Qg + (size_t)(32 * qt + r) * HD + 16 * s + 8 * hh); }
    }
    __syncthreads();
}
struct Args { const float* in[12]; float* out; unsigned char* ws; int ph_lo, ph_hi, li, pad; };
__global__ void __launch_bounds__(NWAVES * 64, 2) mk_fwd(Args args) {
    extern __shared__ __attribute__((aligned(16))) unsigned char lds[];
    Frame F;
    F.lds = (LAS unsigned char*)lds;
    F.MISC = (volatile LAS unsigned*)(F.lds + MISC_OFF);
    F.tid = threadIdx.x; F.lane = F.tid & 63; F.wave = __builtin_amdgcn_readfirstlane(F.tid >> 6);
    F.G = gridDim.x; { const int bx = blockIdx.x; F.vcu = (F.G % 8 == 0) ? (bx % 8) * (F.G / 8) + bx / 8 : bx; }
    unsigned char* ws = args.ws;
    F.ctl = (gu32*)(ws + WS_CTL);
    F.x = args.in[0]; F.w_mix = args.in[1]; F.w_in = args.in[2]; F.decf = args.in[3]; F.decb = args.in[4]; F.w_retn = args.in[5]; F.w_out = args.in[6];
    F.w_ffn = args.in[7]; F.w_gate = args.in[8]; F.w_up = args.in[9]; F.w_down = args.in[10]; F.w_fin = args.in[11]; F.out = args.out;
    F.Win_t = (bf16*)(ws + WS_WIN); F.Wout_t = (bf16*)(ws + WS_WOUT); F.Wgu_t = (bf16*)(ws + WS_WGU); F.Wdn_t = (bf16*)(ws + WS_WDN);
    F.XN = (bf16*)(ws + WS_XN); F.PROJ = (bf16*)(ws + WS_PROJ); F.MIX = (bf16*)(ws + WS_MIX); F.ACT = (bf16*)(ws + WS_PROJ);
    F.STF = args.out; F.STB = args.out + ST_HALF; F.SS1 = (float*)(ws + WS_CTL + CTL_SS1); F.LSE = (float*)(ws + WS_LSE);
    F.tA = 0; F.tB = 0;
    for (int u = F.tid; u < (LDS_BYTES - LDSCTL_OFF) / 4; u += NWAVES * 64) ((LAS unsigned*)(F.lds + LDSCTL_OFF))[u] = 0u;
    __syncthreads();
    XcdBarrier bar; bar.bar = (unsigned*)(F.ctl + CW_BAR); bar.x = 0; bar.st = nullptr;
    if (N_LAUNCHES != PER_PHASE) bar = xcd_barrier_post((unsigned*)(F.ctl + CW_BAR), F.MISC + 8);
#define GRID_BAR(seam) do { if (N_LAUNCHES == PER_PHASE) { if (F.tid == 0) __hip_atomic_store(F.ctl + CW_TMO, 0xBADBA0u | (unsigned)(seam), RLX_AGENT); } else { xcd_barrier(bar); } } while (0)
    const int lo = args.ph_lo, hi = args.ph_hi;
#define IN(k) (lo <= (k) && (k) < hi)
#define BOTH(k) (IN(k) && IN((k) + 1))

#define REP(k) (((PROBE_REPEAT) >> (k)) & 1)
    if (IN(0)) { p0_prologue(F); if (REP(0)) p0_prologue(F); if (BOTH(0)) GRID_BAR(0); }
    if (N_LAUNCHES != PER_PHASE && lo == 0 && hi > 1) {
        unsigned pre = 0;
        for (unsigned j = 0; j < bar.x; ++j) pre += xb_ld(&bar.bar[XB_XCNT(j)]);
        F.vcu = (int)(pre + F.MISC[10]);
    }
    if (IN(1)) {
        pg8::Gemm g{F.XN, F.Win_t, M, DIN, D}; pg8::StaticOrder S; S.init(M, DIN, F.G, (int)blockIdx.x);
        pg8::EpiHeads E{F.PROJ, M};
        for (int rep = 0; rep <= REP(1); ++rep) pg8::gemm_phase<pg8::EpiHeads, pg8::StaticOrder, true, true>(F.lds + RING_OFF, g, S, E);
        if (REP(9)) { pg8::EpiNull E0{}; pg8::gemm_phase<pg8::EpiNull, pg8::StaticOrder, true, true>(F.lds + RING_OFF, g, S, E0); }
        if (BOTH(1)) GRID_BAR(1);
    }
    if (IN(2)) {
        for (int rep = 0; rep <= REP(2); ++rep) {
#if ATTN_NAIVE
        p2_attn_naive(F); __syncthreads();
#elif ATTN_V1
        p2_attn_mfma(F);
#else
        p2_attn_dma(F);
#endif
#if R1_NAIVE
        p2_r1_naive(F);
#elif R1_V1
        p2_r1_mfma(F);
#else
        { unsigned long long tR1 = 0; T_START(tR1); p2_r1_dma(F); if (PROBE_T == 2) T_ADD(F.tA, tR1); }
#endif
        }
        if (BOTH(2)) GRID_BAR(2); }
#if R1_NAIVE || R1_V1
#define P3_SCAN p3_scan
#else
#define P3_SCAN p3_scan_bf16
#endif
    if (IN(3)) { P3_SCAN(F); if (REP(3)) P3_SCAN(F);
#if !ATTN_NAIVE
        p3_merge(F);
#endif
        if (BOTH(3)) GRID_BAR(3); }
    if (IN(4)) {
        for (int rep = 0; rep <= REP(4); ++rep) {
#if R3_NAIVE
        p4_r3_naive(F);
#elif R3_V1
        p4_r3_mfma(F);
#else
        { unsigned long long tR3 = 0; T_START(tR3); p4_r3_dma(F); if (PROBE_T == 2) T_ADD(F.tB, tR3); }
#endif
        }
        if (BOTH(4)) GRID_BAR(4); }
    if (IN(5)) {
        pg8::Gemm g{F.MIX, F.Wout_t, M, D, D}; pg8::StaticOrder S; S.init(M, D, F.G, (int)blockIdx.x);
        pg8::EpiResidToBf E{F.x, F.XN, F.SS1, D};
        pg8::gemm_phase<pg8::EpiResidToBf, pg8::StaticOrder, true, true>(F.lds + RING_OFF, g, S, E);
        if (REP(10)) { pg8::EpiNull E0{}; pg8::gemm_phase<pg8::EpiNull, pg8::StaticOrder, true, true>(F.lds + RING_OFF, g, S, E0); }
        if (REP(5)) { pg8::EpiResidToBf E2{F.x, F.XN, nullptr, D}; pg8::gemm_phase<pg8::EpiResidToBf, pg8::StaticOrder, true, true>(F.lds + RING_OFF, g, S, E2); }
        if (BOTH(5)) GRID_BAR(5);
    }
    if (IN(6)) {
        pg8::Gemm g{F.XN, F.Wgu_t, M, NGU, D}; pg8::StaticOrder S; S.init(M, NGU, F.G, (int)blockIdx.x);
        pg8::EpiSwiGLU E{F.ACT, DFF, F.SS1, 1.0f / D, EPS};
        for (int rep = 0; rep <= REP(6); ++rep) pg8::gemm_phase<pg8::EpiSwiGLU, pg8::StaticOrder, true, true>(F.lds + RING_OFF, g, S, E);
        if (REP(11)) { pg8::EpiNull E0{}; pg8::gemm_phase<pg8::EpiNull, pg8::StaticOrder, true, true>(F.lds + RING_OFF, g, S, E0); }
        if (BOTH(6)) GRID_BAR(6);
    }
    if (IN(7)) {
        pg8::Gemm g{F.ACT, F.Wdn_t, M, D, DFF}; pg8::StaticOrder S; S.init(M, D, F.G, (int)blockIdx.x);
        if (REP(7)) { pg8::EpiNull E0{}; pg8::gemm_phase<pg8::EpiNull, pg8::StaticOrder, true, true>(F.lds + RING_OFF, g, S, E0); }
        pg8::EpiResidFromBf E{F.XN, F.out, D};
        pg8::gemm_phase<pg8::EpiResidFromBf, pg8::StaticOrder, true, true>(F.lds + RING_OFF, g, S, E);
        if (BOTH(7)) GRID_BAR(7);
    }
    if (IN(8)) { if (REP(8)) p8_final(F, true); p8_final(F, false); }
#if PROBE_T
    if (blockIdx.x == PROBE_BLOCK && F.tid == 0) {
        const unsigned long long t0 = RT(), span = (unsigned long long)PROBE_MULT * (PROBE_USE_B ? F.tB : F.tA);
        while (RT() - t0 < span) __builtin_amdgcn_s_sleep(8);
    }
#endif
#undef REP
#undef IN
#undef BOTH
}

extern "C" void kernel_launch(void* const* d_in, const int* in_sizes, int n_in, void* d_out, int out_size, void* d_ws, size_t ws_size, hipStream_t stream) {
    static int grid = 0;
    if (grid == 0) {
        if (n_in != 12 || in_sizes[0] != M * D || out_size != M * D || ws_size < WS_END) { fprintf(stderr, "kernel_launch: shape/workspace mismatch (n_in %d, in0 %d, out %d, ws %zu, need %zu)\n", n_in, n_in > 0 ? in_sizes[0] : -1, out_size, ws_size, (size_t)WS_END); grid = -1; return; }
        int dev = 0, cus = 0, per_cu = 0;
        if (hipGetDevice(&dev) != hipSuccess || hipDeviceGetAttribute(&cus, hipDeviceAttributeMultiprocessorCount, dev) != hipSuccess) { grid = -1; return; }
        if (hipFuncSetAttribute((const void*)mk_fwd, hipFuncAttributeMaxDynamicSharedMemorySize, LDS_BYTES) != hipSuccess) { fprintf(stderr, "kernel_launch: hipFuncSetAttribute failed\n"); grid = -1; return; }
        if (hipOccupancyMaxActiveBlocksPerMultiprocessor(&per_cu, (const void*)mk_fwd, NWAVES * 64, LDS_BYTES) != hipSuccess || per_cu < 1) fprintf(stderr, "kernel_launch: occupancy query reports %d\n", per_cu);
        (void)hipGetLastError();
        grid = cus;
    }
    if (grid < 0) return;
    (void)hipMemsetAsync((char*)d_ws + WS_CTL, 0, CTL_ZERO_BYTES, stream);
    Args a{};
    for (int i = 0; i < 12; ++i) a.in[i] = (const float*)d_in[i];
    a.out = (float*)d_out; a.ws = (unsigned char*)d_ws;
    if (N_LAUNCHES == 1) { a.ph_lo = 0; a.ph_hi = PER_PHASE; a.li = 0; hipLaunchKernelGGL(mk_fwd, dim3(grid), dim3(NWAVES * 64), LDS_BYTES, stream, a); }
    else for (int li = 0; li < PER_PHASE; ++li) { a.ph_lo = li; a.ph_hi = li + 1; a.li = li; hipLaunchKernelGGL(mk_fwd, dim3(grid), dim3(NWAVES * 64), LDS_BYTES, stream, a); }
}
```
